# Optimizing an MI355X kernel written in HIP

```python
import jax, jax.numpy as jnp
from jax import lax
import numpy as np

D_MODEL = 2048
BATCH = 8
SEQ = 2048
DEPTH = 1

CHUNK = 64
Q_BLOCK = 128
ROPE_THETA = 500000.0
EPS = 1e-6
NEG_INF = -1e30
N_BRANCHES = 2

MLA_HEADS = 8
MLA_NOPE = 128
MLA_ROPE = 64
MLA_V = 128
MLA_Q_RANK = 512
MLA_KV_RANK = 256

DSA_HEADS = 8
DSA_KV_HEADS = 2
DSA_GROUP = DSA_HEADS // DSA_KV_HEADS
DSA_HEAD_DIM = 128
DSA_ROT = DSA_HEAD_DIM // 4
IDX_HEADS = 16
IDX_DIM = 64
IDX_ROT = IDX_DIM // 4
DSA_TOPK_MAX = 256

PEER_HEADS = 8
PEER_N_KEYS = 128
PEER_N_EXPERTS = PEER_N_KEYS * PEER_N_KEYS
PEER_KEY_DIM = 128
PEER_TOPK = 16
PEER_TOKEN_BLOCK = 128

IN_SIZES = (
    MLA_Q_RANK,
    MLA_KV_RANK,
    MLA_ROPE,
    DSA_HEADS * DSA_HEAD_DIM,
    DSA_KV_HEADS * DSA_HEAD_DIM,
    DSA_KV_HEADS * DSA_HEAD_DIM,
    IDX_HEADS * IDX_DIM,
    IDX_DIM,
    IDX_HEADS,
    N_BRANCHES * D_MODEL,
)
IN_WIDTH = sum(IN_SIZES)

kernel_name = "hybrid_mla_dsa_peer_chunk_causal"


def rmsnorm(t, g):
    tf = t.astype(jnp.float32)
    y = tf * lax.rsqrt(jnp.mean(tf * tf, axis=-1, keepdims=True) + EPS)
    return (y * g.astype(jnp.float32)).astype(t.dtype)


def rope(t, positions, rot_dim):
    half = rot_dim // 2
    inv_freq = ROPE_THETA ** (-(jnp.arange(half, dtype=jnp.float32) * 2.0) / rot_dim)
    ang = positions.astype(jnp.float32)[..., None] * inv_freq
    cos = jnp.cos(ang)[:, :, None, :]
    sin = jnp.sin(ang)[:, :, None, :]
    t1 = t[..., :half].astype(jnp.float32)
    t2 = t[..., half:rot_dim].astype(jnp.float32)
    rest = t[..., rot_dim:]
    return jnp.concatenate([(t1 * cos - t2 * sin).astype(t.dtype),
                            (t2 * cos + t1 * sin).astype(t.dtype), rest], axis=-1)


def to_blocks(t):
    B, S = t.shape[:2]
    return t.reshape((B, S // Q_BLOCK, Q_BLOCK) + t.shape[2:]).swapaxes(0, 1)


def from_blocks(t):
    nb, B, qb, w = t.shape
    return t.swapaxes(0, 1).reshape(B, nb * qb, w)


def chunk_causal_attention(q, k, v, scale):
    S = q.shape[1]
    n_blocks = S // Q_BLOCK
    starts = jnp.arange(n_blocks, dtype=jnp.int32) * Q_BLOCK
    key_chunk = jnp.arange(S, dtype=jnp.int32) // CHUNK

    def one_block(args):
        q_blk, q0 = args
        q_chunk = (q0 + jnp.arange(Q_BLOCK, dtype=jnp.int32)) // CHUNK
        allowed = key_chunk[None, :] <= q_chunk[:, None]
        s = jnp.einsum('bqhd,bkhd->bhqk', q_blk, k).astype(jnp.float32) * scale
        s = jnp.where(allowed[None, None], s, NEG_INF)
        p = jax.nn.softmax(s, axis=-1).astype(v.dtype)
        o = jnp.einsum('bhqk,bkhd->bqhd', p, v)
        return o.reshape(o.shape[0], Q_BLOCK, -1)

    return from_blocks(lax.map(one_block, (to_blocks(q), starts)))


def mla_branch(c_q, c_kv, k_rope, positions, q_norm_g, kv_norm_g, w_uq, w_uk, w_uv):
    B, S, _ = c_q.shape
    q = jnp.einsum('bsr,rhd->bshd', rmsnorm(c_q, q_norm_g), w_uq)
    q = jnp.concatenate([q[..., :MLA_NOPE], rope(q[..., MLA_NOPE:], positions, MLA_ROPE)], axis=-1)
    ckv = rmsnorm(c_kv, kv_norm_g)
    k_nope = jnp.einsum('bsr,rhd->bshd', ckv, w_uk)
    v = jnp.einsum('bsr,rhd->bshd', ckv, w_uv)
    k_pe = rope(k_rope[:, :, None, :], positions, MLA_ROPE)
    k = jnp.concatenate([k_nope, jnp.broadcast_to(k_pe, (B, S, MLA_HEADS, MLA_ROPE))], axis=-1)
    return chunk_causal_attention(q, k, v, (MLA_NOPE + MLA_ROPE) ** -0.5)


def dsa_branch(q, k, v, q_idx, k_idx, w_idx, positions):
    B, S, _ = q.shape
    q = rope(q.reshape(B, S, DSA_HEADS, DSA_HEAD_DIM), positions, DSA_ROT)
    k = rope(k.reshape(B, S, DSA_KV_HEADS, DSA_HEAD_DIM), positions, DSA_ROT)
    v = v.reshape(B, S, DSA_KV_HEADS, DSA_HEAD_DIM)
    q_idx = rope(q_idx.reshape(B, S, IDX_HEADS, IDX_DIM), positions, IDX_ROT)
    k_idx = rope(k_idx[:, :, None, :], positions, IDX_ROT)[:, :, 0, :]
    top_k = min(DSA_TOPK_MAX, S // 4)
    n_blocks = S // Q_BLOCK
    starts = jnp.arange(n_blocks, dtype=jnp.int32) * Q_BLOCK
    key_chunk = jnp.arange(S, dtype=jnp.int32) // CHUNK
    scale = DSA_HEAD_DIM ** -0.5
    gather_rows = jax.vmap(lambda table, idx: table[idx])

    def one_block(args):
        q_blk, qi_blk, w_blk, q0 = args
        q_chunk = (q0 + jnp.arange(Q_BLOCK, dtype=jnp.int32)) // CHUNK
        allowed = key_chunk[None, :] <= q_chunk[:, None]
        dots = jnp.einsum('bqhd,bsd->bqhs', qi_blk, k_idx).astype(jnp.float32) * IDX_DIM ** -0.5
        w = w_blk.astype(jnp.float32) * IDX_HEADS ** -0.5
        index_score = jnp.einsum('bqh,bqhs->bqs', w, jax.nn.relu(dots))
        index_score = jnp.where(allowed[None], index_score, NEG_INF)
        _, sel = lax.top_k(index_score, top_k)
        valid = (sel // CHUNK) <= q_chunk[None, :, None]
        k_sel = gather_rows(k, sel)
        v_sel = gather_rows(v, sel)
        qg = q_blk.reshape(B, Q_BLOCK, DSA_KV_HEADS, DSA_GROUP, DSA_HEAD_DIM)
        s = jnp.einsum('bqgnd,bqkgd->bqgnk', qg, k_sel).astype(jnp.float32) * scale
        s = jnp.where(valid[:, :, None, None, :], s, NEG_INF)
        p = jax.nn.softmax(s, axis=-1).astype(v.dtype)
        o = jnp.einsum('bqgnk,bqkgd->bqgnd', p, v_sel)
        return o.reshape(B, Q_BLOCK, DSA_HEADS * DSA_HEAD_DIM)

    out = lax.map(one_block, (to_blocks(q), to_blocks(q_idx), to_blocks(w_idx), starts))
    return from_blocks(out)


def peer_ffn(h, w_q, sub_keys, u_emb, v_emb):
    B, S, D = h.shape
    n_blocks = (B * S) // PEER_TOKEN_BLOCK
    half = PEER_KEY_DIM // 2

    def one_block(xb):
        q = jnp.einsum('td,dhk->thk', xb, w_q).reshape(PEER_TOKEN_BLOCK, PEER_HEADS, 2, half)
        s = jnp.einsum('thpc,hpnc->thpn', q, sub_keys).astype(jnp.float32)
        s1, i1 = lax.top_k(s[:, :, 0], PEER_TOPK)
        s2, i2 = lax.top_k(s[:, :, 1], PEER_TOPK)
        cand_s = (s1[..., :, None] + s2[..., None, :]).reshape(PEER_TOKEN_BLOCK, PEER_HEADS, -1)
        cand_i = (i1[..., :, None] * PEER_N_KEYS + i2[..., None, :]).reshape(PEER_TOKEN_BLOCK, PEER_HEADS, -1)
        top_s, pos = lax.top_k(cand_s, PEER_TOPK)
        expert = jnp.take_along_axis(cand_i, pos, axis=-1)
        g = jax.nn.softmax(top_s, axis=-1)
        u = u_emb[expert]
        a = jax.nn.gelu(jnp.einsum('thkd,td->thk', u, xb).astype(jnp.float32), approximate=False)
        coef = (g * a).astype(xb.dtype)
        return jnp.einsum('thk,thkd->td', coef, v_emb[expert])

    out = lax.map(one_block, h.reshape(n_blocks, PEER_TOKEN_BLOCK, D))
    return out.reshape(B, S, D)


def setup_inputs(seed: int = 0) -> dict:
    key = jax.random.key(seed)
    ks = jax.random.split(key, 20)
    f32 = jnp.float32
    L = DEPTH

    def nrm(k, shape, fan_in):
        return jax.random.normal(k, shape, f32) * (fan_in ** -0.5)

    def gain(k, shape):
        return 1.0 + 0.01 * jax.random.normal(k, shape, f32)

    x = jax.random.normal(ks[0], (BATCH, SEQ, D_MODEL), f32)
    start = jax.random.randint(ks[1], (BATCH, 1), 0, 64, dtype=jnp.int32) * CHUNK
    positions = start + jnp.arange(SEQ, dtype=jnp.int32)[None, :]
    return {
        'x': x,
        'positions': positions,
        'norm_mix_g': gain(ks[2], (L, D_MODEL)),
        'w_in': nrm(ks[3], (L, D_MODEL, IN_WIDTH), D_MODEL),
        'mla_q_norm_g': gain(ks[4], (L, MLA_Q_RANK)),
        'mla_kv_norm_g': gain(ks[5], (L, MLA_KV_RANK)),
        'mla_w_uq': nrm(ks[6], (L, MLA_Q_RANK, MLA_HEADS, MLA_NOPE + MLA_ROPE), MLA_Q_RANK),
        'mla_w_uk': nrm(ks[7], (L, MLA_KV_RANK, MLA_HEADS, MLA_NOPE), MLA_KV_RANK),
        'mla_w_uv': nrm(ks[8], (L, MLA_KV_RANK, MLA_HEADS, MLA_V), MLA_KV_RANK),
        'w_branch_a': nrm(ks[9], (L, MLA_HEADS * MLA_V, D_MODEL), MLA_HEADS * MLA_V),
        'w_branch_b': nrm(ks[10], (L, DSA_HEADS * DSA_HEAD_DIM, D_MODEL), DSA_HEADS * DSA_HEAD_DIM),
        'w_out': nrm(ks[11], (L, D_MODEL, D_MODEL), D_MODEL),
        'norm_ffn_g': gain(ks[12], (L, D_MODEL)),
        'peer_w_q': nrm(ks[13], (L, D_MODEL, PEER_HEADS, PEER_KEY_DIM), D_MODEL),
        'peer_sub_keys': nrm(ks[14], (L, PEER_HEADS, 2, PEER_N_KEYS, PEER_KEY_DIM // 2), PEER_KEY_DIM // 2),
        'peer_u': nrm(ks[15], (L, PEER_N_EXPERTS, D_MODEL), D_MODEL),
        'peer_v': nrm(ks[16], (L, PEER_N_EXPERTS, D_MODEL), PEER_HEADS),
        'norm_final_g': gain(ks[17], (D_MODEL,)),
    }


def reference(x, positions, norm_mix_g, w_in, mla_q_norm_g, mla_kv_norm_g, mla_w_uq, mla_w_uk,
              mla_w_uv, w_branch_a, w_branch_b, w_out, norm_ffn_g, peer_w_q, peer_sub_keys,
              peer_u, peer_v, norm_final_g):
    B, S, _ = x.shape
    splits = [int(c) for c in np.cumsum(IN_SIZES)[:-1]]
    for l in range(DEPTH):
        h = rmsnorm(x, norm_mix_g[l])
        proj = jnp.einsum('bsd,de->bse', h, w_in[l])
        c_q, c_kv, k_rope, dq, dk, dv, iq, ik, iw, gates = jnp.split(proj, splits, axis=-1)
        o_a = mla_branch(c_q, c_kv, k_rope, positions, mla_q_norm_g[l], mla_kv_norm_g[l],
                         mla_w_uq[l], mla_w_uk[l], mla_w_uv[l])
        o_b = dsa_branch(dq, dk, dv, iq, ik, iw, positions)
        gate = jax.nn.sigmoid(gates.astype(jnp.float32)).astype(x.dtype).reshape(B, S, N_BRANCHES, D_MODEL)
        merged = gate[:, :, 0, :] * (o_a @ w_branch_a[l]) + gate[:, :, 1, :] * (o_b @ w_branch_b[l])
        x = x + merged @ w_out[l]
        x = x + peer_ffn(rmsnorm(x, norm_ffn_g[l]), peer_w_q[l], peer_sub_keys[l], peer_u[l], peer_v[l])
    return rmsnorm(x, norm_final_g)
```

```cpp
#include <hip/hip_runtime.h>
#include <cstdio>
#include <cstdint>
#include <cmath>
namespace pg8 {
#define PG8_LAS __attribute__((address_space(3)))
typedef unsigned short bf16_t;
typedef short bf16x8 __attribute__((ext_vector_type(8)));
typedef float f32x4 __attribute__((ext_vector_type(4)));
typedef unsigned u32x4 __attribute__((ext_vector_type(4)));
constexpr int BM = 256, BK = 64, HALF = 128, HTB = HALF * BK * 2  , STAGE_BYTES = 8 * HTB, NXCD = 8, WGM = 8;

__host__ __device__ __forceinline__ int lds_byte(int r, int c) { const int st = (r >> 4) * 2 + (c >> 5), rr = r & 15, cc = c & 31, ob = rr * 64 + cc * 2; return st * 1024 + (ob ^ (((ob >> 9) & 1) << 5)); }
__host__ __device__ __forceinline__ void stage_rc(int b, int& R, int& C) { const int st = b / 1024, sb = b % 1024, swz = sb ^ (((sb >> 9) & 1) << 5); R = (st >> 1) * 16 + swz / 64; C = (st & 1) * 32 + (swz % 64) / 2; }
__host__ __device__ __forceinline__ int perm32(int rho) { const int n = rho >> 4, i = rho & 15; return 8 * (i >> 2) + 4 * n + (i & 3); }

struct Unit { int pm, pn; };
struct Gemm { const bf16_t* A; const bf16_t* Bt; int M, N, K; };

template <class Epi, class Sched, bool ALIGN_EPI = false, bool SP2 = false>
__device__ __forceinline__ void gemm_phase(PG8_LAS unsigned char* lds, const Gemm g, const Sched& S, const Epi& E, const int wid) {
    int lane; asm volatile("v_mbcnt_lo_u32_b32 %0, -1, 0\n\tv_mbcnt_hi_u32_b32 %0, -1, %0" : "=v"(lane)); const int tid = wid * 64 + lane, wr = wid >> 2, wc = wid & 3, fr = lane & 15, fq = lane >> 4;
    const int K = g.K, nt = K / BK;
    unsigned voffA[2], voffB[2];
#pragma unroll
    for (int i = 0; i < 2; ++i) { int R, C; stage_rc(tid * 16 + i * 8192, R, C); const int Rb = Epi::PERM ? ((R & ~31) + perm32(R & 31)) : R;
        voffA[i] = (unsigned)(R * K + C) * 2u; voffB[i] = (unsigned)(Rb * K + C) * 2u; }
    const size_t kstep = (size_t)(BK * 2);
    const size_t hstep = (size_t)HALF * K * 2;
    const size_t tstep = 2 * hstep;
    const unsigned ldsw = (unsigned)wid * 1024u;
    const int aoff = lds_byte(wr * 64 + fr, fq * 8), boff = lds_byte(wc * 32 + fr, fq * 8);
#define PG8_SA(b, h) (((b) * 2 + (h)) * HTB)
#define PG8_SB(b, h) ((4 + (b) * 2 + (h)) * HTB)
#define PG8_STAGE(bufoff, gbase, voff) do { _Pragma("unroll") for (int _i = 0; _i < 2; ++_i) \
        __builtin_amdgcn_global_load_lds((const unsigned*)((const char*)(gbase) + (voff)[_i]), (PG8_LAS unsigned*)(lds + (bufoff) + ldsw + _i * 8192), 16, 0, 0); } while (0)
#define PG8_LDA(dst, b, h) do { _Pragma("unroll") for (int m = 0; m < 4; ++m) _Pragma("unroll") for (int k = 0; k < 2; ++k) dst[m][k] = *(const PG8_LAS bf16x8*)(lds + PG8_SA(b, h) + aoff + m * 2048 + k * 1024); } while (0)
#define PG8_LDB(dst, b, h) do { _Pragma("unroll") for (int n = 0; n < 2; ++n) _Pragma("unroll") for (int k = 0; k < 2; ++k) dst[n][k] = *(const PG8_LAS bf16x8*)(lds + PG8_SB(b, h) + boff + n * 2048 + k * 1024); } while (0)
#define PG8_MMA(ai, bj, At, Bt) do { __builtin_amdgcn_s_setprio(1); _Pragma("unroll") for (int m = 0; m < 4; ++m) _Pragma("unroll") for (int n = 0; n < 2; ++n) _Pragma("unroll") for (int k = 0; k < 2; ++k) \
        acc[ai][bj][m][n] = __builtin_amdgcn_mfma_f32_16x16x32_bf16(Bt[n][k], At[m][k], acc[ai][bj][m][n], 0, 0, 0); __builtin_amdgcn_s_setprio(0); } while (0)
#define PG8_WAIT_V(n) asm volatile("s_waitcnt vmcnt(" #n ")" ::: "memory")
#define PG8_WAIT_L(n) asm volatile("s_waitcnt lgkmcnt(" #n ")" ::: "memory")
#define PG8_BAR __builtin_amdgcn_s_barrier()
#define PG8_SCHED __builtin_amdgcn_sched_barrier(0)
    Unit cur, nxt; int ui = 0;
    if (!S.next(0, cur)) return;
    f32x4 acc[2][2][4][2];
#pragma unroll
    for (int a = 0; a < 2; ++a)
#pragma unroll
        for (int b = 0; b < 2; ++b)
#pragma unroll
            for (int m = 0; m < 4; ++m)
#pragma unroll
                for (int n = 0; n < 2; ++n) acc[a][b][m][n] = (f32x4){0.f, 0.f, 0.f, 0.f};
    bf16x8 At[4][2], B0[2][2], B1[2][2];
    const char* cA = (const char*)g.A + (size_t)cur.pm * tstep; const char* cB = (const char*)g.Bt + (size_t)cur.pn * tstep;
    S.a_ready(cur);
    if constexpr (SP2) {
        PG8_STAGE(PG8_SB(0, 0), cB, voffB); PG8_STAGE(PG8_SB(0, 1), cB + hstep, voffB); PG8_STAGE(PG8_SA(0, 0), cA, voffA); PG8_STAGE(PG8_SA(0, 1), cA + hstep, voffA);
        if (wr == 1) PG8_BAR;
        PG8_WAIT_V(2); PG8_BAR;
        PG8_STAGE(PG8_SB(1, 0), cB + kstep, voffB); PG8_STAGE(PG8_SA(1, 0), cA + kstep, voffA); PG8_STAGE(PG8_SB(1, 1), cB + hstep + kstep, voffB);
        PG8_WAIT_V(6); PG8_BAR;
    } else {
        PG8_STAGE(PG8_SB(0, 0), cB, voffB); PG8_STAGE(PG8_SA(0, 0), cA, voffA); PG8_STAGE(PG8_SB(0, 1), cB + hstep, voffB); PG8_STAGE(PG8_SA(0, 1), cA + hstep, voffA);
        if (wr == 1) PG8_BAR;
        PG8_WAIT_V(4); PG8_BAR;
        PG8_STAGE(PG8_SB(1, 0), cB + kstep, voffB); PG8_STAGE(PG8_SA(1, 0), cA + kstep, voffA); PG8_STAGE(PG8_SB(1, 1), cB + hstep + kstep, voffB);
        PG8_WAIT_V(6); PG8_BAR;
    }
    for (;;) {
        const bool has_next = S.next(ui + 1, nxt);
        const char* nA = has_next ? (const char*)g.A + (size_t)nxt.pm * tstep : cA; const char* nB = has_next ? (const char*)g.Bt + (size_t)nxt.pn * tstep : cB;
        for (int t = 0; t < nt; t += 2) {
            const bool last = (t == nt - 2);
            const char* a1 = cA + (size_t)(t + 1) * kstep;
            const char* a2 = last ? nA : cA + (size_t)(t + 2) * kstep; const char* b2 = last ? nB : cB + (size_t)(t + 2) * kstep;
            const char* a3 = a2 + kstep; const char* b3 = b2 + kstep;
            if (last && has_next) S.a_ready(nxt);
            if constexpr (SP2) {
            PG8_LDB(B0, 0, 0); PG8_LDB(B1, 0, 1); PG8_SCHED; PG8_LDA(At, 0, 0); PG8_STAGE(PG8_SA(1, 1), a1 + hstep, voffA);
            PG8_WAIT_V(8); PG8_WAIT_L(0); PG8_BAR; PG8_MMA(0, 0, At, B0); PG8_MMA(0, 1, At, B1); PG8_BAR; PG8_SCHED;
            PG8_LDA(At, 0, 1); PG8_STAGE(PG8_SB(0, 0), b2, voffB); PG8_STAGE(PG8_SB(0, 1), b2 + hstep, voffB); PG8_STAGE(PG8_SA(0, 0), a2, voffA);
            PG8_WAIT_V(8); PG8_WAIT_L(0); PG8_BAR; PG8_MMA(1, 0, At, B0); PG8_MMA(1, 1, At, B1); PG8_BAR; PG8_SCHED;
            PG8_LDB(B0, 1, 0); PG8_LDB(B1, 1, 1); PG8_SCHED; PG8_LDA(At, 1, 0); PG8_STAGE(PG8_SA(0, 1), a2 + hstep, voffA);
            PG8_WAIT_V(8); PG8_WAIT_L(0); PG8_BAR; PG8_MMA(0, 0, At, B0); PG8_MMA(0, 1, At, B1); PG8_BAR; PG8_SCHED;
            PG8_LDA(At, 1, 1); PG8_STAGE(PG8_SB(1, 0), b3, voffB); PG8_STAGE(PG8_SB(1, 1), b3 + hstep, voffB); PG8_STAGE(PG8_SA(1, 0), a3, voffA);
            PG8_WAIT_V(8); PG8_WAIT_L(0); PG8_BAR; PG8_MMA(1, 0, At, B0); PG8_MMA(1, 1, At, B1); PG8_BAR; PG8_SCHED;
            } else {
            PG8_LDB(B0, 0, 0); PG8_SCHED; PG8_LDA(At, 0, 0); PG8_STAGE(PG8_SA(1, 1), a1 + hstep, voffA);
            PG8_WAIT_L(8); PG8_BAR; PG8_WAIT_L(0); PG8_MMA(0, 0, At, B0); PG8_BAR; PG8_SCHED;
            PG8_LDB(B1, 0, 1); PG8_STAGE(PG8_SB(0, 0), b2, voffB);
            PG8_BAR; PG8_WAIT_L(0); PG8_MMA(0, 1, At, B1); PG8_BAR;
            PG8_LDA(At, 0, 1); PG8_STAGE(PG8_SA(0, 0), a2, voffA);
            PG8_BAR; PG8_WAIT_L(0); PG8_MMA(1, 0, At, B0); PG8_BAR; PG8_SCHED;
            PG8_STAGE(PG8_SB(0, 1), b2 + hstep, voffB);
            PG8_WAIT_V(6); PG8_BAR; PG8_MMA(1, 1, At, B1); PG8_BAR;
            PG8_LDB(B0, 1, 0); PG8_SCHED; PG8_LDA(At, 1, 0); PG8_STAGE(PG8_SA(0, 1), a2 + hstep, voffA);
            PG8_WAIT_L(8); PG8_BAR; PG8_WAIT_L(0); PG8_MMA(0, 0, At, B0); PG8_BAR; PG8_SCHED;
            PG8_LDB(B1, 1, 1); PG8_STAGE(PG8_SB(1, 0), b3, voffB);
            PG8_BAR; PG8_WAIT_L(0); PG8_MMA(0, 1, At, B1); PG8_BAR;
            PG8_LDA(At, 1, 1); PG8_STAGE(PG8_SA(1, 0), a3, voffA);
            PG8_BAR; PG8_WAIT_L(0); PG8_MMA(1, 0, At, B0); PG8_BAR; PG8_SCHED;
            PG8_STAGE(PG8_SB(1, 1), b3 + hstep, voffB);
            PG8_WAIT_V(6); PG8_BAR; PG8_MMA(1, 1, At, B1); PG8_BAR;
            }
        }
        if constexpr (ALIGN_EPI) { if (wr == 0) PG8_BAR; }
        if constexpr (!Epi::AFTER_DRAIN) { E(acc, cur, wr, wc, fr, fq); S.done(cur); }
        if (!has_next) break;
#pragma unroll
        for (int a = 0; a < 2; ++a)
#pragma unroll
            for (int b = 0; b < 2; ++b)
#pragma unroll
                for (int m = 0; m < 4; ++m)
#pragma unroll
                    for (int n = 0; n < 2; ++n) acc[a][b][m][n] = (f32x4){0.f, 0.f, 0.f, 0.f};
        cur = nxt; cA = nA; cB = nB; ++ui;
        if constexpr (ALIGN_EPI) { if (wr == 1) PG8_BAR; }
    }
    PG8_WAIT_V(0);
    if constexpr (!ALIGN_EPI) { if (wr == 0) PG8_BAR; }
    PG8_BAR;
    if constexpr (Epi::AFTER_DRAIN) { E.fused(acc, cur, wr, wc, fr, fq, lds, wid, lane); S.done(cur); }
#undef PG8_SA
#undef PG8_SB
#undef PG8_STAGE
#undef PG8_LDA
#undef PG8_LDB
#undef PG8_MMA
#undef PG8_WAIT_V
#undef PG8_WAIT_L
#undef PG8_BAR
#undef PG8_SCHED
}
}

constexpr int NWAVES = 8;
constexpr int NB = 8, SEQ = 2048, D = 2048, M = NB * SEQ;
constexpr int IN_WIDTH = 7568;
constexpr int N1 = 7680;
constexpr int NEXP = 16384;
constexpr float EPS = 1e-6f;
constexpr float LOG2E = 1.4426950408889634f;
constexpr float MLA_QSCALE = 0.07216878364870322f * LOG2E;
constexpr float DSA_QSCALE = 0.08838834764831845f * LOG2E;

constexpr size_t MiB = 1u << 20;
constexpr size_t WS_CTL = 0, CTL_ZERO_BYTES = 1 * MiB;
constexpr size_t WS_T64 = 1 * MiB;
constexpr size_t WS_T32 = 5 * MiB;
constexpr size_t WS_T16 = 7 * MiB;
constexpr size_t WS_RS  = 8 * MiB;
constexpr size_t WS_MB  = 9 * MiB;
constexpr size_t WS_SC  = 16 * MiB;
constexpr size_t WS_XN  = 18 * MiB;
constexpr size_t WS_OA  = 16 * MiB;
constexpr size_t WS_OB  = 48 * MiB;
constexpr size_t WS_X1B = 16 * MiB;
constexpr size_t WS_WIN = 82 * MiB;
constexpr size_t WS_WUQ = 112 * MiB;
constexpr size_t WS_CKV = 114 * MiB;
constexpr size_t WS_WUK = 122 * MiB;
constexpr size_t WS_WUV = 122 * MiB + 512 * 1024;
constexpr size_t WS_WAB = 123 * MiB;
constexpr size_t WS_WO  = 131 * MiB;
constexpr size_t WS_W2  = 139 * MiB;
constexpr size_t WS_U   = 147 * MiB;
constexpr size_t WS_V   = 211 * MiB;
constexpr size_t WS_CQ  = 275 * MiB;
constexpr size_t WS_DQ  = 291 * MiB;
constexpr size_t WS_DK  = 323 * MiB;
constexpr size_t WS_DVT = 331 * MiB;
constexpr size_t WS_IQ  = 339 * MiB;
constexpr size_t WS_KR  = 371 * MiB;
constexpr size_t WS_IK  = 373 * MiB;
constexpr size_t WS_IW  = 375 * MiB;
constexpr size_t WS_Q   = 376 * MiB;
constexpr size_t WS_KN  = 424 * MiB;
constexpr size_t WS_VT  = 456 * MiB;
constexpr size_t WS_PA  = 275 * MiB;
constexpr size_t WS_MRG = 339 * MiB;
constexpr size_t WS_S   = 275 * MiB;
constexpr size_t WS_END = 488 * MiB;
constexpr int CW_BAR = 4096;

constexpr int RING_OFF = 0, RING_BYTES = 131072;
constexpr int LDSCTL_OFF = RING_BYTES, MISC_OFF = LDSCTL_OFF + 320;
constexpr int LDS_BYTES = 147456;

#define GAS __attribute__((address_space(1)))
#define LAS __attribute__((address_space(3)))
typedef unsigned short bf16;
typedef unsigned v4u __attribute__((ext_vector_type(4)));
typedef unsigned v2u __attribute__((ext_vector_type(2)));
typedef float f32x4 __attribute__((ext_vector_type(4)));
typedef float f32x2 __attribute__((ext_vector_type(2)));
typedef float f32x16 __attribute__((ext_vector_type(16)));
typedef short bf16x8 __attribute__((ext_vector_type(8)));
typedef GAS unsigned gu32;
#define RLX_AGENT __ATOMIC_RELAXED, __HIP_MEMORY_SCOPE_AGENT
#define LDS_WAIT() asm volatile("s_waitcnt lgkmcnt(0)" ::: "memory")
#define VM_WAIT() asm volatile("s_waitcnt vmcnt(0)" ::: "memory")
__device__ __forceinline__ unsigned f2bf(float f) { unsigned u = __builtin_bit_cast(unsigned, f); return (u + 0x7fffu + ((u >> 16) & 1u)) >> 16; }
__device__ __forceinline__ unsigned pk2(float lo, float hi) { unsigned r; asm volatile("v_cvt_pk_bf16_f32 %0, %1, %2" : "=v"(r) : "v"(lo), "v"(hi)); return r; }
__device__ __forceinline__ float bflo(unsigned w) { return __builtin_bit_cast(float, w << 16); }
__device__ __forceinline__ float bfhi(unsigned w) { return __builtin_bit_cast(float, w & 0xffff0000u); }
__device__ __forceinline__ float wave_sum(float v) {
#pragma unroll
    for (int o = 1; o < 64; o <<= 1) v += __shfl_xor(v, o);
    return v;
}
__device__ __forceinline__ int lane_id() { int l; asm volatile("v_mbcnt_lo_u32_b32 %0, -1, 0\n\tv_mbcnt_hi_u32_b32 %0, -1, %0" : "=v"(l)); return l; }
#define XB_TMO      128
#define XB_XCNT(j)  (256  + 64 * (j))
#define XB_XSUB(j)  (1280 + 64 * (j))
#define XB_XGEN(j)  (2304 + 64 * (j))
#define XB_TOP      3328
#define XB_TOPGEN   3392
#define XCD_BAR_WORDS 3456
#define XB_SPIN_CAP (1u << 18)

__device__ __forceinline__ unsigned xb_ld(unsigned* p)              { return __hip_atomic_load(p, __ATOMIC_RELAXED, __HIP_MEMORY_SCOPE_AGENT); }
__device__ __forceinline__ unsigned xb_add(unsigned* p, unsigned v) { return __hip_atomic_fetch_add(p, v, __ATOMIC_RELAXED, __HIP_MEMORY_SCOPE_AGENT); }
__device__ __forceinline__ unsigned xb_xcc_id() { return (unsigned)__builtin_amdgcn_s_getreg((3 << 11) | 20) & 0xFu; }
#define XB_SPIN(cond, bar) do { unsigned _sp = 0; while (cond) { __builtin_amdgcn_s_sleep(1); \
    if ((++_sp & 255u) == 0u) { if (xb_ld(&(bar)[XB_TMO])) break; if (_sp > XB_SPIN_CAP) { atomicAdd(&(bar)[XB_TMO], 1u); break; } } } } while (0)

struct XcdBarrier {
    unsigned* bar; unsigned x;
    volatile LAS unsigned* st;
};

__device__ __forceinline__ XcdBarrier xcd_barrier_post(unsigned* bar, volatile LAS unsigned* st) {
    XcdBarrier b; b.bar = bar; b.x = xb_xcc_id(); b.st = st;
    if (threadIdx.x == 0) (void)xb_add(&bar[XB_XCNT(b.x)], 1u);
    return b;
}
__device__ __forceinline__ void xcd_barrier_complete(unsigned* bar, unsigned x, unsigned& nloc, unsigned& nx) {
    const unsigned G = gridDim.x * gridDim.y * gridDim.z;
    unsigned sum, cnt, mine, sp = 0u;
    for (;;) {
        sum = 0u; cnt = 0u; mine = 0u;
#pragma unroll
        for (unsigned j = 0; j < 16; ++j) { const unsigned c = xb_ld(&bar[XB_XCNT(j)]); sum += c; cnt += (c > 0u) ? 1u : 0u; mine = (j == x) ? c : mine; }
        if (sum == G) break;
        __builtin_amdgcn_s_sleep(1);
        if ((++sp & 255u) == 0u) { if (xb_ld(&bar[XB_TMO])) break; if (sp > XB_SPIN_CAP) { atomicAdd(&bar[XB_TMO], 1u); break; } }
    }
    nloc = mine > 0u ? mine : 1u; nx = cnt > 0u ? cnt : 1u;
}

__device__ __forceinline__ void xcd_barrier(const XcdBarrier& b, const bool leader  ) {
    asm volatile("s_waitcnt vmcnt(0)" ::: "memory");
    __syncthreads();
    if (leader) {
        unsigned* bar = b.bar;
        __builtin_amdgcn_s_waitcnt(0);
        unsigned nloc = b.st[0], nx = b.st[1];
        if (nloc == 0u) { xcd_barrier_complete(bar, b.x, nloc, nx); b.st[0] = nloc; b.st[1] = nx; }
        const unsigned old = xb_add(&bar[XB_XSUB(b.x)], 1u);
        const unsigned gen = old / nloc;
        if (old + 1u == (gen + 1u) * nloc) {
            __builtin_amdgcn_fence(__ATOMIC_RELEASE, "agent");
            asm volatile("s_waitcnt vmcnt(0)" ::: "memory");
            const unsigned og = xb_add(&bar[XB_TOP], 1u);
            const unsigned tg = og / nx;
            if (og + 1u == (tg + 1u) * nx) xb_add(&bar[XB_TOPGEN], 1u);
            else XB_SPIN(xb_ld(&bar[XB_TOPGEN]) == tg, bar);
            __builtin_amdgcn_fence(__ATOMIC_ACQUIRE, "agent");
            xb_add(&bar[XB_XGEN(b.x)], 1u);
            asm volatile("s_waitcnt vmcnt(0)" ::: "memory");
        } else {
            XB_SPIN(xb_ld(&bar[XB_XGEN(b.x)]) == gen, bar);
            __builtin_amdgcn_fence(__ATOMIC_ACQUIRE, "agent");
            asm volatile("s_waitcnt vmcnt(0)" ::: "memory");
        }
    }
    __syncthreads();
}

struct Args {
    const float* x; const int* pos; const float* g_mix; const float* w_in; const float* g_q; const float* g_kv;
    const float* w_uq; const float* w_uk; const float* w_uv; const float* w_a; const float* w_b; const float* w_o;
    const float* g_ffn; const float* w_pq; const float* subk; const float* pu; const float* pv; const float* g_fin;
    float* out; unsigned char* ws;
    double invf[56];
    int ph_lo, ph_hi;
};

__device__ __forceinline__ int src_win(int n) {
    if (n < 768) return n;
    if (n < 2048) { const int r = n - 768, head = r >> 7, j = r & 127; const int sj = j < 32 ? ((j & 1) * 16 + (j >> 1)) : j; return 832 + head * 128 + sj; }
    if (n < 2304) return 2112 + (n - 2048);
    if (n < 3328) { const int r = n - 2304, head = r >> 6, j = r & 63; const int sj = j < 16 ? ((j & 1) * 8 + (j >> 1)) : j; return 2368 + head * 64 + sj; }
    if (n < 3584) { const int r = n - 3328;
        if (r < 64) return 768 + (r & 1) * 32 + (r >> 1);
        if (r < 128) { const int j = r - 64; return 3392 + (j < 16 ? ((j & 1) * 8 + (j >> 1)) : j); }
        if (r < 144) return 3456 + (r - 128);
        return -1; }
    return 3472 + (n - 3584);
}
__device__ __forceinline__ int src_wuq(int n) {
    if (n < 1024) return (n >> 7) * 192 + (n & 127);
    const int r = n - 1024, head = r >> 6, j = r & 63; return head * 192 + 128 + (j & 1) * 32 + (j >> 1);
}
template <int MODE> __device__ __forceinline__ int src_map(int n) { if (MODE == 1) return src_win(n); if (MODE == 2) return src_wuq(n); return n; }

template <int MODE> __device__ __forceinline__ void p0_transpose_item(const float* W, int K, int N, int nblk, bf16* WT, int row_off, LAS float* scr, int item, int lane, const float* kscale) {
    const int kb = item / nblk, nb = item % nblk, k0 = 64 * kb, n0 = 32 * nb;
    const int sc = src_map<MODE>(n0 + (lane & 31));
#pragma unroll 8
    for (int i = 0; i < 32; ++i) { const int kk = 2 * i + (lane >> 5); float v = sc >= 0 ? W[(size_t)(k0 + kk) * N + sc] : 0.f; if (kscale) v *= kscale[k0 + kk]; scr[kk * 33 + (lane & 31)] = v; }
    LDS_WAIT(); asm volatile("" ::: "memory");
    const int c = lane & 7;
#pragma unroll
    for (int j = 0; j < 4; ++j) { const int n = (lane >> 3) + 8 * j; const LAS float* s = scr + (8 * c) * 33 + n;
        v4u o; o.x = pk2(s[0 * 33], s[1 * 33]); o.y = pk2(s[2 * 33], s[3 * 33]); o.z = pk2(s[4 * 33], s[5 * 33]); o.w = pk2(s[6 * 33], s[7 * 33]);
        *(GAS v4u*)(WT + (size_t)(row_off + n0 + n) * K + k0 + 8 * c) = o; }
    LDS_WAIT(); asm volatile("" ::: "memory");
}

__device__ __forceinline__ void p0_w2_item(const Args& a, bf16* W2, LAS float* scr, int item, int lane) {
    const int hp = item >> 6, d0 = (item & 63) * 32;
#pragma unroll 4
    for (int dd = 0; dd < 32; ++dd) scr[dd * 64 + lane] = a.w_pq[(size_t)(d0 + dd) * 1024 + hp * 64 + lane];
    LDS_WAIT(); asm volatile("" ::: "memory");
    for (int pass = 0; pass < 2; ++pass) {
        const int n = lane + 64 * pass;
        const f32x4* skp = (const f32x4*)(a.subk + ((size_t)hp * 128 + n) * 64);
        float acc[32];
#pragma unroll
        for (int i = 0; i < 32; ++i) acc[i] = 0.f;
#pragma unroll 2
        for (int c4 = 0; c4 < 16; ++c4) { const f32x4 sk = skp[c4];
#pragma unroll
            for (int dd = 0; dd < 32; ++dd) { const f32x4 w = *(const LAS f32x4*)(scr + dd * 64 + c4 * 4); acc[dd] += w.x * sk.x + w.y * sk.y + w.z * sk.z + w.w * sk.w; } }
        bf16* o = W2 + (size_t)(hp * 128 + n) * D + d0;
#pragma unroll
        for (int q = 0; q < 4; ++q) { v4u w; const float* g = a.g_ffn + d0 + 8 * q;
            w.x = pk2(acc[8 * q + 0] * g[0], acc[8 * q + 1] * g[1]); w.y = pk2(acc[8 * q + 2] * g[2], acc[8 * q + 3] * g[3]);
            w.z = pk2(acc[8 * q + 4] * g[4], acc[8 * q + 5] * g[5]); w.w = pk2(acc[8 * q + 6] * g[6], acc[8 * q + 7] * g[7]);
            *(GAS v4u*)(o + 8 * q) = w; }
    }
    LDS_WAIT(); asm volatile("" ::: "memory");
}

__device__ __forceinline__ void rms_row_to_bf16(const float* xrow, const float* g, bf16* orow, int lane) {
    f32x4 v[8]; float s = 0.f;
#pragma unroll
    for (int j = 0; j < 4; ++j) { const GAS f32x4* p = (const GAS f32x4*)(xrow + j * 512 + lane * 8); v[2 * j] = p[0]; v[2 * j + 1] = p[1]; }
#pragma unroll
    for (int j = 0; j < 8; ++j) s += (v[j].x * v[j].x + v[j].y * v[j].y) + (v[j].z * v[j].z + v[j].w * v[j].w);
    const float rstd = 1.0f / sqrtf(wave_sum(s) * (1.f / D) + EPS);
#pragma unroll
    for (int j = 0; j < 4; ++j) { const f32x4 g0 = *(const f32x4*)(g + j * 512 + lane * 8), g1 = *(const f32x4*)(g + j * 512 + lane * 8 + 4);
        const f32x4 a0 = v[2 * j] * rstd * g0, a1 = v[2 * j + 1] * rstd * g1;
        v4u w; w.x = pk2(a0.x, a0.y); w.y = pk2(a0.z, a0.w); w.z = pk2(a1.x, a1.y); w.w = pk2(a1.z, a1.w);
        *(GAS v4u*)(orow + j * 512 + lane * 8) = w; }
}
__device__ __forceinline__ void cvt_row_to_bf16(const float* xrow, bf16* orow, int lane) {
#pragma unroll
    for (int j = 0; j < 4; ++j) { const GAS f32x4* p = (const GAS f32x4*)(xrow + j * 512 + lane * 8); const f32x4 a0 = __builtin_nontemporal_load(p), a1 = __builtin_nontemporal_load(p + 1);
        v4u w; w.x = pk2(a0.x, a0.y); w.y = pk2(a0.z, a0.w); w.z = pk2(a1.x, a1.y); w.w = pk2(a1.z, a1.w);
        *(GAS v4u*)(orow + j * 512 + lane * 8) = w; }
}

__device__ __forceinline__ void p0_prologue(const Args& a, LAS unsigned char* lds, int vcu, int G, int wave, int lane) {
    unsigned char* ws = a.ws;
    LAS float* scr = (LAS float*)(lds + RING_OFF + wave * 16384);
    const int gw = vcu * NWAVES + wave, NGW = G * NWAVES;
    constexpr int I_WIN = 32 * 240, I_WUQ = 8 * 48, I_WUK = 4 * 32, I_WUV = 4 * 32, I_WA = 16 * 64, I_WB = 16 * 64, I_WO = 32 * 64, I_W2 = 1024;
    constexpr int NITEMS = I_WIN + I_WUQ + I_WUK + I_WUV + I_WA + I_WB + I_WO + I_W2;
    for (int it = gw; it < NITEMS; it += NGW) {
        int r = it;
        if (r < I_WIN) { p0_transpose_item<1>(a.w_in, D, IN_WIDTH, 240, (bf16*)(ws + WS_WIN), 0, scr, r, lane, nullptr); continue; } r -= I_WIN;
        if (r < I_WUQ) { p0_transpose_item<2>(a.w_uq, 512, 1536, 48, (bf16*)(ws + WS_WUQ), 0, scr, r, lane, a.g_q); continue; } r -= I_WUQ;
        if (r < I_WUK) { p0_transpose_item<0>(a.w_uk, 256, 1024, 32, (bf16*)(ws + WS_WUK), 0, scr, r, lane, a.g_kv); continue; } r -= I_WUK;
        if (r < I_WUV) { p0_transpose_item<0>(a.w_uv, 256, 1024, 32, (bf16*)(ws + WS_WUV), 0, scr, r, lane, a.g_kv); continue; } r -= I_WUV;
        if (r < I_WA) { p0_transpose_item<0>(a.w_a, 1024, 2048, 64, (bf16*)(ws + WS_WAB), 0, scr, r, lane, nullptr); continue; } r -= I_WA;
        if (r < I_WB) { p0_transpose_item<0>(a.w_b, 1024, 2048, 64, (bf16*)(ws + WS_WAB), 2048, scr, r, lane, nullptr); continue; } r -= I_WB;
        if (r < I_WO) { p0_transpose_item<0>(a.w_o, 2048, 2048, 64, (bf16*)(ws + WS_WO), 0, scr, r, lane, nullptr); continue; } r -= I_WO;
        p0_w2_item(a, (bf16*)(ws + WS_W2), scr, r, lane);
    }
    for (int m = gw; m < M; m += NGW) rms_row_to_bf16(a.x + (size_t)m * D, a.g_mix, (bf16*)(ws + WS_XN) + (size_t)m * D, lane);
    for (int m = gw; m < 2 * NEXP; m += NGW) { const int e = m & (NEXP - 1);
        if (m < NEXP) cvt_row_to_bf16(a.pu + (size_t)e * D, (bf16*)(ws + WS_U) + (size_t)e * D, lane);
        else cvt_row_to_bf16(a.pv + (size_t)e * D, (bf16*)(ws + WS_V) + (size_t)e * D, lane); }
    const int gt = gw * 64 + lane, NGT = NGW * 64;
    for (int idx = gt; idx < M * 56; idx += NGT) {
        const int t = idx / 56, i = idx - t * 56;
        const double ang = (double)a.pos[t] * a.invf[i];
        double rev = ang * 0.15915494309189535; rev -= __builtin_rint(rev);
        const float r = (float)(rev * 6.283185307179586);
        const float c = cosf(r), s = sinf(r);
        f32x2* dst = i < 32 ? (f32x2*)(ws + WS_T64) + (size_t)t * 32 + i : i < 48 ? (f32x2*)(ws + WS_T32) + (size_t)t * 16 + (i - 32) : (f32x2*)(ws + WS_T16) + (size_t)t * 8 + (i - 48);
        *dst = (f32x2){c, s};
    }
}

template <int KIND> struct Order {
    int nM, nN, nwg, G, c;
    __device__ void init(int nM_, int nN_, int G_, int c_) { nM = nM_; nN = nN_; nwg = nM * nN; G = G_; c = c_; }
    __device__ bool next(int i, pg8::Unit& u) const {
        const int ii = (KIND == 3) ? (i >> 1) : i;
        const long L = (long)ii * G + c; if (L >= nwg) return false;
        int wgid = (int)L; { const int q = nwg / 8, r = nwg % 8, xcd = wgid % 8, off = wgid / 8; wgid = (xcd < r ? xcd * (q + 1) : r * (q + 1) + (xcd - r) * q) + off; }
        const int nig = 8 * nN, gid = wgid / nig, fm = gid * 8, gsz = (nM - fm) < 8 ? (nM - fm) : 8;
        const int pm = fm + ((wgid % nig) % gsz), vn = (wgid % nig) / gsz;
        if (KIND == 0) { u.pm = pm; u.pn = vn; }
        if (KIND == 1) { if (vn == 8) { u.pm = 72; u.pn = pm; } else { u.pm = pm; u.pn = 64 + vn; } }
        if (KIND == 2) { if (vn >= 4) { u.pm = 64 + vn; u.pn = pm; } else { u.pm = pm; u.pn = 64 + vn; } }
        if (KIND == 3) { const int br = i & 1; u.pm = pm + 64 * br; u.pn = vn + 8 * br; }
        return true;
    }
    __device__ __forceinline__ void a_ready(const pg8::Unit&) const {}
    __device__ __forceinline__ void done(const pg8::Unit&) const {}
};

__device__ __forceinline__ void st8bf(bf16* p, f32x4 a, f32x4 b) { v4u w; w.x = pk2(a.x, a.y); w.y = pk2(a.z, a.w); w.z = pk2(b.x, b.y); w.w = pk2(b.z, b.w); *(GAS v4u*)p = w; }
__device__ __forceinline__ void rope8(f32x4& a, f32x4& b, const float* tab) {
    const f32x4 t0 = *(const f32x4*)tab, t1 = *(const f32x4*)(tab + 4);
    const f32x4 ra = {a.x * t0.x - a.y * t0.y, a.y * t0.x + a.x * t0.y, a.z * t0.z - a.w * t0.w, a.w * t0.z + a.z * t0.w};
    const f32x4 rb = {b.x * t1.x - b.y * t1.y, b.y * t1.x + b.x * t1.y, b.z * t1.z - b.w * t1.w, b.w * t1.z + b.z * t1.w};
    a = ra; b = rb;
}
__device__ __forceinline__ void st8_vt(bf16* rowp, int tk0, f32x4 a, f32x4 b) {
    bf16* p = rowp + (tk0 & ~15) + 4 * ((tk0 >> 3) & 1);
    v2u w0, w1; w0.x = pk2(a.x, a.y); w0.y = pk2(a.z, a.w); w1.x = pk2(b.x, b.y); w1.y = pk2(b.z, b.w);
    *(GAS v2u*)p = w0; *(GAS v2u*)(p + 8) = w1;
}
#define EPI_FOR _Pragma("unroll") for (int ai = 0; ai < 2; ++ai) _Pragma("unroll") for (int m = 0; m < 4; ++m) _Pragma("unroll") for (int bj = 0; bj < 2; ++bj)
#define EPI_VARS asm volatile("" ::: "memory"); const int rl = 128 * ai + 64 * wr + 16 * m + fr, lc = 128 * bj + 32 * wc + 8 * fq; f32x4 v0 = acc[ai][bj][m][0], v1 = acc[ai][bj][m][1]; (void)rl; (void)lc;

struct Epi1 {
    static constexpr bool PERM = true, AFTER_DRAIN = false;
    unsigned char* ws; bf16* G;
    __device__ __forceinline__ void operator()(const f32x4 (&acc)[2][2][4][2], const pg8::Unit& u, int wr, int wc, int fr_, int fq_) const {
        int fr = fr_, fq = fq_; asm volatile("" : "+v"(fr), "+v"(fq));
        if (u.pm >= 64) {
            bf16* DVT = (bf16*)(ws + WS_DVT);
            EPI_FOR { EPI_VARS st8_vt(DVT + (size_t)rl * M, u.pn * 256 + lc, v0, v1); }
            return;
        }
        const int ct = u.pn - 64; const size_t row0 = (size_t)u.pm * 256;
        if (ct < 2) { bf16* O = (bf16*)(ws + WS_CQ); EPI_FOR { EPI_VARS st8bf(O + (row0 + rl) * 512 + ct * 256 + lc, v0, v1); } }
        else if (ct == 2) { bf16* O = (bf16*)(ws + WS_CKV); EPI_FOR { EPI_VARS st8bf(O + (row0 + rl) * 256 + lc, v0, v1); } }
        else if (ct < 7) { bf16* O = (bf16*)(ws + WS_DQ); const float* T = (const float*)(ws + WS_T32);
            EPI_FOR { EPI_VARS const int gc = (ct - 3) * 256 + lc, j = gc & 127; const size_t row = row0 + rl;
                if (j < 32) rope8(v0, v1, T + row * 32 + j);
                st8bf(O + row * 1024 + gc, v0 * DSA_QSCALE, v1 * DSA_QSCALE); } }
        else if (ct == 7) { bf16* O = (bf16*)(ws + WS_DK); const float* T = (const float*)(ws + WS_T32);
            EPI_FOR { EPI_VARS const int j = lc & 127; const size_t row = row0 + rl;
                if (j < 32) rope8(v0, v1, T + row * 32 + j);
                st8bf(O + row * 256 + lc, v0, v1); } }
        else if (ct < 13) { bf16* O = (bf16*)(ws + WS_IQ); const float* T = (const float*)(ws + WS_T16);
            EPI_FOR { EPI_VARS const int gc = (ct - 9) * 256 + lc, j = gc & 63; const size_t row = row0 + rl;
                if (j < 16) rope8(v0, v1, T + row * 16 + j);
                st8bf(O + row * 1024 + gc, v0, v1); } }
        else if (ct == 13) {
            EPI_FOR { EPI_VARS const size_t row = row0 + rl;
                if (lc < 64) { rope8(v0, v1, (const float*)(ws + WS_T64) + row * 64 + lc); st8bf((bf16*)(ws + WS_KR) + row * 64 + lc, v0, v1); }
                else if (lc < 128) { const int j = lc - 64; if (j < 16) rope8(v0, v1, (const float*)(ws + WS_T16) + row * 16 + j); st8bf((bf16*)(ws + WS_IK) + row * 64 + j, v0, v1); }
                else if (lc < 144) { float* o = (float*)(ws + WS_IW) + row * 16 + (lc - 128); *(GAS f32x4*)o = v0 * 0.03125f; *(GAS f32x4*)(o + 4) = v1 * 0.03125f; } } }
        else {
            EPI_FOR { EPI_VARS const int gc = (ct - 14) * 256 + lc; const size_t row = row0 + rl;
                f32x4 s0, s1;
#pragma unroll
                for (int e = 0; e < 4; ++e) { s0[e] = __builtin_amdgcn_rcpf(1.f + __expf(-v0[e])); s1[e] = __builtin_amdgcn_rcpf(1.f + __expf(-v1[e])); }
                st8bf(G + row * 4096 + gc, s0, s1); } }
    }
};

struct Epi3q {
    static constexpr bool PERM = true, AFTER_DRAIN = false;
    unsigned char* ws;
    __device__ __forceinline__ void operator()(const f32x4 (&acc)[2][2][4][2], const pg8::Unit& u, int wr, int wc, int fr_, int fq_) const {
        int fr = fr_, fq = fq_; asm volatile("" : "+v"(fr), "+v"(fq));
        bf16* Q = (bf16*)(ws + WS_Q); const float* RSQ = (const float*)(ws + WS_RS); const float* T = (const float*)(ws + WS_T64);
        const size_t row0 = (size_t)u.pm * 256;
        EPI_FOR { EPI_VARS const size_t row = row0 + rl; const float sc = RSQ[row] * MLA_QSCALE; v0 = v0 * sc; v1 = v1 * sc;
            if (u.pn < 4) { const int gc = u.pn * 256 + lc; st8bf(Q + row * 1536 + (gc >> 7) * 192 + (gc & 127), v0, v1); }
            else { const int r = (u.pn - 4) * 256 + lc, j = r & 63; rope8(v0, v1, T + row * 64 + j); st8bf(Q + row * 1536 + (r >> 6) * 192 + 128 + j, v0, v1); } }
    }
};
struct Epi3k {
    static constexpr bool PERM = true, AFTER_DRAIN = false;
    unsigned char* ws;
    __device__ __forceinline__ void operator()(const f32x4 (&acc)[2][2][4][2], const pg8::Unit& u, int wr, int wc, int fr_, int fq_) const {
        int fr = fr_, fq = fq_; asm volatile("" : "+v"(fr), "+v"(fq));
        const float* RSK = (const float*)(ws + WS_RS) + M;
        if (u.pm >= 64) { bf16* VT = (bf16*)(ws + WS_VT); const int vt = u.pm - 68;
            EPI_FOR { EPI_VARS const int tk0 = u.pn * 256 + lc; const f32x4 r0 = *(const f32x4*)(RSK + tk0), r1 = *(const f32x4*)(RSK + tk0 + 4);
                st8_vt(VT + (size_t)(vt * 256 + rl) * M, tk0, v0 * r0, v1 * r1); }
            return; }
        bf16* KN = (bf16*)(ws + WS_KN); const int ct = u.pn - 64; const size_t row0 = (size_t)u.pm * 256;
        EPI_FOR { EPI_VARS const size_t row = row0 + rl; const float sc = RSK[row]; st8bf(KN + row * 1024 + ct * 256 + lc, v0 * sc, v1 * sc); }
    }
};
struct Epi5 {
    static constexpr bool PERM = true, AFTER_DRAIN = false;
    unsigned char* ws; const bf16* G;
    __device__ __forceinline__ void operator()(const f32x4 (&acc)[2][2][4][2], const pg8::Unit& u, int wr, int wc, int fr_, int fq_) const {
        int fr = fr_, fq = fq_; asm volatile("" : "+v"(fr), "+v"(fq));
        bf16* PA = (bf16*)(ws + WS_PA); bf16* MRG = (bf16*)(ws + WS_MRG);
        const size_t row0 = (size_t)(u.pm & 63) * 256; const int col0 = (u.pn & 7) * 256;
#ifdef DBG_ZERO_MLA
        if (u.pm < 64) { EPI_FOR { EPI_VARS st8bf(PA + (row0 + rl) * 2048 + col0 + lc, v0 * 0.f, v1 * 0.f); } return; }
#else
        if (u.pm < 64) { EPI_FOR { EPI_VARS st8bf(PA + (row0 + rl) * 2048 + col0 + lc, v0, v1); } return; }
#endif
        EPI_FOR { EPI_VARS const size_t row = row0 + rl; const int col = col0 + lc;
            const v4u ga = *(const GAS v4u*)(G + row * 4096 + col), gb = *(const GAS v4u*)(G + row * 4096 + 2048 + col), pa = *(const GAS v4u*)(PA + row * 2048 + col);
            f32x4 o0, o1;
#ifdef DBG_ZERO_DSA
            v0 = v0 * 0.f; v1 = v1 * 0.f;
#endif
            o0.x = bflo(ga.x) * bflo(pa.x) + bflo(gb.x) * v0.x; o0.y = bfhi(ga.x) * bfhi(pa.x) + bfhi(gb.x) * v0.y;
            o0.z = bflo(ga.y) * bflo(pa.y) + bflo(gb.y) * v0.z; o0.w = bfhi(ga.y) * bfhi(pa.y) + bfhi(gb.y) * v0.w;
            o1.x = bflo(ga.z) * bflo(pa.z) + bflo(gb.z) * v1.x; o1.y = bfhi(ga.z) * bfhi(pa.z) + bfhi(gb.z) * v1.y;
            o1.z = bflo(ga.w) * bflo(pa.w) + bflo(gb.w) * v1.z; o1.w = bfhi(ga.w) * bfhi(pa.w) + bfhi(gb.w) * v1.w;
            st8bf(MRG + row * 2048 + col, o0, o1); }
    }
};
struct Epi6 {
    static constexpr bool PERM = true, AFTER_DRAIN = false;
    unsigned char* ws; const float* x; float* out;
    __device__ __forceinline__ void operator()(const f32x4 (&acc)[2][2][4][2], const pg8::Unit& u, int wr, int wc, int fr_, int fq_) const {
        int fr = fr_, fq = fq_; asm volatile("" : "+v"(fr), "+v"(fq));
        bf16* X1B = (bf16*)(ws + WS_X1B);
        EPI_FOR { EPI_VARS const size_t off = ((size_t)u.pm * 256 + rl) * 2048 + u.pn * 256 + lc;
            const f32x4 a = *(const GAS f32x4*)(x + off) + v0, b = *(const GAS f32x4*)(x + off + 4) + v1;
            *(GAS f32x4*)(out + off) = a; *(GAS f32x4*)(out + off + 4) = b; st8bf(X1B + off, a, b); }
    }
};
struct Epi7 {
    static constexpr bool PERM = true, AFTER_DRAIN = false;
    unsigned char* ws;
    __device__ __forceinline__ void operator()(const f32x4 (&acc)[2][2][4][2], const pg8::Unit& u, int wr, int wc, int fr_, int fq_) const {
        int fr = fr_, fq = fq_; asm volatile("" : "+v"(fr), "+v"(fq));
        float* S = (float*)(ws + WS_S);
        EPI_FOR { EPI_VARS const size_t off = ((size_t)u.pm * 256 + rl) * 2048 + u.pn * 256 + lc;
            *(GAS f32x4*)(S + off) = v0; *(GAS f32x4*)(S + off + 4) = v1; }
    }
};

__device__ __forceinline__ void p2_rowstats(unsigned char* ws, int vcu, int G, int wave, int lane) {
    const bf16* CQ = (const bf16*)(ws + WS_CQ); const bf16* CKV = (const bf16*)(ws + WS_CKV); float* RS = (float*)(ws + WS_RS);
    const int gw = vcu * NWAVES + wave, NGW = G * NWAVES;
    for (int m = gw; m < M; m += NGW) {
        const v4u q = *(const GAS v4u*)(CQ + (size_t)m * 512 + lane * 8); const v2u k = *(const GAS v2u*)(CKV + (size_t)m * 256 + lane * 4);
        float sq = 0.f, sk = 0.f;
#pragma unroll
        for (int e = 0; e < 4; ++e) { const float a = bflo(q[e]), b = bfhi(q[e]); sq += a * a + b * b; }
#pragma unroll
        for (int e = 0; e < 2; ++e) { const float a = bflo(k[e]), b = bfhi(k[e]); sk += a * a + b * b; }
        sq = wave_sum(sq); sk = wave_sum(sk);
        if (lane == 0) { RS[m] = 1.0f / sqrtf(sq * (1.f / 512.f) + EPS); RS[M + m] = 1.0f / sqrtf(sk * (1.f / 256.f) + EPS); }
    }
}
__device__ __forceinline__ size_t sc_base(int b, int c) { return (size_t)b * 2162688u + (size_t)2048 * c * (c + 1); }
__device__ __forceinline__ void idx_segment(unsigned char* ws, LAS unsigned char* lds, int b, int c, int k0, int k1, int wave, int lane, int tid) {
    const bf16* IQ = (const bf16*)(ws + WS_IQ); const bf16* IK = (const bf16*)(ws + WS_IK); const float* IW = (const float*)(ws + WS_IW); float* SC = (float*)(ws + WS_SC);
    const int t0 = b * SEQ + 64 * c, r = lane & 31, hk = lane >> 5;
    bf16x8 af[4][4]; f32x4 wv[4][4];
#pragma unroll
    for (int rt = 0; rt < 4; ++rt) {
        const int tq = t0 + 8 * wave + 2 * rt + ((r >> 2) & 1), hh = (r & 3) + 4 * (r >> 3);
#pragma unroll
        for (int ks = 0; ks < 4; ++ks) af[rt][ks] = *(const GAS bf16x8*)(IQ + (size_t)tq * 1024 + hh * 64 + 16 * ks + 8 * hk);
        const int tw = t0 + 8 * wave + 2 * rt + hk;
#pragma unroll
        for (int q4 = 0; q4 < 4; ++q4) wv[rt][q4] = *(const GAS f32x4*)(IW + (size_t)tw * 16 + 4 * q4);
    }
    const int skey = tid >> 3, sch = tid & 7;
    const bf16* src = IK + ((size_t)b * SEQ + skey) * 64 + sch * 8;
    const int sdst = skey * 144 + sch * 16;
    const int nrow = 64 * (c + 1);
    float* scrow = SC + sc_base(b, c);
    { const v4u t = *(const GAS v4u*)(src + (size_t)k0 * 64 * 64); *(LAS v4u*)(lds + sdst) = t; }
    __syncthreads();
    for (int kt = k0; kt < k1; ++kt) {
        const int cur = (kt - k0) & 1; v4u nx = {0u, 0u, 0u, 0u};
        if (kt + 1 < k1) nx = *(const GAS v4u*)(src + (size_t)(kt + 1) * 64 * 64);
        const LAS unsigned char* kb = lds + cur * 9216;
#pragma unroll
        for (int kh = 0; kh < 2; ++kh) {
            bf16x8 bfr[4];
#pragma unroll
            for (int ks = 0; ks < 4; ++ks) bfr[ks] = *(const LAS bf16x8*)(kb + (32 * kh + r) * 144 + (16 * ks + 8 * hk) * 2);
#pragma unroll
            for (int rt = 0; rt < 4; ++rt) {
                f32x16 cc;
#pragma unroll
                for (int e = 0; e < 16; ++e) cc[e] = 0.f;
#pragma unroll
                for (int ks = 0; ks < 4; ++ks) cc = __builtin_amdgcn_mfma_f32_32x32x16_bf16(af[rt][ks], bfr[ks], cc, 0, 0, 0);
                float s = 0.f;
#pragma unroll
                for (int e = 0; e < 16; ++e) s += wv[rt][e >> 2][e & 3] * fmaxf(cc[e], 0.f);
                scrow[(size_t)(8 * wave + 2 * rt + hk) * nrow + 64 * kt + 32 * kh + r] = s;
            }
        }
        if (kt + 1 < k1) *(LAS v4u*)(lds + (cur ^ 1) * 9216 + sdst) = nx;
        __syncthreads();
    }
}
__device__ __forceinline__ void p2_indexer(unsigned char* ws, LAS unsigned char* lds, int bx, int G, int wave, int lane) {
    const int tid = wave * 64 + lane;
    for (int i = bx; i < 256; i += G) {
        const int p = i >> 1, b = p >> 4, c = p & 15;
        if ((i & 1) == 0) { idx_segment(ws, lds, b, c, 0, c + 1, wave, lane, tid); idx_segment(ws, lds, b, 31 - c, 0, 16 - c, wave, lane, tid); }
        else idx_segment(ws, lds, b, 31 - c, 16 - c, 32 - c, wave, lane, tid);
    }
}

__device__ __forceinline__ int wave_sum_i(int v) {
#pragma unroll
    for (int o = 1; o < 64; o <<= 1) v += __shfl_xor(v, o);
    return v;
}
__device__ __forceinline__ void p3_select(unsigned char* ws, int vcu, int G, int wave, int lane) {
    const float* SC = (const float*)(ws + WS_SC); unsigned* MB = (unsigned*)(ws + WS_MB);
    const int gw = vcu * NWAVES + wave, NGW = G * NWAVES;
    for (int m = gw; m < M; m += NGW) {
        const int b = m >> 11, c = (m & 2047) >> 6, qi = m & 63, n = 64 * (c + 1), nw = n >> 5;
        if (n <= 256) { MB[(size_t)m * 64 + lane] = lane < nw ? 0xffffffffu : 0u; continue; }
        unsigned key[32];
        const float* row = SC + sc_base(b, c) + (size_t)qi * n + lane * 32;
        const bool act = lane < nw;
#pragma unroll
        for (int q = 0; q < 8; ++q) { f32x4 t = {0.f, 0.f, 0.f, 0.f}; if (act) t = *(const GAS f32x4*)(row + 4 * q);
#pragma unroll
            for (int e = 0; e < 4; ++e) { const unsigned u = __builtin_bit_cast(unsigned, t[e] + 0.0f); key[4 * q + e] = act ? (u ^ ((u >> 31) ? 0xffffffffu : 0x80000000u)) : 0u; } }
        unsigned prefix = 0u;
        for (int bit = 31; bit >= 0; --bit) {
            const unsigned cand = prefix | (1u << bit); int cnt = 0;
#pragma unroll
            for (int i = 0; i < 32; ++i) cnt += (key[i] >= cand) ? 1 : 0;
            if (wave_sum_i(cnt) >= 256) prefix = cand;
        }
        int gt = 0, eq = 0;
#pragma unroll
        for (int i = 0; i < 32; ++i) { gt += (key[i] > prefix) ? 1 : 0; eq += (key[i] == prefix) ? 1 : 0; }
        const int need = 256 - wave_sum_i(gt);
        int pe = eq;
#pragma unroll
        for (int o = 1; o < 64; o <<= 1) { const int t = __shfl_up(pe, o); if (lane >= o) pe += t; }
        int rk = pe - eq; unsigned word = 0u;
#pragma unroll
        for (int i = 0; i < 32; ++i) { const bool e = key[i] == prefix; const bool sel = (key[i] > prefix) || (e && rk < need); rk += e ? 1 : 0; word |= sel ? (1u << i) : 0u; }
        MB[(size_t)m * 64 + lane] = word;
    }
}

template <bool DSA> struct AttnCfg {
    static constexpr int DQK = DSA ? 128 : 192, NKS = DQK / 16, KSTR = DQK * 2 + 16, KBUF = 64 * KSTR, VSTR = 144, VBUF = 128 * VSTR, BUF = KBUF + VBUF;
    static constexpr int NKCH = DQK / 8, NKLD = 64 * NKCH / 512;
};
template <bool DSA>
__device__ __forceinline__ void attn_unit(unsigned char* ws, LAS unsigned char* lds, int b, int hh  , int blk  , int wave, int lane, int tid) {
    typedef AttnCfg<DSA> C;
    const int r = lane & 31, hk = lane >> 5;
    const int head = DSA ? 4 * hh + (wave >> 1) : hh;
    const int tok0 = DSA ? b * SEQ + 64 * blk + 32 * (wave & 1) : b * SEQ + 256 * blk + 32 * wave;
    const int ntw = DSA ? blk + 1 : 4 * blk + (wave >> 1) + 1;
    const int ntb = DSA ? blk + 1 : 4 * blk + 4;
    const bf16* Qp = DSA ? (const bf16*)(ws + WS_DQ) + (size_t)(tok0 + r) * 1024 + head * 128 : (const bf16*)(ws + WS_Q) + (size_t)(tok0 + r) * 1536 + head * 192;
    bf16x8 qf[C::NKS];
#pragma unroll
    for (int ks = 0; ks < C::NKS; ++ks) qf[ks] = *(const GAS bf16x8*)(Qp + 16 * ks + 8 * hk);
    const int skey = tid >> 3, sub = tid & 7;
    const bf16* ksrc0 = DSA ? (const bf16*)(ws + WS_DK) + ((size_t)b * SEQ + skey) * 256 + hh * 128 + sub * 8 : (const bf16*)(ws + WS_KN) + ((size_t)b * SEQ + skey) * 1024 + hh * 128 + sub * 8;
    const bf16* ksrc2 = (const bf16*)(ws + WS_KR) + ((size_t)b * SEQ + skey) * 64 + sub * 8;
    const int kdst = skey * C::KSTR + sub * 16;
    constexpr int KADV0 = DSA ? 64 * 256 : 64 * 1024, KADV2 = 64 * 64;
    const bf16* vsrc = (DSA ? (const bf16*)(ws + WS_DVT) : (const bf16*)(ws + WS_VT)) + (size_t)(hh * 128 + skey) * M + (size_t)b * SEQ + sub * 8;
    const int vdst = C::KBUF + skey * C::VSTR + sub * 16;
    v4u kreg[C::NKLD], vreg[2];
#define ATT_LOAD(kt_) do { kreg[0] = *(const GAS v4u*)(ksrc0 + (size_t)(kt_) * KADV0); kreg[1] = *(const GAS v4u*)(ksrc0 + (size_t)(kt_) * KADV0 + 64); \
        if (!DSA) kreg[C::NKLD - 1] = *(const GAS v4u*)(ksrc2 + (size_t)(kt_) * KADV2); \
        vreg[0] = *(const GAS v4u*)(vsrc + (size_t)(kt_) * 64); vreg[1] = *(const GAS v4u*)(vsrc + (size_t)64 * M + (size_t)(kt_) * 64); } while (0)
#define ATT_STORE(buf_) do { LAS unsigned char* bb_ = lds + (buf_) * C::BUF; *(LAS v4u*)(bb_ + kdst) = kreg[0]; *(LAS v4u*)(bb_ + kdst + 128) = kreg[1]; \
        if (!DSA) *(LAS v4u*)(bb_ + kdst + 256) = kreg[C::NKLD - 1]; \
        *(LAS v4u*)(bb_ + vdst) = vreg[0]; *(LAS v4u*)(bb_ + vdst + 64 * C::VSTR) = vreg[1]; } while (0)
    ATT_LOAD(0); ATT_STORE(0);
    __syncthreads();
    f32x16 o[4];
#pragma unroll
    for (int dt = 0; dt < 4; ++dt)
#pragma unroll
        for (int e = 0; e < 16; ++e) o[dt][e] = 0.f;
    float mrun = -1e30f, lrun = 0.f;
    const unsigned long long* mbp = (const unsigned long long*)((const unsigned*)(ws + WS_MB) + (size_t)(tok0 + r) * 64);
    for (int kt = 0; kt < ntb; ++kt) {
        const int cur = kt & 1;
        if (kt + 1 < ntb) ATT_LOAD(kt + 1);
        if (kt < ntw) {
            const LAS unsigned char* kb = lds + cur * C::BUF; const LAS unsigned char* vb = kb + C::KBUF;
            f32x16 st[2];
#pragma unroll
            for (int kh = 0; kh < 2; ++kh) {
                asm volatile("" ::: "memory");
#pragma unroll
                for (int e = 0; e < 16; ++e) st[kh][e] = 0.f;
#pragma unroll
                for (int ks = 0; ks < C::NKS; ++ks) { if ((ks & 3) == 0 && ks) asm volatile("" ::: "memory"); const bf16x8 kf = *(const LAS bf16x8*)(kb + (32 * kh + r) * C::KSTR + (16 * ks + 8 * hk) * 2);
                    st[kh] = __builtin_amdgcn_mfma_f32_32x32x16_bf16(kf, qf[ks], st[kh], 0, 0, 0); }
            }
            if (DSA) {
                const unsigned long long w = mbp[kt];
                const unsigned w0 = (unsigned)w >> (4 * hk), w1 = (unsigned)(w >> 32) >> (4 * hk);
#pragma unroll
                for (int e = 0; e < 16; ++e) { const int cb = (e & 3) + 8 * (e >> 2);
                    st[0][e] = ((w0 >> cb) & 1u) ? st[0][e] : -__builtin_inff(); st[1][e] = ((w1 >> cb) & 1u) ? st[1][e] : -__builtin_inff(); }
            }
            float mx = st[0][0];
#pragma unroll
            for (int e = 1; e < 16; ++e) mx = fmaxf(mx, st[0][e]);
#pragma unroll
            for (int e = 0; e < 16; ++e) mx = fmaxf(mx, st[1][e]);
            mx = fmaxf(mx, __shfl_xor(mx, 32));
            const float mnew = fmaxf(mrun, mx), alpha = __builtin_amdgcn_exp2f(mrun - mnew);
            mrun = mnew;
            float ps = 0.f;
#pragma unroll
            for (int kh = 0; kh < 2; ++kh)
#pragma unroll
                for (int e = 0; e < 16; ++e) { st[kh][e] = __builtin_amdgcn_exp2f(st[kh][e] - mnew); ps += st[kh][e]; }
            ps += __shfl_xor(ps, 32);
            lrun = lrun * alpha + ps;
#pragma unroll
            for (int dt = 0; dt < 4; ++dt)
#pragma unroll
                for (int e = 0; e < 16; ++e) o[dt][e] *= alpha;
            bf16x8 pf[4];
#pragma unroll
            for (int s = 0; s < 4; ++s) { const int kh = s >> 1, e0 = 8 * (s & 1); v4u w;
                w.x = pk2(st[kh][e0], st[kh][e0 + 1]); w.y = pk2(st[kh][e0 + 2], st[kh][e0 + 3]); w.z = pk2(st[kh][e0 + 4], st[kh][e0 + 5]); w.w = pk2(st[kh][e0 + 6], st[kh][e0 + 7]);
                pf[s] = __builtin_bit_cast(bf16x8, w); }
#pragma unroll
            for (int dt = 0; dt < 4; ++dt) {
                asm volatile("" ::: "memory");
#pragma unroll
                for (int s = 0; s < 4; ++s) { const bf16x8 vf = *(const LAS bf16x8*)(vb + (32 * dt + r) * C::VSTR + (16 * s + 8 * hk) * 2);
                    o[dt] = __builtin_amdgcn_mfma_f32_32x32x16_bf16(vf, pf[s], o[dt], 0, 0, 0); } }
        }
        if (kt + 1 < ntb) ATT_STORE(cur ^ 1);
        __syncthreads();
    }
    const float inv = 1.0f / lrun;
    bf16* Op = (DSA ? (bf16*)(ws + WS_OB) : (bf16*)(ws + WS_OA)) + (size_t)(tok0 + r) * 1024 + head * 128 + 4 * hk;
#pragma unroll
    for (int dt = 0; dt < 4; ++dt)
#pragma unroll
        for (int g = 0; g < 4; ++g) { v2u w; w.x = pk2(o[dt][4 * g] * inv, o[dt][4 * g + 1] * inv); w.y = pk2(o[dt][4 * g + 2] * inv, o[dt][4 * g + 3] * inv);
            *(GAS v2u*)(Op + 32 * dt + 8 * g) = w; }
}
#undef ATT_LOAD
#undef ATT_STORE
__device__ __forceinline__ void p4_attention(unsigned char* ws, LAS unsigned char* lds, int bx, int G, int wave, int lane) {
    const int tid = wave * 64 + lane;
    for (int i = bx; i < 256; i += G) {
        const int xcd = i & 7, idx = i >> 3;
#ifndef NO_MLA
        { const int bh = (idx >> 2) * 8 + xcd, qp = idx & 3, b = bh >> 3, h = bh & 7;
          attn_unit<false>(ws, lds, b, h, 7 - qp, wave, lane, tid); attn_unit<false>(ws, lds, b, h, qp, wave, lane, tid); }
#endif
#ifndef NO_DSA
        { const int bg = (idx >> 4) * 8 + xcd, cp = idx & 15, b = bg >> 1, g = bg & 1;
          attn_unit<true>(ws, lds, b, g, 31 - cp, wave, lane, tid); attn_unit<true>(ws, lds, b, g, cp, wave, lane, tid); }
#endif
    }
}

typedef __bf16 bf16x2_t __attribute__((ext_vector_type(2)));
__device__ __forceinline__ float dot2bf(unsigned w, unsigned x, float acc) { return __builtin_amdgcn_fdot2_f32_bf16(__builtin_bit_cast(bf16x2_t, w), __builtin_bit_cast(bf16x2_t, x), acc, false); }
#ifndef P8_BATCH
#define P8_BATCH 2
#endif
__device__ __forceinline__ void p8_peer(const Args& a, LAS unsigned char* lds, int vcu, int G, int wave, int lane) {
    unsigned char* ws = a.ws;
    const bf16* U = (const bf16*)(ws + WS_U); const bf16* V = (const bf16*)(ws + WS_V); const float* S = (const float*)(ws + WS_S);
    LAS float* T1v = (LAS float*)(lds + wave * 16384);
    LAS int*   T1i = (LAS int*)(lds + wave * 16384 + 1024);
    LAS float* EXg = (LAS float*)(lds + wave * 16384 + 2048);
    LAS int*   EXi = (LAS int*)(lds + wave * 16384 + 2560);
    const int gw = vcu * NWAVES + wave, NGW = G * NWAVES;
    const float NINF = -__builtin_inff();
    for (int m = gw; m < M; m += NGW) {
        const float* xrow = a.out + (size_t)m * D;
        f32x4 xv[8]; float ss = 0.f;
#pragma unroll
        for (int j = 0; j < 4; ++j) { const GAS f32x4* p = (const GAS f32x4*)(xrow + j * 512 + lane * 8); xv[2 * j] = p[0]; xv[2 * j + 1] = p[1]; }
#pragma unroll
        for (int j = 0; j < 8; ++j) ss += (xv[j].x * xv[j].x + xv[j].y * xv[j].y) + (xv[j].z * xv[j].z + xv[j].w * xv[j].w);
        const float rstd = 1.0f / sqrtf(wave_sum(ss) * (1.f / D) + EPS);
        unsigned xn[16];
#pragma unroll
        for (int j = 0; j < 4; ++j) { const f32x4 g0 = *(const f32x4*)(a.g_ffn + j * 512 + lane * 8), g1 = *(const f32x4*)(a.g_ffn + j * 512 + lane * 8 + 4);
            const f32x4 a0 = xv[2 * j] * rstd * g0, a1 = xv[2 * j + 1] * rstd * g1;
            xn[4 * j] = pk2(a0.x, a0.y); xn[4 * j + 1] = pk2(a0.z, a0.w); xn[4 * j + 2] = pk2(a1.x, a1.y); xn[4 * j + 3] = pk2(a1.z, a1.w); }
        {
            float sv[32];
#pragma unroll
            for (int q = 0; q < 8; ++q) { const f32x4 t = *(const GAS f32x4*)(S + (size_t)m * 2048 + lane * 32 + q * 4); sv[4 * q] = t.x; sv[4 * q + 1] = t.y; sv[4 * q + 2] = t.z; sv[4 * q + 3] = t.w; }
            const int qb = (lane & 3) * 32;
            for (int it = 0; it < 16; ++it) {
                float mx = sv[0];
#pragma unroll
                for (int i = 1; i < 32; ++i) mx = fmaxf(mx, sv[i]);
                float qm = fmaxf(mx, __shfl_xor(mx, 1)); qm = fmaxf(qm, __shfl_xor(qm, 2));
                int bi = 1000;
#pragma unroll
                for (int i = 31; i >= 0; --i) bi = (sv[i] == qm) ? (qb + i) : bi;
                int qi = min(bi, __shfl_xor(bi, 1)); qi = min(qi, __shfl_xor(qi, 2));
                const int li = qi - qb;
#pragma unroll
                for (int i = 0; i < 32; ++i) sv[i] = (i == li) ? NINF : sv[i];
                if ((lane & 3) == 0) { T1v[(lane >> 2) * 16 + it] = qm; T1i[(lane >> 2) * 16 + it] = qi; }
            }
        }
        LDS_WAIT(); asm volatile("" ::: "memory");
        {
            const int h = lane >> 3, e = lane & 7;
            const LAS float* s1p = T1v + (2 * h) * 16; const LAS float* s2p = T1v + (2 * h + 1) * 16;
            const float s1a = s1p[e], s1b = s1p[e + 8];
            float cv[17];
#pragma unroll
            for (int k = 0; k < 16; ++k) cv[k] = ((e + 1) * (k + 1) <= 16) ? s1a + s2p[k] : NINF;
            cv[16] = s1b + s2p[0];
            float smax = 0.f, den = 0.f;
            for (int it = 0; it < 16; ++it) {
                float mx = cv[0];
#pragma unroll
                for (int k = 1; k < 17; ++k) mx = fmaxf(mx, cv[k]);
                float gm = fmaxf(mx, __shfl_xor(mx, 1)); gm = fmaxf(gm, __shfl_xor(gm, 2)); gm = fmaxf(gm, __shfl_xor(gm, 4));
                int bp = 100000;
                bp = (cv[16] == gm) ? ((e + 8) * 16) : bp;
#pragma unroll
                for (int k = 15; k >= 0; --k) bp = (cv[k] == gm) ? (e * 16 + k) : bp;
                int gp = min(bp, __shfl_xor(bp, 1)); gp = min(gp, __shfl_xor(gp, 2)); gp = min(gp, __shfl_xor(gp, 4));
                const int lk = (gp == (e + 8) * 16) ? 16 : (((gp >> 4) == e) ? (gp & 15) : -1);
#pragma unroll
                for (int k = 0; k < 17; ++k) cv[k] = (k == lk) ? NINF : cv[k];
                if (it == 0) smax = gm;
                const float ex = __expf((gm - smax) * rstd); den += ex;
                if (e == 0) { const int r1 = gp >> 4, r2 = gp & 15; EXg[h * 16 + it] = ex; EXi[h * 16 + it] = T1i[(2 * h) * 16 + r1] * 128 + T1i[(2 * h + 1) * 16 + r2]; }
            }
            LDS_WAIT(); asm volatile("" ::: "memory");
            const float inv = 1.0f / den;
            EXg[h * 16 + 2 * e] *= inv; EXg[h * 16 + 2 * e + 1] *= inv;
        }
        LDS_WAIT(); asm volatile("" ::: "memory");
        f32x4 acc[8];
#pragma unroll
        for (int j = 0; j < 8; ++j) acc[j] = (f32x4){0.f, 0.f, 0.f, 0.f};
        for (int e0 = 0; e0 < 128; e0 += P8_BATCH) {
            v4u uu[P8_BATCH][4], vv[P8_BATCH][4]; float gg[P8_BATCH];
#pragma unroll
            for (int q = 0; q < P8_BATCH; ++q) {
                const int ex = __builtin_amdgcn_readfirstlane(EXi[e0 + q]); gg[q] = __builtin_bit_cast(float, __builtin_amdgcn_readfirstlane(__builtin_bit_cast(int, EXg[e0 + q])));
                const bf16* up = U + (size_t)ex * D + lane * 8; const bf16* vp = V + (size_t)ex * D + lane * 8;
#pragma unroll
                for (int j = 0; j < 4; ++j) { uu[q][j] = *(const GAS v4u*)(up + j * 512); vv[q][j] = *(const GAS v4u*)(vp + j * 512); }
            }
#pragma unroll
            for (int q = 0; q < P8_BATCH; ++q) {
                float d0 = 0.f, d1 = 0.f, d2 = 0.f, d3 = 0.f;
#pragma unroll
                for (int j = 0; j < 4; ++j) { d0 = dot2bf(uu[q][j].x, xn[4 * j], d0); d1 = dot2bf(uu[q][j].y, xn[4 * j + 1], d1); d2 = dot2bf(uu[q][j].z, xn[4 * j + 2], d2); d3 = dot2bf(uu[q][j].w, xn[4 * j + 3], d3); }
                const float z = wave_sum((d0 + d1) + (d2 + d3));
                const float coef = gg[q] * 0.5f * z * (1.0f + erff(z * 0.70710678118654752f));
#pragma unroll
                for (int j = 0; j < 4; ++j) { const v4u w = vv[q][j];
                    acc[2 * j].x += coef * bflo(w.x); acc[2 * j].y += coef * bfhi(w.x); acc[2 * j].z += coef * bflo(w.y); acc[2 * j].w += coef * bfhi(w.y);
                    acc[2 * j + 1].x += coef * bflo(w.z); acc[2 * j + 1].y += coef * bfhi(w.z); acc[2 * j + 1].z += coef * bflo(w.w); acc[2 * j + 1].w += coef * bfhi(w.w); }
            }
        }
        float s2 = 0.f;
#pragma unroll
        for (int j = 0; j < 8; ++j) { xv[j] = xv[j] + acc[j]; s2 += (xv[j].x * xv[j].x + xv[j].y * xv[j].y) + (xv[j].z * xv[j].z + xv[j].w * xv[j].w); }
        const float rstd2 = 1.0f / sqrtf(wave_sum(s2) * (1.f / D) + EPS);
        float* orow = a.out + (size_t)m * D;
#pragma unroll
        for (int j = 0; j < 4; ++j) { const f32x4 g0 = *(const f32x4*)(a.g_fin + j * 512 + lane * 8), g1 = *(const f32x4*)(a.g_fin + j * 512 + lane * 8 + 4);
            *(GAS f32x4*)(orow + j * 512 + lane * 8) = xv[2 * j] * rstd2 * g0; *(GAS f32x4*)(orow + j * 512 + lane * 8 + 4) = xv[2 * j + 1] * rstd2 * g1; }
        LDS_WAIT(); asm volatile("" ::: "memory");
    }
}

#ifndef N_LAUNCHES
#define N_LAUNCHES 1
#endif
constexpr int NPHASE = 9;
__global__ void __launch_bounds__(NWAVES * 64, 2) mk_fwd(Args args) {
    extern __shared__ __attribute__((aligned(16))) unsigned char lds_raw[];
    LAS unsigned char* lds = (LAS unsigned char*)lds_raw;
    volatile LAS unsigned* MISC = (volatile LAS unsigned*)(lds + MISC_OFF);
    const int wave = __builtin_amdgcn_readfirstlane(threadIdx.x >> 6);
#define lane (lane_id())
#define tid (wave * 64 + lane)
    const int G = gridDim.x; const int bx = blockIdx.x; const int vcu = (G % 8 == 0) ? (bx % 8) * (G / 8) + bx / 8 : bx;
    unsigned char* ws = args.ws;
    gu32* ctl = (gu32*)(ws + WS_CTL);
    for (int u = tid; u < (LDS_BYTES - LDSCTL_OFF) / 4; u += NWAVES * 64) ((LAS unsigned*)(lds + LDSCTL_OFF))[u] = 0u;
    __syncthreads();
    XcdBarrier bar; bar.bar = (unsigned*)(ctl + CW_BAR); bar.x = 0; bar.st = nullptr;
    if (N_LAUNCHES == 1) bar = xcd_barrier_post((unsigned*)(ctl + CW_BAR), MISC + 8);
    const int lo = args.ph_lo, hi = args.ph_hi;
#ifndef PHMASK
#define PHMASK 0x1ff
#endif
#define IN(k) (((PHMASK >> (k)) & 1) && lo <= (k) && (k) < hi)
#define GRID_BAR(k) do { if (IN(k) && IN((k) + 1)) xcd_barrier(bar, wave == 0 && lane == 0); } while (0)

    if (IN(0)) { p0_prologue(args, lds, vcu, G, wave, lane); }
    GRID_BAR(0);
    if (IN(1)) {
        pg8::Gemm g{(const bf16*)(ws + WS_XN), (const bf16*)(ws + WS_XN), M, N1, D}; Order<1> S; S.init(64, 30, G, bx);
        Epi1 E{ws, (bf16*)args.out};
        pg8::gemm_phase<Epi1, Order<1>, true, true>(lds + RING_OFF, g, S, E, wave);
    }
    GRID_BAR(1);
    if (IN(2)) { p2_rowstats(ws, vcu, G, wave, lane); p2_indexer(ws, lds, bx, G, wave, lane); }
    GRID_BAR(2);
    if (IN(3)) {
        { pg8::Gemm g{(const bf16*)(ws + WS_CQ), (const bf16*)(ws + WS_WUQ), M, 1536, 512}; Order<0> S; S.init(64, 6, G, bx); Epi3q E{ws};
          pg8::gemm_phase<Epi3q, Order<0>, true, true>(lds + RING_OFF, g, S, E, wave); }
        { pg8::Gemm g{(const bf16*)(ws + WS_CKV), (const bf16*)(ws + WS_CKV), M, 2048, 256}; Order<2> S; S.init(64, 8, G, bx); Epi3k E{ws};
          pg8::gemm_phase<Epi3k, Order<2>, true, true>(lds + RING_OFF, g, S, E, wave); }
        p3_select(ws, vcu, G, wave, lane);
    }
    GRID_BAR(3);
    if (IN(4)) { p4_attention(ws, lds, bx, G, wave, lane); }
    GRID_BAR(4);
    if (IN(5)) {
        pg8::Gemm g{(const bf16*)(ws + WS_OA), (const bf16*)(ws + WS_WAB), 2 * M, 4096, 1024}; Order<3> S; S.init(64, 8, G, bx); Epi5 E{ws, (const bf16*)args.out};
        pg8::gemm_phase<Epi5, Order<3>, true, true>(lds + RING_OFF, g, S, E, wave);
    }
    GRID_BAR(5);
    if (IN(6)) {
        pg8::Gemm g{(const bf16*)(ws + WS_MRG), (const bf16*)(ws + WS_WO), M, D, D}; Order<0> S; S.init(64, 8, G, bx); Epi6 E{ws, args.x, args.out};
        pg8::gemm_phase<Epi6, Order<0>, true, true>(lds + RING_OFF, g, S, E, wave);
    }
    GRID_BAR(6);
    if (IN(7)) {
        pg8::Gemm g{(const bf16*)(ws + WS_X1B), (const bf16*)(ws + WS_W2), M, D, D}; Order<0> S; S.init(64, 8, G, bx); Epi7 E{ws};
        pg8::gemm_phase<Epi7, Order<0>, true, true>(lds + RING_OFF, g, S, E, wave);
    }
    GRID_BAR(7);
    if (IN(8)) { p8_peer(args, lds, vcu, G, wave, lane); }
#undef IN
#undef GRID_BAR
#undef lane
#undef tid
}

extern "C" void kernel_launch(void* const* d_in, const int* in_sizes, int n_in, void* d_out, int out_size, void* d_ws, size_t ws_size, hipStream_t stream) {
    static int grid = 0;
    if (grid == 0) {
        if (n_in != 18 || in_sizes[0] != M * D || out_size != M * D || ws_size < WS_END) { fprintf(stderr, "kernel_launch: unexpected problem (n_in %d, in0 %d, out %d, ws %zu)\n", n_in, n_in > 0 ? in_sizes[0] : -1, out_size, ws_size); grid = -1; return; }
        int dev = 0, cus = 0, per_cu = 0;
        if (hipGetDevice(&dev) != hipSuccess || hipDeviceGetAttribute(&cus, hipDeviceAttributeMultiprocessorCount, dev) != hipSuccess) { grid = -1; return; }
        if (hipFuncSetAttribute((const void*)mk_fwd, hipFuncAttributeMaxDynamicSharedMemorySize, LDS_BYTES) != hipSuccess) { fprintf(stderr, "kernel_launch: hipFuncSetAttribute failed\n"); grid = -1; return; }
        if (hipOccupancyMaxActiveBlocksPerMultiprocessor(&per_cu, (const void*)mk_fwd, NWAVES * 64, LDS_BYTES) != hipSuccess || per_cu < 1)
            fprintf(stderr, "kernel_launch: note: occupancy query reports %d workgroups per CU\n", per_cu);
        (void)hipGetLastError();
        grid = cus;
    }
    if (grid < 0) return;
    if (hipMemsetAsync((char*)d_ws + WS_CTL, 0, CTL_ZERO_BYTES, stream) != hipSuccess) return;
    Args a{};
    a.x = (const float*)d_in[0]; a.pos = (const int*)d_in[1]; a.g_mix = (const float*)d_in[2]; a.w_in = (const float*)d_in[3]; a.g_q = (const float*)d_in[4]; a.g_kv = (const float*)d_in[5];
    a.w_uq = (const float*)d_in[6]; a.w_uk = (const float*)d_in[7]; a.w_uv = (const float*)d_in[8]; a.w_a = (const float*)d_in[9]; a.w_b = (const float*)d_in[10]; a.w_o = (const float*)d_in[11];
    a.g_ffn = (const float*)d_in[12]; a.w_pq = (const float*)d_in[13]; a.subk = (const float*)d_in[14]; a.pu = (const float*)d_in[15]; a.pv = (const float*)d_in[16]; a.g_fin = (const float*)d_in[17];
    a.out = (float*)d_out; a.ws = (unsigned char*)d_ws;
    for (int i = 0; i < 32; ++i) a.invf[i] = pow(500000.0, -(2.0 * i) / 64.0);
    for (int i = 0; i < 16; ++i) a.invf[32 + i] = pow(500000.0, -(2.0 * i) / 32.0);
    for (int i = 0; i < 8; ++i) a.invf[48 + i] = pow(500000.0, -(2.0 * i) / 16.0);
    if (N_LAUNCHES == 1) { a.ph_lo = 0; a.ph_hi = NPHASE; hipLaunchKernelGGL(mk_fwd, dim3(grid), dim3(NWAVES * 64), LDS_BYTES, stream, a); }
    else for (int li = 0; li < NPHASE; ++li) { a.ph_lo = li; a.ph_hi = li + 1; hipLaunchKernelGGL(mk_fwd, dim3(grid), dim3(NWAVES * 64), LDS_BYTES, stream, a); }
}
```

```cpp
#include <hip/hip_runtime.h>
#include <cstdio>
#include <cstdint>
#include <cmath>
namespace pg8 {
#define PG8_LAS __attribute__((address_space(3)))
typedef unsigned short bf16_t;
typedef short bf16x8 __attribute__((ext_vector_type(8)));
typedef float f32x4 __attribute__((ext_vector_type(4)));
typedef unsigned u32x4 __attribute__((ext_vector_type(4)));
constexpr int BM = 256, BK = 64, HALF = 128, HTB = HALF * BK * 2  , STAGE_BYTES = 8 * HTB, NXCD = 8, WGM = 8;

__host__ __device__ __forceinline__ int lds_byte(int r, int c) { const int st = (r >> 4) * 2 + (c >> 5), rr = r & 15, cc = c & 31, ob = rr * 64 + cc * 2; return st * 1024 + (ob ^ (((ob >> 9) & 1) << 5)); }
__host__ __device__ __forceinline__ void stage_rc(int b, int& R, int& C) { const int st = b / 1024, sb = b % 1024, swz = sb ^ (((sb >> 9) & 1) << 5); R = (st >> 1) * 16 + swz / 64; C = (st & 1) * 32 + (swz % 64) / 2; }
__host__ __device__ __forceinline__ int perm32(int rho) { const int n = rho >> 4, i = rho & 15; return 8 * (i >> 2) + 4 * n + (i & 3); }

struct Unit { int pm, pn; };
struct Gemm { const bf16_t* A; const bf16_t* Bt; int M, N, K; };

template <class Epi, class Sched, bool ALIGN_EPI = false, bool SP2 = false>
__device__ __forceinline__ void gemm_phase(PG8_LAS unsigned char* lds, const Gemm g, const Sched& S, const Epi& E, const int wid) {
    int lane; asm volatile("v_mbcnt_lo_u32_b32 %0, -1, 0\n\tv_mbcnt_hi_u32_b32 %0, -1, %0" : "=v"(lane)); const int tid = wid * 64 + lane, wr = wid >> 2, wc = wid & 3, fr = lane & 15, fq = lane >> 4;
    const int K = g.K, nt = K / BK;
    unsigned voffA[2], voffB[2];
#pragma unroll
    for (int i = 0; i < 2; ++i) { int R, C; stage_rc(tid * 16 + i * 8192, R, C); const int Rb = Epi::PERM ? ((R & ~31) + perm32(R & 31)) : R;
        voffA[i] = (unsigned)(R * K + C) * 2u; voffB[i] = (unsigned)(Rb * K + C) * 2u; }
    const size_t kstep = (size_t)(BK * 2);
    const size_t hstep = (size_t)HALF * K * 2;
    const size_t tstep = 2 * hstep;
    const unsigned ldsw = (unsigned)wid * 1024u;
    const int aoff = lds_byte(wr * 64 + fr, fq * 8), boff = lds_byte(wc * 32 + fr, fq * 8);
#define PG8_SA(b, h) (((b) * 2 + (h)) * HTB)
#define PG8_SB(b, h) ((4 + (b) * 2 + (h)) * HTB)
#define PG8_STAGE(bufoff, gbase, voff) do { _Pragma("unroll") for (int _i = 0; _i < 2; ++_i) \
        __builtin_amdgcn_global_load_lds((const unsigned*)((const char*)(gbase) + (voff)[_i]), (PG8_LAS unsigned*)(lds + (bufoff) + ldsw + _i * 8192), 16, 0, 0); } while (0)
#define PG8_LDA(dst, b, h) do { _Pragma("unroll") for (int m = 0; m < 4; ++m) _Pragma("unroll") for (int k = 0; k < 2; ++k) dst[m][k] = *(const PG8_LAS bf16x8*)(lds + PG8_SA(b, h) + aoff + m * 2048 + k * 1024); } while (0)
#define PG8_LDB(dst, b, h) do { _Pragma("unroll") for (int n = 0; n < 2; ++n) _Pragma("unroll") for (int k = 0; k < 2; ++k) dst[n][k] = *(const PG8_LAS bf16x8*)(lds + PG8_SB(b, h) + boff + n * 2048 + k * 1024); } while (0)
#define PG8_MMA(ai, bj, At, Bt) do { __builtin_amdgcn_s_setprio(1); _Pragma("unroll") for (int m = 0; m < 4; ++m) _Pragma("unroll") for (int n = 0; n < 2; ++n) _Pragma("unroll") for (int k = 0; k < 2; ++k) \
        acc[ai][bj][m][n] = __builtin_amdgcn_mfma_f32_16x16x32_bf16(Bt[n][k], At[m][k], acc[ai][bj][m][n], 0, 0, 0); __builtin_amdgcn_s_setprio(0); } while (0)
#define PG8_WAIT_V(n) asm volatile("s_waitcnt vmcnt(" #n ")" ::: "memory")
#define PG8_WAIT_L(n) asm volatile("s_waitcnt lgkmcnt(" #n ")" ::: "memory")
#define PG8_BAR __builtin_amdgcn_s_barrier()
#define PG8_SCHED __builtin_amdgcn_sched_barrier(0)
    Unit cur, nxt; int ui = 0;
    if (!S.next(0, cur)) return;
    f32x4 acc[2][2][4][2];
#pragma unroll
    for (int a = 0; a < 2; ++a)
#pragma unroll
        for (int b = 0; b < 2; ++b)
#pragma unroll
            for (int m = 0; m < 4; ++m)
#pragma unroll
                for (int n = 0; n < 2; ++n) acc[a][b][m][n] = (f32x4){0.f, 0.f, 0.f, 0.f};
    bf16x8 At[4][2], B0[2][2], B1[2][2];
    const char* cA = (const char*)g.A + (size_t)cur.pm * tstep; const char* cB = (const char*)g.Bt + (size_t)cur.pn * tstep;
    S.a_ready(cur);
    if constexpr (SP2) {
        PG8_STAGE(PG8_SB(0, 0), cB, voffB); PG8_STAGE(PG8_SB(0, 1), cB + hstep, voffB); PG8_STAGE(PG8_SA(0, 0), cA, voffA); PG8_STAGE(PG8_SA(0, 1), cA + hstep, voffA);
        if (wr == 1) PG8_BAR;
        PG8_WAIT_V(2); PG8_BAR;
        PG8_STAGE(PG8_SB(1, 0), cB + kstep, voffB); PG8_STAGE(PG8_SA(1, 0), cA + kstep, voffA); PG8_STAGE(PG8_SB(1, 1), cB + hstep + kstep, voffB);
        PG8_WAIT_V(6); PG8_BAR;
    } else {
        PG8_STAGE(PG8_SB(0, 0), cB, voffB); PG8_STAGE(PG8_SA(0, 0), cA, voffA); PG8_STAGE(PG8_SB(0, 1), cB + hstep, voffB); PG8_STAGE(PG8_SA(0, 1), cA + hstep, voffA);
        if (wr == 1) PG8_BAR;
        PG8_WAIT_V(4); PG8_BAR;
        PG8_STAGE(PG8_SB(1, 0), cB + kstep, voffB); PG8_STAGE(PG8_SA(1, 0), cA + kstep, voffA); PG8_STAGE(PG8_SB(1, 1), cB + hstep + kstep, voffB);
        PG8_WAIT_V(6); PG8_BAR;
    }
    for (;;) {
        const bool has_next = S.next(ui + 1, nxt);
        const char* nA = has_next ? (const char*)g.A + (size_t)nxt.pm * tstep : cA; const char* nB = has_next ? (const char*)g.Bt + (size_t)nxt.pn * tstep : cB;
        for (int t = 0; t < nt; t += 2) {
            const bool last = (t == nt - 2);
            const char* a1 = cA + (size_t)(t + 1) * kstep;
            const char* a2 = last ? nA : cA + (size_t)(t + 2) * kstep; const char* b2 = last ? nB : cB + (size_t)(t + 2) * kstep;
            const char* a3 = a2 + kstep; const char* b3 = b2 + kstep;
            if (last && has_next) S.a_ready(nxt);
            if constexpr (SP2) {
            PG8_LDB(B0, 0, 0); PG8_LDB(B1, 0, 1); PG8_SCHED; PG8_LDA(At, 0, 0); PG8_STAGE(PG8_SA(1, 1), a1 + hstep, voffA);
            PG8_WAIT_V(8); PG8_WAIT_L(0); PG8_BAR; PG8_MMA(0, 0, At, B0); PG8_MMA(0, 1, At, B1); PG8_BAR; PG8_SCHED;
            PG8_LDA(At, 0, 1); PG8_STAGE(PG8_SB(0, 0), b2, voffB); PG8_STAGE(PG8_SB(0, 1), b2 + hstep, voffB); PG8_STAGE(PG8_SA(0, 0), a2, voffA);
            PG8_WAIT_V(8); PG8_WAIT_L(0); PG8_BAR; PG8_MMA(1, 0, At, B0); PG8_MMA(1, 1, At, B1); PG8_BAR; PG8_SCHED;
            PG8_LDB(B0, 1, 0); PG8_LDB(B1, 1, 1); PG8_SCHED; PG8_LDA(At, 1, 0); PG8_STAGE(PG8_SA(0, 1), a2 + hstep, voffA);
            PG8_WAIT_V(8); PG8_WAIT_L(0); PG8_BAR; PG8_MMA(0, 0, At, B0); PG8_MMA(0, 1, At, B1); PG8_BAR; PG8_SCHED;
            PG8_LDA(At, 1, 1); PG8_STAGE(PG8_SB(1, 0), b3, voffB); PG8_STAGE(PG8_SB(1, 1), b3 + hstep, voffB); PG8_STAGE(PG8_SA(1, 0), a3, voffA);
            PG8_WAIT_V(8); PG8_WAIT_L(0); PG8_BAR; PG8_MMA(1, 0, At, B0); PG8_MMA(1, 1, At, B1); PG8_BAR; PG8_SCHED;
            } else {
            PG8_LDB(B0, 0, 0); PG8_SCHED; PG8_LDA(At, 0, 0); PG8_STAGE(PG8_SA(1, 1), a1 + hstep, voffA);
            PG8_WAIT_L(8); PG8_BAR; PG8_WAIT_L(0); PG8_MMA(0, 0, At, B0); PG8_BAR; PG8_SCHED;
            PG8_LDB(B1, 0, 1); PG8_STAGE(PG8_SB(0, 0), b2, voffB);
            PG8_BAR; PG8_WAIT_L(0); PG8_MMA(0, 1, At, B1); PG8_BAR;
            PG8_LDA(At, 0, 1); PG8_STAGE(PG8_SA(0, 0), a2, voffA);
            PG8_BAR; PG8_WAIT_L(0); PG8_MMA(1, 0, At, B0); PG8_BAR; PG8_SCHED;
            PG8_STAGE(PG8_SB(0, 1), b2 + hstep, voffB);
            PG8_WAIT_V(6); PG8_BAR; PG8_MMA(1, 1, At, B1); PG8_BAR;
            PG8_LDB(B0, 1, 0); PG8_SCHED; PG8_LDA(At, 1, 0); PG8_STAGE(PG8_SA(0, 1), a2 + hstep, voffA);
            PG8_WAIT_L(8); PG8_BAR; PG8_WAIT_L(0); PG8_MMA(0, 0, At, B0); PG8_BAR; PG8_SCHED;
            PG8_LDB(B1, 1, 1); PG8_STAGE(PG8_SB(1, 0), b3, voffB);
            PG8_BAR; PG8_WAIT_L(0); PG8_MMA(0, 1, At, B1); PG8_BAR;
            PG8_LDA(At, 1, 1); PG8_STAGE(PG8_SA(1, 0), a3, voffA);
            PG8_BAR; PG8_WAIT_L(0); PG8_MMA(1, 0, At, B0); PG8_BAR; PG8_SCHED;
            PG8_STAGE(PG8_SB(1, 1), b3 + hstep, voffB);
            PG8_WAIT_V(6); PG8_BAR; PG8_MMA(1, 1, At, B1); PG8_BAR;
            }
        }
        if constexpr (ALIGN_EPI) { if (wr == 0) PG8_BAR; }
        if constexpr (!Epi::AFTER_DRAIN) { E(acc, cur, wr, wc, fr, fq); S.done(cur); }
        if (!has_next) break;
#pragma unroll
        for (int a = 0; a < 2; ++a)
#pragma unroll
            for (int b = 0; b < 2; ++b)
#pragma unroll
                for (int m = 0; m < 4; ++m)
#pragma unroll
                    for (int n = 0; n < 2; ++n) acc[a][b][m][n] = (f32x4){0.f, 0.f, 0.f, 0.f};
        cur = nxt; cA = nA; cB = nB; ++ui;
        if constexpr (ALIGN_EPI) { if (wr == 1) PG8_BAR; }
    }
    PG8_WAIT_V(0);
    if constexpr (!ALIGN_EPI) { if (wr == 0) PG8_BAR; }
    PG8_BAR;
    if constexpr (Epi::AFTER_DRAIN) { E.fused(acc, cur, wr, wc, fr, fq, lds, wid, lane); S.done(cur); }
#undef PG8_SA
#undef PG8_SB
#undef PG8_STAGE
#undef PG8_LDA
#undef PG8_LDB
#undef PG8_MMA
#undef PG8_WAIT_V
#undef PG8_WAIT_L
#undef PG8_BAR
#undef PG8_SCHED
}
}

constexpr int NWAVES = 8;
constexpr int NB = 8, SEQ = 2048, D = 2048, M = NB * SEQ;
constexpr int IN_WIDTH = 7568;
constexpr int N1 = 7680;
constexpr int NEXP = 16384;
constexpr float EPS = 1e-6f;
constexpr float LOG2E = 1.4426950408889634f;
constexpr float MLA_QSCALE = 0.07216878364870322f * LOG2E;
constexpr float DSA_QSCALE = 0.08838834764831845f * LOG2E;

constexpr size_t MiB = 1u << 20;
constexpr size_t WS_CTL = 0, CTL_ZERO_BYTES = 1 * MiB;
constexpr size_t WS_T64 = 1 * MiB;
constexpr size_t WS_T32 = 5 * MiB;
constexpr size_t WS_T16 = 7 * MiB;
constexpr size_t WS_RS  = 8 * MiB;
constexpr size_t WS_USC = 8 * MiB + 256 * 1024;
constexpr size_t WS_VSC = 8 * MiB + 512 * 1024;
constexpr size_t WS_MB  = 9 * MiB;
constexpr size_t WS_SC  = 16 * MiB;
constexpr size_t WS_XN  = 18 * MiB;
constexpr size_t WS_OA  = 16 * MiB;
constexpr size_t WS_OB  = 48 * MiB;
constexpr size_t WS_X1B = 16 * MiB;
constexpr size_t WS_WIN = 82 * MiB;
constexpr size_t WS_WUQ = 112 * MiB;
constexpr size_t WS_CKV = 114 * MiB;
constexpr size_t WS_WUK = 122 * MiB;
constexpr size_t WS_WUV = 122 * MiB + 512 * 1024;
constexpr size_t WS_WAB = 123 * MiB;
constexpr size_t WS_WO  = 131 * MiB;
constexpr size_t WS_W2  = 139 * MiB;
constexpr size_t WS_U   = 147 * MiB;
constexpr size_t WS_V   = 211 * MiB;
constexpr size_t WS_CQ  = 275 * MiB;
constexpr size_t WS_DQ  = 291 * MiB;
constexpr size_t WS_DK  = 323 * MiB;
constexpr size_t WS_DVT = 331 * MiB;
constexpr size_t WS_IQ  = 339 * MiB;
constexpr size_t WS_KR  = 371 * MiB;
constexpr size_t WS_IK  = 373 * MiB;
constexpr size_t WS_IW  = 375 * MiB;
constexpr size_t WS_Q   = 376 * MiB;
constexpr size_t WS_KN  = 424 * MiB;
constexpr size_t WS_VT  = 456 * MiB;
constexpr size_t WS_PA  = 275 * MiB;
constexpr size_t WS_MRG = 339 * MiB;
constexpr size_t WS_S   = 275 * MiB;
constexpr size_t WS_END = 488 * MiB;
constexpr int CW_BAR = 4096;

constexpr int RING_OFF = 0, RING_BYTES = 131072;
constexpr int LDSCTL_OFF = RING_BYTES, MISC_OFF = LDSCTL_OFF + 320;
constexpr int LDS_BYTES = 147456;

#define GAS __attribute__((address_space(1)))
#define LAS __attribute__((address_space(3)))
typedef unsigned short bf16;
typedef unsigned v4u __attribute__((ext_vector_type(4)));
typedef unsigned v2u __attribute__((ext_vector_type(2)));
typedef float f32x4 __attribute__((ext_vector_type(4)));
typedef float f32x2 __attribute__((ext_vector_type(2)));
typedef float f32x16 __attribute__((ext_vector_type(16)));
typedef short bf16x8 __attribute__((ext_vector_type(8)));
typedef GAS unsigned gu32;
#define RLX_AGENT __ATOMIC_RELAXED, __HIP_MEMORY_SCOPE_AGENT
#define LDS_WAIT() asm volatile("s_waitcnt lgkmcnt(0)" ::: "memory")
#define VM_WAIT() asm volatile("s_waitcnt vmcnt(0)" ::: "memory")
__device__ __forceinline__ unsigned f2bf(float f) { unsigned u = __builtin_bit_cast(unsigned, f); return (u + 0x7fffu + ((u >> 16) & 1u)) >> 16; }
__device__ __forceinline__ unsigned pk2(float lo, float hi) { unsigned r; asm volatile("v_cvt_pk_bf16_f32 %0, %1, %2" : "=v"(r) : "v"(lo), "v"(hi)); return r; }
__device__ __forceinline__ float bflo(unsigned w) { return __builtin_bit_cast(float, w << 16); }
__device__ __forceinline__ float bfhi(unsigned w) { return __builtin_bit_cast(float, w & 0xffff0000u); }
__device__ __forceinline__ float wave_sum(float v) {
#pragma unroll
    for (int o = 1; o < 64; o <<= 1) v += __shfl_xor(v, o);
    return v;
}
__device__ __forceinline__ int lane_id() { int l; asm volatile("v_mbcnt_lo_u32_b32 %0, -1, 0\n\tv_mbcnt_hi_u32_b32 %0, -1, %0" : "=v"(l)); return l; }
#define XB_TMO      128
#define XB_XCNT(j)  (256  + 64 * (j))
#define XB_XSUB(j)  (1280 + 64 * (j))
#define XB_XGEN(j)  (2304 + 64 * (j))
#define XB_TOP      3328
#define XB_TOPGEN   3392
#define XCD_BAR_WORDS 3456
#define XB_SPIN_CAP (1u << 18)

__device__ __forceinline__ unsigned xb_ld(unsigned* p)              { return __hip_atomic_load(p, __ATOMIC_RELAXED, __HIP_MEMORY_SCOPE_AGENT); }
__device__ __forceinline__ unsigned xb_add(unsigned* p, unsigned v) { return __hip_atomic_fetch_add(p, v, __ATOMIC_RELAXED, __HIP_MEMORY_SCOPE_AGENT); }
__device__ __forceinline__ unsigned xb_xcc_id() { return (unsigned)__builtin_amdgcn_s_getreg((3 << 11) | 20) & 0xFu; }
#define XB_SPIN(cond, bar) do { unsigned _sp = 0; while (cond) { __builtin_amdgcn_s_sleep(1); \
    if ((++_sp & 255u) == 0u) { if (xb_ld(&(bar)[XB_TMO])) break; if (_sp > XB_SPIN_CAP) { atomicAdd(&(bar)[XB_TMO], 1u); break; } } } } while (0)

struct XcdBarrier {
    unsigned* bar; unsigned x;
    volatile LAS unsigned* st;
};

__device__ __forceinline__ XcdBarrier xcd_barrier_post(unsigned* bar, volatile LAS unsigned* st) {
    XcdBarrier b; b.bar = bar; b.x = xb_xcc_id(); b.st = st;
    if (threadIdx.x == 0) (void)xb_add(&bar[XB_XCNT(b.x)], 1u);
    return b;
}
__device__ __forceinline__ void xcd_barrier_complete(unsigned* bar, unsigned x, unsigned& nloc, unsigned& nx) {
    const unsigned G = gridDim.x * gridDim.y * gridDim.z;
    unsigned sum, cnt, mine, sp = 0u;
    for (;;) {
        sum = 0u; cnt = 0u; mine = 0u;
#pragma unroll
        for (unsigned j = 0; j < 16; ++j) { const unsigned c = xb_ld(&bar[XB_XCNT(j)]); sum += c; cnt += (c > 0u) ? 1u : 0u; mine = (j == x) ? c : mine; }
        if (sum == G) break;
        __builtin_amdgcn_s_sleep(1);
        if ((++sp & 255u) == 0u) { if (xb_ld(&bar[XB_TMO])) break; if (sp > XB_SPIN_CAP) { atomicAdd(&bar[XB_TMO], 1u); break; } }
    }
    nloc = mine > 0u ? mine : 1u; nx = cnt > 0u ? cnt : 1u;
}

__device__ __forceinline__ void xcd_barrier(const XcdBarrier& b, const bool leader  ) {
    asm volatile("s_waitcnt vmcnt(0)" ::: "memory");
    __syncthreads();
    if (leader) {
        unsigned* bar = b.bar;
        __builtin_amdgcn_s_waitcnt(0);
        unsigned nloc = b.st[0], nx = b.st[1];
        if (nloc == 0u) { xcd_barrier_complete(bar, b.x, nloc, nx); b.st[0] = nloc; b.st[1] = nx; }
        const unsigned old = xb_add(&bar[XB_XSUB(b.x)], 1u);
        const unsigned gen = old / nloc;
        if (old + 1u == (gen + 1u) * nloc) {
            __builtin_amdgcn_fence(__ATOMIC_RELEASE, "agent");
            asm volatile("s_waitcnt vmcnt(0)" ::: "memory");
            const unsigned og = xb_add(&bar[XB_TOP], 1u);
            const unsigned tg = og / nx;
            if (og + 1u == (tg + 1u) * nx) xb_add(&bar[XB_TOPGEN], 1u);
            else XB_SPIN(xb_ld(&bar[XB_TOPGEN]) == tg, bar);
            __builtin_amdgcn_fence(__ATOMIC_ACQUIRE, "agent");
            xb_add(&bar[XB_XGEN(b.x)], 1u);
            asm volatile("s_waitcnt vmcnt(0)" ::: "memory");
        } else {
            XB_SPIN(xb_ld(&bar[XB_XGEN(b.x)]) == gen, bar);
            __builtin_amdgcn_fence(__ATOMIC_ACQUIRE, "agent");
            asm volatile("s_waitcnt vmcnt(0)" ::: "memory");
        }
    }
    __syncthreads();
}

struct Args {
    const float* x; const int* pos; const float* g_mix; const float* w_in; const float* g_q; const float* g_kv;
    const float* w_uq; const float* w_uk; const float* w_uv; const float* w_a; const float* w_b; const float* w_o;
    const float* g_ffn; const float* w_pq; const float* subk; const float* pu; const float* pv; const float* g_fin;
    float* out; unsigned char* ws;
    double invf[56];
    int ph_lo, ph_hi;
};

__device__ __forceinline__ int src_win(int n) {
    if (n < 768) return n;
    if (n < 2048) { const int r = n - 768, head = r >> 7, j = r & 127; const int sj = j < 32 ? ((j & 1) * 16 + (j >> 1)) : j; return 832 + head * 128 + sj; }
    if (n < 2304) return 2112 + (n - 2048);
    if (n < 3328) { const int r = n - 2304, head = r >> 6, j = r & 63; const int sj = j < 16 ? ((j & 1) * 8 + (j >> 1)) : j; return 2368 + head * 64 + sj; }
    if (n < 3584) { const int r = n - 3328;
        if (r < 64) return 768 + (r & 1) * 32 + (r >> 1);
        if (r < 128) { const int j = r - 64; return 3392 + (j < 16 ? ((j & 1) * 8 + (j >> 1)) : j); }
        if (r < 144) return 3456 + (r - 128);
        return -1; }
    return 3472 + (n - 3584);
}
__device__ __forceinline__ int src_wuq(int n) {
    if (n < 1024) return (n >> 7) * 192 + (n & 127);
    const int r = n - 1024, head = r >> 6, j = r & 63; return head * 192 + 128 + (j & 1) * 32 + (j >> 1);
}
template <int MODE> __device__ __forceinline__ int src_map(int n) { if (MODE == 1) return src_win(n); if (MODE == 2) return src_wuq(n); return n; }

template <int MODE> __device__ __forceinline__ void p0_transpose_item(const float* W, int K, int N, int nblk, bf16* WT, int row_off, LAS float* scr, int item, int lane, const float* kscale) {
    const int kb = item / nblk, nb = item % nblk, k0 = 64 * kb, n0 = 32 * nb;
    const int sc = src_map<MODE>(n0 + (lane & 31));
#pragma unroll 8
    for (int i = 0; i < 32; ++i) { const int kk = 2 * i + (lane >> 5); float v = sc >= 0 ? W[(size_t)(k0 + kk) * N + sc] : 0.f; if (kscale) v *= kscale[k0 + kk]; scr[kk * 33 + (lane & 31)] = v; }
    LDS_WAIT(); asm volatile("" ::: "memory");
    const int c = lane & 7;
#pragma unroll
    for (int j = 0; j < 4; ++j) { const int n = (lane >> 3) + 8 * j; const LAS float* s = scr + (8 * c) * 33 + n;
        v4u o; o.x = pk2(s[0 * 33], s[1 * 33]); o.y = pk2(s[2 * 33], s[3 * 33]); o.z = pk2(s[4 * 33], s[5 * 33]); o.w = pk2(s[6 * 33], s[7 * 33]);
        *(GAS v4u*)(WT + (size_t)(row_off + n0 + n) * K + k0 + 8 * c) = o; }
    LDS_WAIT(); asm volatile("" ::: "memory");
}

__device__ __forceinline__ void p0_w2_item(const Args& a, bf16* W2, LAS float* scr, int item, int lane) {
    const int hp = item >> 6, d0 = (item & 63) * 32;
#pragma unroll 4
    for (int dd = 0; dd < 32; ++dd) scr[dd * 64 + lane] = a.w_pq[(size_t)(d0 + dd) * 1024 + hp * 64 + lane];
    LDS_WAIT(); asm volatile("" ::: "memory");
    for (int pass = 0; pass < 2; ++pass) {
        const int n = lane + 64 * pass;
        const f32x4* skp = (const f32x4*)(a.subk + ((size_t)hp * 128 + n) * 64);
        float acc[32];
#pragma unroll
        for (int i = 0; i < 32; ++i) acc[i] = 0.f;
#pragma unroll 2
        for (int c4 = 0; c4 < 16; ++c4) { const f32x4 sk = skp[c4];
#pragma unroll
            for (int dd = 0; dd < 32; ++dd) { const f32x4 w = *(const LAS f32x4*)(scr + dd * 64 + c4 * 4); acc[dd] += w.x * sk.x + w.y * sk.y + w.z * sk.z + w.w * sk.w; } }
        bf16* o = W2 + (size_t)(hp * 128 + n) * D + d0;
#pragma unroll
        for (int q = 0; q < 4; ++q) { v4u w; const float* g = a.g_ffn + d0 + 8 * q;
            w.x = pk2(acc[8 * q + 0] * g[0], acc[8 * q + 1] * g[1]); w.y = pk2(acc[8 * q + 2] * g[2], acc[8 * q + 3] * g[3]);
            w.z = pk2(acc[8 * q + 4] * g[4], acc[8 * q + 5] * g[5]); w.w = pk2(acc[8 * q + 6] * g[6], acc[8 * q + 7] * g[7]);
            *(GAS v4u*)(o + 8 * q) = w; }
    }
    LDS_WAIT(); asm volatile("" ::: "memory");
}

__device__ __forceinline__ void rms_row_to_bf16(const float* xrow, const float* g, bf16* orow, int lane) {
    f32x4 v[8]; float s = 0.f;
#pragma unroll
    for (int j = 0; j < 4; ++j) { const GAS f32x4* p = (const GAS f32x4*)(xrow + j * 512 + lane * 8); v[2 * j] = p[0]; v[2 * j + 1] = p[1]; }
#pragma unroll
    for (int j = 0; j < 8; ++j) s += (v[j].x * v[j].x + v[j].y * v[j].y) + (v[j].z * v[j].z + v[j].w * v[j].w);
    const float rstd = 1.0f / sqrtf(wave_sum(s) * (1.f / D) + EPS);
#pragma unroll
    for (int j = 0; j < 4; ++j) { const f32x4 g0 = *(const f32x4*)(g + j * 512 + lane * 8), g1 = *(const f32x4*)(g + j * 512 + lane * 8 + 4);
        const f32x4 a0 = v[2 * j] * rstd * g0, a1 = v[2 * j + 1] * rstd * g1;
        v4u w; w.x = pk2(a0.x, a0.y); w.y = pk2(a0.z, a0.w); w.z = pk2(a1.x, a1.y); w.w = pk2(a1.z, a1.w);
        *(GAS v4u*)(orow + j * 512 + lane * 8) = w; }
}
__device__ __forceinline__ void quant_row_fp8(const float* xrow, unsigned char* orow, float* scale, int lane) {
    f32x4 v[8]; float mx = 0.f;
#pragma unroll
    for (int j = 0; j < 2; ++j)
#pragma unroll
        for (int c = 0; c < 4; ++c) v[4 * j + c] = __builtin_nontemporal_load((const GAS f32x4*)(xrow + j * 1024 + lane * 16 + 4 * c));
#pragma unroll
    for (int j = 0; j < 8; ++j) mx = fmaxf(fmaxf(mx, fmaxf(fabsf(v[j].x), fabsf(v[j].y))), fmaxf(fabsf(v[j].z), fabsf(v[j].w)));
#pragma unroll
    for (int o = 1; o < 64; o <<= 1) mx = fmaxf(mx, __shfl_xor(mx, o));
    const float sc = mx > 0.f ? mx * (1.0f / 448.0f) : 1.0f, inv = 1.0f / sc;
#pragma unroll
    for (int j = 0; j < 2; ++j) { v4u w;
#pragma unroll
        for (int c = 0; c < 4; ++c) { const f32x4 t = v[4 * j + c] * inv; int p = __builtin_amdgcn_cvt_pk_fp8_f32(t.x, t.y, 0, false); p = __builtin_amdgcn_cvt_pk_fp8_f32(t.z, t.w, p, true); w[c] = (unsigned)p; }
        *(GAS v4u*)(orow + j * 1024 + lane * 16) = w; }
    if (lane == 0) *scale = sc;
}
__device__ __forceinline__ void p0_prologue(const Args& a, LAS unsigned char* lds, int vcu, int G, int wave, int lane) {
    unsigned char* ws = a.ws;
    LAS float* scr = (LAS float*)(lds + RING_OFF + wave * 16384);
    const int gw = vcu * NWAVES + wave, NGW = G * NWAVES;
    constexpr int I_WIN = 32 * 240, I_WUQ = 8 * 48, I_WUK = 4 * 32, I_WUV = 4 * 32, I_WA = 16 * 64, I_WB = 16 * 64, I_WO = 32 * 64, I_W2 = 1024;
    constexpr int NITEMS = I_WIN + I_WUQ + I_WUK + I_WUV + I_WA + I_WB + I_WO + I_W2;
    for (int it = gw; it < NITEMS; it += NGW) {
        int r = it;
        if (r < I_WIN) { p0_transpose_item<1>(a.w_in, D, IN_WIDTH, 240, (bf16*)(ws + WS_WIN), 0, scr, r, lane, nullptr); continue; } r -= I_WIN;
        if (r < I_WUQ) { p0_transpose_item<2>(a.w_uq, 512, 1536, 48, (bf16*)(ws + WS_WUQ), 0, scr, r, lane, a.g_q); continue; } r -= I_WUQ;
        if (r < I_WUK) { p0_transpose_item<0>(a.w_uk, 256, 1024, 32, (bf16*)(ws + WS_WUK), 0, scr, r, lane, a.g_kv); continue; } r -= I_WUK;
        if (r < I_WUV) { p0_transpose_item<0>(a.w_uv, 256, 1024, 32, (bf16*)(ws + WS_WUV), 0, scr, r, lane, a.g_kv); continue; } r -= I_WUV;
        if (r < I_WA) { p0_transpose_item<0>(a.w_a, 1024, 2048, 64, (bf16*)(ws + WS_WAB), 0, scr, r, lane, nullptr); continue; } r -= I_WA;
        if (r < I_WB) { p0_transpose_item<0>(a.w_b, 1024, 2048, 64, (bf16*)(ws + WS_WAB), 2048, scr, r, lane, nullptr); continue; } r -= I_WB;
        if (r < I_WO) { p0_transpose_item<0>(a.w_o, 2048, 2048, 64, (bf16*)(ws + WS_WO), 0, scr, r, lane, nullptr); continue; } r -= I_WO;
        p0_w2_item(a, (bf16*)(ws + WS_W2), scr, r, lane);
    }
    for (int m = gw; m < M; m += NGW) rms_row_to_bf16(a.x + (size_t)m * D, a.g_mix, (bf16*)(ws + WS_XN) + (size_t)m * D, lane);
    for (int m = gw; m < 2 * NEXP; m += NGW) { const int e = m & (NEXP - 1);
        if (m < NEXP) quant_row_fp8(a.pu + (size_t)e * D, ws + WS_U + (size_t)e * D, (float*)(ws + WS_USC) + e, lane);
        else quant_row_fp8(a.pv + (size_t)e * D, ws + WS_V + (size_t)e * D, (float*)(ws + WS_VSC) + e, lane); }
    const int gt = gw * 64 + lane, NGT = NGW * 64;
    for (int idx = gt; idx < M * 56; idx += NGT) {
        const int t = idx / 56, i = idx - t * 56;
        const double ang = (double)a.pos[t] * a.invf[i];
        double rev = ang * 0.15915494309189535; rev -= __builtin_rint(rev);
        const float r = (float)(rev * 6.283185307179586);
        const float c = cosf(r), s = sinf(r);
        f32x2* dst = i < 32 ? (f32x2*)(ws + WS_T64) + (size_t)t * 32 + i : i < 48 ? (f32x2*)(ws + WS_T32) + (size_t)t * 16 + (i - 32) : (f32x2*)(ws + WS_T16) + (size_t)t * 8 + (i - 48);
        *dst = (f32x2){c, s};
    }
}

template <int KIND> struct Order {
    int nM, nN, nwg, G, c;
    __device__ void init(int nM_, int nN_, int G_, int c_) { nM = nM_; nN = nN_; nwg = nM * nN; G = G_; c = c_; }
    __device__ bool next(int i, pg8::Unit& u) const {
        const int ii = (KIND == 3) ? (i >> 1) : i;
        const long L = (long)ii * G + c; if (L >= nwg) return false;
        int wgid = (int)L; { const int q = nwg / 8, r = nwg % 8, xcd = wgid % 8, off = wgid / 8; wgid = (xcd < r ? xcd * (q + 1) : r * (q + 1) + (xcd - r) * q) + off; }
        const int nig = 8 * nN, gid = wgid / nig, fm = gid * 8, gsz = (nM - fm) < 8 ? (nM - fm) : 8;
        const int pm = fm + ((wgid % nig) % gsz), vn = (wgid % nig) / gsz;
        if (KIND == 0) { u.pm = pm; u.pn = vn; }
        if (KIND == 1) { if (vn == 8) { u.pm = 72; u.pn = pm; } else { u.pm = pm; u.pn = 64 + vn; } }
        if (KIND == 2) { if (vn >= 4) { u.pm = 64 + vn; u.pn = pm; } else { u.pm = pm; u.pn = 64 + vn; } }
        if (KIND == 3) { const int br = i & 1; u.pm = pm + 64 * br; u.pn = vn + 8 * br; }
        return true;
    }
    __device__ __forceinline__ void a_ready(const pg8::Unit&) const {}
    __device__ __forceinline__ void done(const pg8::Unit&) const {}
};

__device__ __forceinline__ void st8bf(bf16* p, f32x4 a, f32x4 b) { v4u w; w.x = pk2(a.x, a.y); w.y = pk2(a.z, a.w); w.z = pk2(b.x, b.y); w.w = pk2(b.z, b.w); *(GAS v4u*)p = w; }
__device__ __forceinline__ void rope8(f32x4& a, f32x4& b, const float* tab) {
    const f32x4 t0 = *(const f32x4*)tab, t1 = *(const f32x4*)(tab + 4);
    const f32x4 ra = {a.x * t0.x - a.y * t0.y, a.y * t0.x + a.x * t0.y, a.z * t0.z - a.w * t0.w, a.w * t0.z + a.z * t0.w};
    const f32x4 rb = {b.x * t1.x - b.y * t1.y, b.y * t1.x + b.x * t1.y, b.z * t1.z - b.w * t1.w, b.w * t1.z + b.z * t1.w};
    a = ra; b = rb;
}
__device__ __forceinline__ void st8_vt(bf16* rowp, int tk0, f32x4 a, f32x4 b) {
    bf16* p = rowp + (tk0 & ~15) + 4 * ((tk0 >> 3) & 1);
    v2u w0, w1; w0.x = pk2(a.x, a.y); w0.y = pk2(a.z, a.w); w1.x = pk2(b.x, b.y); w1.y = pk2(b.z, b.w);
    *(GAS v2u*)p = w0; *(GAS v2u*)(p + 8) = w1;
}
#define EPI_FOR _Pragma("unroll") for (int ai = 0; ai < 2; ++ai) _Pragma("unroll") for (int m = 0; m < 4; ++m) _Pragma("unroll") for (int bj = 0; bj < 2; ++bj)
#define EPI_VARS asm volatile("" ::: "memory"); const int rl = 128 * ai + 64 * wr + 16 * m + fr, lc = 128 * bj + 32 * wc + 8 * fq; f32x4 v0 = acc[ai][bj][m][0], v1 = acc[ai][bj][m][1]; (void)rl; (void)lc;

struct Epi1 {
    static constexpr bool PERM = true, AFTER_DRAIN = false;
    unsigned char* ws; bf16* G;
    __device__ __forceinline__ void operator()(const f32x4 (&acc)[2][2][4][2], const pg8::Unit& u, int wr, int wc, int fr_, int fq_) const {
        int fr = fr_, fq = fq_; asm volatile("" : "+v"(fr), "+v"(fq));
        if (u.pm >= 64) {
            bf16* DVT = (bf16*)(ws + WS_DVT);
            EPI_FOR { EPI_VARS st8_vt(DVT + (size_t)rl * M, u.pn * 256 + lc, v0, v1); }
            return;
        }
        const int ct = u.pn - 64; const size_t row0 = (size_t)u.pm * 256;
        if (ct < 2) { bf16* O = (bf16*)(ws + WS_CQ); EPI_FOR { EPI_VARS st8bf(O + (row0 + rl) * 512 + ct * 256 + lc, v0, v1); } }
        else if (ct == 2) { bf16* O = (bf16*)(ws + WS_CKV); EPI_FOR { EPI_VARS st8bf(O + (row0 + rl) * 256 + lc, v0, v1); } }
        else if (ct < 7) { bf16* O = (bf16*)(ws + WS_DQ); const float* T = (const float*)(ws + WS_T32);
            EPI_FOR { EPI_VARS const int gc = (ct - 3) * 256 + lc, j = gc & 127; const size_t row = row0 + rl;
                if (j < 32) rope8(v0, v1, T + row * 32 + j);
                st8bf(O + row * 1024 + gc, v0 * DSA_QSCALE, v1 * DSA_QSCALE); } }
        else if (ct == 7) { bf16* O = (bf16*)(ws + WS_DK); const float* T = (const float*)(ws + WS_T32);
            EPI_FOR { EPI_VARS const int j = lc & 127; const size_t row = row0 + rl;
                if (j < 32) rope8(v0, v1, T + row * 32 + j);
                st8bf(O + row * 256 + lc, v0, v1); } }
        else if (ct < 13) { bf16* O = (bf16*)(ws + WS_IQ); const float* T = (const float*)(ws + WS_T16);
            EPI_FOR { EPI_VARS const int gc = (ct - 9) * 256 + lc, j = gc & 63; const size_t row = row0 + rl;
                if (j < 16) rope8(v0, v1, T + row * 16 + j);
                st8bf(O + row * 1024 + gc, v0, v1); } }
        else if (ct == 13) {
            EPI_FOR { EPI_VARS const size_t row = row0 + rl;
                if (lc < 64) { rope8(v0, v1, (const float*)(ws + WS_T64) + row * 64 + lc); st8bf((bf16*)(ws + WS_KR) + row * 64 + lc, v0, v1); }
                else if (lc < 128) { const int j = lc - 64; if (j < 16) rope8(v0, v1, (const float*)(ws + WS_T16) + row * 16 + j); st8bf((bf16*)(ws + WS_IK) + row * 64 + j, v0, v1); }
                else if (lc < 144) { float* o = (float*)(ws + WS_IW) + row * 16 + (lc - 128); *(GAS f32x4*)o = v0 * 0.03125f; *(GAS f32x4*)(o + 4) = v1 * 0.03125f; } } }
        else {
            EPI_FOR { EPI_VARS const int gc = (ct - 14) * 256 + lc; const size_t row = row0 + rl;
                f32x4 s0, s1;
#pragma unroll
                for (int e = 0; e < 4; ++e) { s0[e] = __builtin_amdgcn_rcpf(1.f + __expf(-v0[e])); s1[e] = __builtin_amdgcn_rcpf(1.f + __expf(-v1[e])); }
                st8bf(G + row * 4096 + gc, s0, s1); } }
    }
};

struct Epi3q {
    static constexpr bool PERM = true, AFTER_DRAIN = false;
    unsigned char* ws;
    __device__ __forceinline__ void operator()(const f32x4 (&acc)[2][2][4][2], const pg8::Unit& u, int wr, int wc, int fr_, int fq_) const {
        int fr = fr_, fq = fq_; asm volatile("" : "+v"(fr), "+v"(fq));
        bf16* Q = (bf16*)(ws + WS_Q); const float* RSQ = (const float*)(ws + WS_RS); const float* T = (const float*)(ws + WS_T64);
        const size_t row0 = (size_t)u.pm * 256;
        EPI_FOR { EPI_VARS const size_t row = row0 + rl; const float sc = RSQ[row] * MLA_QSCALE; v0 = v0 * sc; v1 = v1 * sc;
            if (u.pn < 4) { const int gc = u.pn * 256 + lc; st8bf(Q + row * 1536 + (gc >> 7) * 192 + (gc & 127), v0, v1); }
            else { const int r = (u.pn - 4) * 256 + lc, j = r & 63; rope8(v0, v1, T + row * 64 + j); st8bf(Q + row * 1536 + (r >> 6) * 192 + 128 + j, v0, v1); } }
    }
};
struct Epi3k {
    static constexpr bool PERM = true, AFTER_DRAIN = false;
    unsigned char* ws;
    __device__ __forceinline__ void operator()(const f32x4 (&acc)[2][2][4][2], const pg8::Unit& u, int wr, int wc, int fr_, int fq_) const {
        int fr = fr_, fq = fq_; asm volatile("" : "+v"(fr), "+v"(fq));
        const float* RSK = (const float*)(ws + WS_RS) + M;
        if (u.pm >= 64) { bf16* VT = (bf16*)(ws + WS_VT); const int vt = u.pm - 68;
            EPI_FOR { EPI_VARS const int tk0 = u.pn * 256 + lc; const f32x4 r0 = *(const f32x4*)(RSK + tk0), r1 = *(const f32x4*)(RSK + tk0 + 4);
                st8_vt(VT + (size_t)(vt * 256 + rl) * M, tk0, v0 * r0, v1 * r1); }
            return; }
        bf16* KN = (bf16*)(ws + WS_KN); const int ct = u.pn - 64; const size_t row0 = (size_t)u.pm * 256;
        EPI_FOR { EPI_VARS const size_t row = row0 + rl; const float sc = RSK[row]; st8bf(KN + row * 1024 + ct * 256 + lc, v0 * sc, v1 * sc); }
    }
};
struct Epi5 {
    static constexpr bool PERM = true, AFTER_DRAIN = false;
    unsigned char* ws; const bf16* G;
    __device__ __forceinline__ void operator()(const f32x4 (&acc)[2][2][4][2], const pg8::Unit& u, int wr, int wc, int fr_, int fq_) const {
        int fr = fr_, fq = fq_; asm volatile("" : "+v"(fr), "+v"(fq));
        bf16* PA = (bf16*)(ws + WS_PA); bf16* MRG = (bf16*)(ws + WS_MRG);
        const size_t row0 = (size_t)(u.pm & 63) * 256; const int col0 = (u.pn & 7) * 256;
#ifdef DBG_ZERO_MLA
        if (u.pm < 64) { EPI_FOR { EPI_VARS st8bf(PA + (row0 + rl) * 2048 + col0 + lc, v0 * 0.f, v1 * 0.f); } return; }
#else
        if (u.pm < 64) { EPI_FOR { EPI_VARS st8bf(PA + (row0 + rl) * 2048 + col0 + lc, v0, v1); } return; }
#endif
        EPI_FOR { EPI_VARS const size_t row = row0 + rl; const int col = col0 + lc;
            const v4u ga = *(const GAS v4u*)(G + row * 4096 + col), gb = *(const GAS v4u*)(G + row * 4096 + 2048 + col), pa = *(const GAS v4u*)(PA + row * 2048 + col);
            f32x4 o0, o1;
#ifdef DBG_ZERO_DSA
            v0 = v0 * 0.f; v1 = v1 * 0.f;
#endif
            o0.x = bflo(ga.x) * bflo(pa.x) + bflo(gb.x) * v0.x; o0.y = bfhi(ga.x) * bfhi(pa.x) + bfhi(gb.x) * v0.y;
            o0.z = bflo(ga.y) * bflo(pa.y) + bflo(gb.y) * v0.z; o0.w = bfhi(ga.y) * bfhi(pa.y) + bfhi(gb.y) * v0.w;
            o1.x = bflo(ga.z) * bflo(pa.z) + bflo(gb.z) * v1.x; o1.y = bfhi(ga.z) * bfhi(pa.z) + bfhi(gb.z) * v1.y;
            o1.z = bflo(ga.w) * bflo(pa.w) + bflo(gb.w) * v1.z; o1.w = bfhi(ga.w) * bfhi(pa.w) + bfhi(gb.w) * v1.w;
            st8bf(MRG + row * 2048 + col, o0, o1); }
    }
};
struct Epi6 {
    static constexpr bool PERM = true, AFTER_DRAIN = false;
    unsigned char* ws; const float* x; float* out;
    __device__ __forceinline__ void operator()(const f32x4 (&acc)[2][2][4][2], const pg8::Unit& u, int wr, int wc, int fr_, int fq_) const {
        int fr = fr_, fq = fq_; asm volatile("" : "+v"(fr), "+v"(fq));
        bf16* X1B = (bf16*)(ws + WS_X1B);
        EPI_FOR { EPI_VARS const size_t off = ((size_t)u.pm * 256 + rl) * 2048 + u.pn * 256 + lc;
            const f32x4 a = *(const GAS f32x4*)(x + off) + v0, b = *(const GAS f32x4*)(x + off + 4) + v1;
            *(GAS f32x4*)(out + off) = a; *(GAS f32x4*)(out + off + 4) = b; st8bf(X1B + off, a, b); }
    }
};
struct Epi7 {
    static constexpr bool PERM = true, AFTER_DRAIN = false;
    unsigned char* ws;
    __device__ __forceinline__ void operator()(const f32x4 (&acc)[2][2][4][2], const pg8::Unit& u, int wr, int wc, int fr_, int fq_) const {
        int fr = fr_, fq = fq_; asm volatile("" : "+v"(fr), "+v"(fq));
        float* S = (float*)(ws + WS_S);
        EPI_FOR { EPI_VARS const size_t off = ((size_t)u.pm * 256 + rl) * 2048 + u.pn * 256 + lc;
            *(GAS f32x4*)(S + off) = v0; *(GAS f32x4*)(S + off + 4) = v1; }
    }
};

__device__ __forceinline__ void p2_rowstats(unsigned char* ws, int vcu, int G, int wave, int lane) {
    const bf16* CQ = (const bf16*)(ws + WS_CQ); const bf16* CKV = (const bf16*)(ws + WS_CKV); float* RS = (float*)(ws + WS_RS);
    const int gw = vcu * NWAVES + wave, NGW = G * NWAVES;
    for (int m = gw; m < M; m += NGW) {
        const v4u q = *(const GAS v4u*)(CQ + (size_t)m * 512 + lane * 8); const v2u k = *(const GAS v2u*)(CKV + (size_t)m * 256 + lane * 4);
        float sq = 0.f, sk = 0.f;
#pragma unroll
        for (int e = 0; e < 4; ++e) { const float a = bflo(q[e]), b = bfhi(q[e]); sq += a * a + b * b; }
#pragma unroll
        for (int e = 0; e < 2; ++e) { const float a = bflo(k[e]), b = bfhi(k[e]); sk += a * a + b * b; }
        sq = wave_sum(sq); sk = wave_sum(sk);
        if (lane == 0) { RS[m] = 1.0f / sqrtf(sq * (1.f / 512.f) + EPS); RS[M + m] = 1.0f / sqrtf(sk * (1.f / 256.f) + EPS); }
    }
}
__device__ __forceinline__ size_t sc_base(int b, int c) { return (size_t)b * 2162688u + (size_t)2048 * c * (c + 1); }
__device__ __forceinline__ void idx_segment(unsigned char* ws, LAS unsigned char* lds, int b, int c, int k0, int k1, int wave, int lane, int tid) {
    const bf16* IQ = (const bf16*)(ws + WS_IQ); const bf16* IK = (const bf16*)(ws + WS_IK); const float* IW = (const float*)(ws + WS_IW); float* SC = (float*)(ws + WS_SC);
    const int t0 = b * SEQ + 64 * c, r = lane & 31, hk = lane >> 5;
    bf16x8 af[4][4]; f32x4 wv[4][4];
#pragma unroll
    for (int rt = 0; rt < 4; ++rt) {
        const int tq = t0 + 8 * wave + 2 * rt + ((r >> 2) & 1), hh = (r & 3) + 4 * (r >> 3);
#pragma unroll
        for (int ks = 0; ks < 4; ++ks) af[rt][ks] = *(const GAS bf16x8*)(IQ + (size_t)tq * 1024 + hh * 64 + 16 * ks + 8 * hk);
        const int tw = t0 + 8 * wave + 2 * rt + hk;
#pragma unroll
        for (int q4 = 0; q4 < 4; ++q4) wv[rt][q4] = *(const GAS f32x4*)(IW + (size_t)tw * 16 + 4 * q4);
    }
    const int skey = tid >> 3, sch = tid & 7;
    const bf16* src = IK + ((size_t)b * SEQ + skey) * 64 + sch * 8;
    const int sdst = skey * 144 + sch * 16;
    const int nrow = 64 * (c + 1);
    float* scrow = SC + sc_base(b, c);
    { const v4u t = *(const GAS v4u*)(src + (size_t)k0 * 64 * 64); *(LAS v4u*)(lds + sdst) = t; }
    __syncthreads();
    for (int kt = k0; kt < k1; ++kt) {
        const int cur = (kt - k0) & 1; v4u nx = {0u, 0u, 0u, 0u};
        if (kt + 1 < k1) nx = *(const GAS v4u*)(src + (size_t)(kt + 1) * 64 * 64);
        const LAS unsigned char* kb = lds + cur * 9216;
#pragma unroll
        for (int kh = 0; kh < 2; ++kh) {
            bf16x8 bfr[4];
#pragma unroll
            for (int ks = 0; ks < 4; ++ks) bfr[ks] = *(const LAS bf16x8*)(kb + (32 * kh + r) * 144 + (16 * ks + 8 * hk) * 2);
#pragma unroll
            for (int rt = 0; rt < 4; ++rt) {
                f32x16 cc;
#pragma unroll
                for (int e = 0; e < 16; ++e) cc[e] = 0.f;
#pragma unroll
                for (int ks = 0; ks < 4; ++ks) cc = __builtin_amdgcn_mfma_f32_32x32x16_bf16(af[rt][ks], bfr[ks], cc, 0, 0, 0);
                float s = 0.f;
#pragma unroll
                for (int e = 0; e < 16; ++e) s += wv[rt][e >> 2][e & 3] * fmaxf(cc[e], 0.f);
                scrow[(size_t)(8 * wave + 2 * rt + hk) * nrow + 64 * kt + 32 * kh + r] = s;
            }
        }
        if (kt + 1 < k1) *(LAS v4u*)(lds + (cur ^ 1) * 9216 + sdst) = nx;
        __syncthreads();
    }
}
__device__ __forceinline__ void p2_indexer(unsigned char* ws, LAS unsigned char* lds, int bx, int G, int wave, int lane) {
    const int tid = wave * 64 + lane;
    for (int i = bx; i < 256; i += G) {
        const int p = i >> 1, b = p >> 4, c = p & 15;
        if ((i & 1) == 0) { idx_segment(ws, lds, b, c, 0, c + 1, wave, lane, tid); idx_segment(ws, lds, b, 31 - c, 0, 16 - c, wave, lane, tid); }
        else idx_segment(ws, lds, b, 31 - c, 16 - c, 32 - c, wave, lane, tid);
    }
}

__device__ __forceinline__ int wave_sum_i(int v) {
#pragma unroll
    for (int o = 1; o < 64; o <<= 1) v += __shfl_xor(v, o);
    return v;
}
__device__ __forceinline__ void p3_select(unsigned char* ws, int vcu, int G, int wave, int lane) {
    const float* SC = (const float*)(ws + WS_SC); unsigned* MB = (unsigned*)(ws + WS_MB);
    const int gw = vcu * NWAVES + wave, NGW = G * NWAVES;
    for (int m = gw; m < M; m += NGW) {
        const int b = m >> 11, c = (m & 2047) >> 6, qi = m & 63, n = 64 * (c + 1), nw = n >> 5;
        if (n <= 256) { MB[(size_t)m * 64 + lane] = lane < nw ? 0xffffffffu : 0u; continue; }
        unsigned key[32];
        const float* row = SC + sc_base(b, c) + (size_t)qi * n + lane * 32;
        const bool act = lane < nw;
#pragma unroll
        for (int q = 0; q < 8; ++q) { f32x4 t = {0.f, 0.f, 0.f, 0.f}; if (act) t = *(const GAS f32x4*)(row + 4 * q);
#pragma unroll
            for (int e = 0; e < 4; ++e) { const unsigned u = __builtin_bit_cast(unsigned, t[e] + 0.0f); key[4 * q + e] = act ? (u ^ ((u >> 31) ? 0xffffffffu : 0x80000000u)) : 0u; } }
        unsigned prefix = 0u;
        for (int bit = 31; bit >= 0; --bit) {
            const unsigned cand = prefix | (1u << bit); int cnt = 0;
#pragma unroll
            for (int i = 0; i < 32; ++i) cnt += (key[i] >= cand) ? 1 : 0;
            if (wave_sum_i(cnt) >= 256) prefix = cand;
        }
        int gt = 0, eq = 0;
#pragma unroll
        for (int i = 0; i < 32; ++i) { gt += (key[i] > prefix) ? 1 : 0; eq += (key[i] == prefix) ? 1 : 0; }
        const int need = 256 - wave_sum_i(gt);
        int pe = eq;
#pragma unroll
        for (int o = 1; o < 64; o <<= 1) { const int t = __shfl_up(pe, o); if (lane >= o) pe += t; }
        int rk = pe - eq; unsigned word = 0u;
#pragma unroll
        for (int i = 0; i < 32; ++i) { const bool e = key[i] == prefix; const bool sel = (key[i] > prefix) || (e && rk < need); rk += e ? 1 : 0; word |= sel ? (1u << i) : 0u; }
        MB[(size_t)m * 64 + lane] = word;
    }
}

template <bool DSA> struct AttnCfg {
    static constexpr int DQK = DSA ? 128 : 192, NKS = DQK / 16, KSTR = DQK * 2 + 16, KBUF = 64 * KSTR, VSTR = 144, VBUF = 128 * VSTR, BUF = KBUF + VBUF;
    static constexpr int NKCH = DQK / 8, NKLD = 64 * NKCH / 512;
};
template <bool DSA>
__device__ __forceinline__ void attn_unit(unsigned char* ws, LAS unsigned char* lds, int b, int hh  , int blk  , int wave, int lane, int tid) {
    typedef AttnCfg<DSA> C;
    const int r = lane & 31, hk = lane >> 5;
    const int head = DSA ? 4 * hh + (wave >> 1) : hh;
    const int tok0 = DSA ? b * SEQ + 64 * blk + 32 * (wave & 1) : b * SEQ + 256 * blk + 32 * wave;
    const int ntw = DSA ? blk + 1 : 4 * blk + (wave >> 1) + 1;
    const int ntb = DSA ? blk + 1 : 4 * blk + 4;
    const bf16* Qp = DSA ? (const bf16*)(ws + WS_DQ) + (size_t)(tok0 + r) * 1024 + head * 128 : (const bf16*)(ws + WS_Q) + (size_t)(tok0 + r) * 1536 + head * 192;
    bf16x8 qf[C::NKS];
#pragma unroll
    for (int ks = 0; ks < C::NKS; ++ks) qf[ks] = *(const GAS bf16x8*)(Qp + 16 * ks + 8 * hk);
    const int skey = tid >> 3, sub = tid & 7;
    const bf16* ksrc0 = DSA ? (const bf16*)(ws + WS_DK) + ((size_t)b * SEQ + skey) * 256 + hh * 128 + sub * 8 : (const bf16*)(ws + WS_KN) + ((size_t)b * SEQ + skey) * 1024 + hh * 128 + sub * 8;
    const bf16* ksrc2 = (const bf16*)(ws + WS_KR) + ((size_t)b * SEQ + skey) * 64 + sub * 8;
    const int kdst = skey * C::KSTR + sub * 16;
    constexpr int KADV0 = DSA ? 64 * 256 : 64 * 1024, KADV2 = 64 * 64;
    const bf16* vsrc = (DSA ? (const bf16*)(ws + WS_DVT) : (const bf16*)(ws + WS_VT)) + (size_t)(hh * 128 + skey) * M + (size_t)b * SEQ + sub * 8;
    const int vdst = C::KBUF + skey * C::VSTR + sub * 16;
    v4u kreg[C::NKLD], vreg[2];
#define ATT_LOAD(kt_) do { kreg[0] = *(const GAS v4u*)(ksrc0 + (size_t)(kt_) * KADV0); kreg[1] = *(const GAS v4u*)(ksrc0 + (size_t)(kt_) * KADV0 + 64); \
        if (!DSA) kreg[C::NKLD - 1] = *(const GAS v4u*)(ksrc2 + (size_t)(kt_) * KADV2); \
        vreg[0] = *(const GAS v4u*)(vsrc + (size_t)(kt_) * 64); vreg[1] = *(const GAS v4u*)(vsrc + (size_t)64 * M + (size_t)(kt_) * 64); } while (0)
#define ATT_STORE(buf_) do { LAS unsigned char* bb_ = lds + (buf_) * C::BUF; *(LAS v4u*)(bb_ + kdst) = kreg[0]; *(LAS v4u*)(bb_ + kdst + 128) = kreg[1]; \
        if (!DSA) *(LAS v4u*)(bb_ + kdst + 256) = kreg[C::NKLD - 1]; \
        *(LAS v4u*)(bb_ + vdst) = vreg[0]; *(LAS v4u*)(bb_ + vdst + 64 * C::VSTR) = vreg[1]; } while (0)
    ATT_LOAD(0); ATT_STORE(0);
    __syncthreads();
    f32x16 o[4];
#pragma unroll
    for (int dt = 0; dt < 4; ++dt)
#pragma unroll
        for (int e = 0; e < 16; ++e) o[dt][e] = 0.f;
    float mrun = -1e30f, lrun = 0.f;
    const unsigned long long* mbp = (const unsigned long long*)((const unsigned*)(ws + WS_MB) + (size_t)(tok0 + r) * 64);
    for (int kt = 0; kt < ntb; ++kt) {
        const int cur = kt & 1;
        if (kt + 1 < ntb) ATT_LOAD(kt + 1);
        if (kt < ntw) {
            const LAS unsigned char* kb = lds + cur * C::BUF; const LAS unsigned char* vb = kb + C::KBUF;
            f32x16 st[2];
#pragma unroll
            for (int kh = 0; kh < 2; ++kh) {
                asm volatile("" ::: "memory");
#pragma unroll
                for (int e = 0; e < 16; ++e) st[kh][e] = 0.f;
#pragma unroll
                for (int ks = 0; ks < C::NKS; ++ks) { if ((ks & 3) == 0 && ks) asm volatile("" ::: "memory"); const bf16x8 kf = *(const LAS bf16x8*)(kb + (32 * kh + r) * C::KSTR + (16 * ks + 8 * hk) * 2);
                    st[kh] = __builtin_amdgcn_mfma_f32_32x32x16_bf16(kf, qf[ks], st[kh], 0, 0, 0); }
            }
            if (DSA) {
                const unsigned long long w = mbp[kt];
                const unsigned w0 = (unsigned)w >> (4 * hk), w1 = (unsigned)(w >> 32) >> (4 * hk);
#pragma unroll
                for (int e = 0; e < 16; ++e) { const int cb = (e & 3) + 8 * (e >> 2);
                    st[0][e] = ((w0 >> cb) & 1u) ? st[0][e] : -__builtin_inff(); st[1][e] = ((w1 >> cb) & 1u) ? st[1][e] : -__builtin_inff(); }
            }
            float mx = st[0][0];
#pragma unroll
            for (int e = 1; e < 16; ++e) mx = fmaxf(mx, st[0][e]);
#pragma unroll
            for (int e = 0; e < 16; ++e) mx = fmaxf(mx, st[1][e]);
            mx = fmaxf(mx, __shfl_xor(mx, 32));
            const float mnew = fmaxf(mrun, mx), alpha = __builtin_amdgcn_exp2f(mrun - mnew);
            mrun = mnew;
            float ps = 0.f;
#pragma unroll
            for (int kh = 0; kh < 2; ++kh)
#pragma unroll
                for (int e = 0; e < 16; ++e) { st[kh][e] = __builtin_amdgcn_exp2f(st[kh][e] - mnew); ps += st[kh][e]; }
            ps += __shfl_xor(ps, 32);
            lrun = lrun * alpha + ps;
#pragma unroll
            for (int dt = 0; dt < 4; ++dt)
#pragma unroll
                for (int e = 0; e < 16; ++e) o[dt][e] *= alpha;
            bf16x8 pf[4];
#pragma unroll
            for (int s = 0; s < 4; ++s) { const int kh = s >> 1, e0 = 8 * (s & 1); v4u w;
                w.x = pk2(st[kh][e0], st[kh][e0 + 1]); w.y = pk2(st[kh][e0 + 2], st[kh][e0 + 3]); w.z = pk2(st[kh][e0 + 4], st[kh][e0 + 5]); w.w = pk2(st[kh][e0 + 6], st[kh][e0 + 7]);
                pf[s] = __builtin_bit_cast(bf16x8, w); }
#pragma unroll
            for (int dt = 0; dt < 4; ++dt) {
                asm volatile("" ::: "memory");
#pragma unroll
                for (int s = 0; s < 4; ++s) { const bf16x8 vf = *(const LAS bf16x8*)(vb + (32 * dt + r) * C::VSTR + (16 * s + 8 * hk) * 2);
                    o[dt] = __builtin_amdgcn_mfma_f32_32x32x16_bf16(vf, pf[s], o[dt], 0, 0, 0); } }
        }
        if (kt + 1 < ntb) ATT_STORE(cur ^ 1);
        __syncthreads();
    }
    const float inv = 1.0f / lrun;
    bf16* Op = (DSA ? (bf16*)(ws + WS_OB) : (bf16*)(ws + WS_OA)) + (size_t)(tok0 + r) * 1024 + head * 128 + 4 * hk;
#pragma unroll
    for (int dt = 0; dt < 4; ++dt)
#pragma unroll
        for (int g = 0; g < 4; ++g) { v2u w; w.x = pk2(o[dt][4 * g] * inv, o[dt][4 * g + 1] * inv); w.y = pk2(o[dt][4 * g + 2] * inv, o[dt][4 * g + 3] * inv);
            *(GAS v2u*)(Op + 32 * dt + 8 * g) = w; }
}
#undef ATT_LOAD
#undef ATT_STORE
__device__ __forceinline__ void p4_attention(unsigned char* ws, LAS unsigned char* lds, int bx, int G, int wave, int lane) {
    const int tid = wave * 64 + lane;
    for (int i = bx; i < 256; i += G) {
        const int xcd = i & 7, idx = i >> 3;
#ifndef NO_MLA
        { const int bh = (idx >> 2) * 8 + xcd, qp = idx & 3, b = bh >> 3, h = bh & 7;
          attn_unit<false>(ws, lds, b, h, 7 - qp, wave, lane, tid); attn_unit<false>(ws, lds, b, h, qp, wave, lane, tid); }
#endif
#ifndef NO_DSA
        { const int bg = (idx >> 4) * 8 + xcd, cp = idx & 15, b = bg >> 1, g = bg & 1;
          attn_unit<true>(ws, lds, b, g, 31 - cp, wave, lane, tid); attn_unit<true>(ws, lds, b, g, cp, wave, lane, tid); }
#endif
    }
}

typedef __bf16 bf16x2_t __attribute__((ext_vector_type(2)));
__device__ __forceinline__ float dot2bf(unsigned w, unsigned x, float acc) { return __builtin_amdgcn_fdot2_f32_bf16(__builtin_bit_cast(bf16x2_t, w), __builtin_bit_cast(bf16x2_t, x), acc, false); }
#ifndef P8_BATCH
#define P8_BATCH 2
#endif
typedef float f32x2v __attribute__((ext_vector_type(2)));
struct P8Set { v4u u[P8_BATCH][2], v[P8_BATCH][2]; float su[P8_BATCH], sv[P8_BATCH], g[P8_BATCH]; };
__device__ __forceinline__ void p8_load(P8Set& s, const unsigned char* U8, const unsigned char* V8, const float* USC, const float* VSC, const LAS int* EXi, const LAS float* EXg, int e0, int lane) {
#pragma unroll
    for (int q = 0; q < P8_BATCH; ++q) {
        const int ex = __builtin_amdgcn_readfirstlane(EXi[e0 + q]); s.g[q] = __builtin_bit_cast(float, __builtin_amdgcn_readfirstlane(__builtin_bit_cast(int, EXg[e0 + q])));
        const unsigned char* up = U8 + (size_t)ex * D + lane * 16; const unsigned char* vp = V8 + (size_t)ex * D + lane * 16;
        s.u[q][0] = *(const GAS v4u*)up; s.u[q][1] = *(const GAS v4u*)(up + 1024); s.v[q][0] = *(const GAS v4u*)vp; s.v[q][1] = *(const GAS v4u*)(vp + 1024);
        s.su[q] = USC[ex]; s.sv[q] = VSC[ex];
    }
}
__device__ __forceinline__ void p8_compute(const P8Set& s, const f32x4 (&xn)[8], f32x4 (&acc)[8]) {
#pragma unroll
    for (int q = 0; q < P8_BATCH; ++q) {
        float d0 = 0.f, d1 = 0.f, d2 = 0.f, d3 = 0.f;
#pragma unroll
        for (int j = 0; j < 2; ++j)
#pragma unroll
            for (int c = 0; c < 4; ++c) { const unsigned w = s.u[q][j][c]; const f32x2v lo = __builtin_amdgcn_cvt_pk_f32_fp8(w, false), hi = __builtin_amdgcn_cvt_pk_f32_fp8(w, true); const f32x4 x = xn[4 * j + c];
                d0 += lo.x * x.x; d1 += lo.y * x.y; d2 += hi.x * x.z; d3 += hi.y * x.w; }
        const float z = wave_sum((d0 + d1) + (d2 + d3)) * s.su[q];
        const float coef = s.g[q] * s.sv[q] * 0.5f * z * (1.0f + erff(z * 0.70710678118654752f));
#pragma unroll
        for (int j = 0; j < 2; ++j)
#pragma unroll
            for (int c = 0; c < 4; ++c) { const unsigned w = s.v[q][j][c]; const f32x2v lo = __builtin_amdgcn_cvt_pk_f32_fp8(w, false), hi = __builtin_amdgcn_cvt_pk_f32_fp8(w, true);
                acc[4 * j + c].x += coef * lo.x; acc[4 * j + c].y += coef * lo.y; acc[4 * j + c].z += coef * hi.x; acc[4 * j + c].w += coef * hi.y; }
    }
}
__device__ __forceinline__ void p8_peer(const Args& a, LAS unsigned char* lds, int vcu, int G, int wave, int lane_in) {
    unsigned char* ws = a.ws;
    const unsigned char* U8 = ws + WS_U; const unsigned char* V8 = ws + WS_V; const float* USC = (const float*)(ws + WS_USC); const float* VSC = (const float*)(ws + WS_VSC); const float* S = (const float*)(ws + WS_S);
    LAS float* T1v = (LAS float*)(lds + wave * 16384);
    LAS int*   T1i = (LAS int*)(lds + wave * 16384 + 1024);
    LAS float* EXg = (LAS float*)(lds + wave * 16384 + 2048);
    LAS int*   EXi = (LAS int*)(lds + wave * 16384 + 2560);
    const int gw = vcu * NWAVES + wave, NGW = G * NWAVES;
    const float NINF = -__builtin_inff();
    for (int m = gw; m < M; m += NGW) {
        int lane = lane_in; asm volatile("" : "+v"(lane));
        const float* xrow = a.out + (size_t)m * D;
        float rstd;
        { f32x4 xt[8]; float ss = 0.f;
#pragma unroll
          for (int j = 0; j < 2; ++j)
#pragma unroll
            for (int c = 0; c < 4; ++c) xt[4 * j + c] = *(const GAS f32x4*)(xrow + j * 1024 + lane * 16 + 4 * c);
#pragma unroll
          for (int j = 0; j < 8; ++j) ss += (xt[j].x * xt[j].x + xt[j].y * xt[j].y) + (xt[j].z * xt[j].z + xt[j].w * xt[j].w);
          rstd = 1.0f / sqrtf(wave_sum(ss) * (1.f / D) + EPS); }
        {
            float sv[32];
#pragma unroll
            for (int q = 0; q < 8; ++q) { const f32x4 t = *(const GAS f32x4*)(S + (size_t)m * 2048 + lane * 32 + q * 4); sv[4 * q] = t.x; sv[4 * q + 1] = t.y; sv[4 * q + 2] = t.z; sv[4 * q + 3] = t.w; }
            const int qb = (lane & 3) * 32;
#pragma unroll 1
            for (int it = 0; it < 16; ++it) {
                float mx = sv[0];
#pragma unroll
                for (int i = 1; i < 32; ++i) mx = fmaxf(mx, sv[i]);
                float qm = fmaxf(mx, __shfl_xor(mx, 1)); qm = fmaxf(qm, __shfl_xor(qm, 2));
                int bi = 1000;
#pragma unroll
                for (int i = 31; i >= 0; --i) bi = (sv[i] == qm) ? (qb + i) : bi;
                int qi = min(bi, __shfl_xor(bi, 1)); qi = min(qi, __shfl_xor(qi, 2));
                const int li = qi - qb;
#pragma unroll
                for (int i = 0; i < 32; ++i) sv[i] = (i == li) ? NINF : sv[i];
                if ((lane & 3) == 0) { T1v[(lane >> 2) * 16 + it] = qm; T1i[(lane >> 2) * 16 + it] = qi; }
            }
        }
        LDS_WAIT(); asm volatile("" ::: "memory");
        {
            const int h = lane >> 3, e = lane & 7;
            const LAS float* s1p = T1v + (2 * h) * 16; const LAS float* s2p = T1v + (2 * h + 1) * 16;
            const float s1a = s1p[e], s1b = s1p[e + 8];
            float cv[17];
#pragma unroll
            for (int k = 0; k < 16; ++k) cv[k] = ((e + 1) * (k + 1) <= 16) ? s1a + s2p[k] : NINF;
            cv[16] = s1b + s2p[0];
            float smax = 0.f, den = 0.f;
#pragma unroll 1
            for (int it = 0; it < 16; ++it) {
                float mx = cv[0];
#pragma unroll
                for (int k = 1; k < 17; ++k) mx = fmaxf(mx, cv[k]);
                float gm = fmaxf(mx, __shfl_xor(mx, 1)); gm = fmaxf(gm, __shfl_xor(gm, 2)); gm = fmaxf(gm, __shfl_xor(gm, 4));
                int bp = 100000;
                bp = (cv[16] == gm) ? ((e + 8) * 16) : bp;
#pragma unroll
                for (int k = 15; k >= 0; --k) bp = (cv[k] == gm) ? (e * 16 + k) : bp;
                int gp = min(bp, __shfl_xor(bp, 1)); gp = min(gp, __shfl_xor(gp, 2)); gp = min(gp, __shfl_xor(gp, 4));
                const int lk = (gp == (e + 8) * 16) ? 16 : (((gp >> 4) == e) ? (gp & 15) : -1);
#pragma unroll
                for (int k = 0; k < 17; ++k) cv[k] = (k == lk) ? NINF : cv[k];
                if (it == 0) smax = gm;
                const float ex = __expf((gm - smax) * rstd); den += ex;
                if (e == 0) { const int r1 = gp >> 4, r2 = gp & 15; EXg[h * 16 + it] = ex; EXi[h * 16 + it] = T1i[(2 * h) * 16 + r1] * 128 + T1i[(2 * h + 1) * 16 + r2]; }
            }
            LDS_WAIT(); asm volatile("" ::: "memory");
            const float inv = 1.0f / den;
            EXg[h * 16 + 2 * e] *= inv; EXg[h * 16 + 2 * e + 1] *= inv;
        }
        LDS_WAIT(); asm volatile("" ::: "memory");
        f32x4 acc[8], xn[8];
#pragma unroll
        for (int j = 0; j < 8; ++j) acc[j] = (f32x4){0.f, 0.f, 0.f, 0.f};
#pragma unroll
        for (int j = 0; j < 2; ++j)
#pragma unroll
            for (int c = 0; c < 4; ++c) xn[4 * j + c] = *(const GAS f32x4*)(xrow + j * 1024 + lane * 16 + 4 * c) * rstd * *(const f32x4*)(a.g_ffn + j * 1024 + lane * 16 + 4 * c);
        {
            P8Set sa, sb;
            p8_load(sa, U8, V8, USC, VSC, EXi, EXg, 0, lane);
#pragma unroll 1
            for (int e0 = 0; e0 < 128; e0 += 2 * P8_BATCH) {
                p8_load(sb, U8, V8, USC, VSC, EXi, EXg, e0 + P8_BATCH, lane);
                p8_compute(sa, xn, acc);
                if (e0 + 2 * P8_BATCH < 128) p8_load(sa, U8, V8, USC, VSC, EXi, EXg, e0 + 2 * P8_BATCH, lane);
                p8_compute(sb, xn, acc);
            }
        }
        float s2 = 0.f;
#pragma unroll
        for (int j = 0; j < 2; ++j)
#pragma unroll
            for (int c = 0; c < 4; ++c) { acc[4 * j + c] = acc[4 * j + c] + *(const GAS f32x4*)(xrow + j * 1024 + lane * 16 + 4 * c); }
#pragma unroll
        for (int j = 0; j < 8; ++j) s2 += (acc[j].x * acc[j].x + acc[j].y * acc[j].y) + (acc[j].z * acc[j].z + acc[j].w * acc[j].w);
        const float rstd2 = 1.0f / sqrtf(wave_sum(s2) * (1.f / D) + EPS);
        float* orow = a.out + (size_t)m * D;
#pragma unroll
        for (int j = 0; j < 2; ++j)
#pragma unroll
            for (int c = 0; c < 4; ++c) *(GAS f32x4*)(orow + j * 1024 + lane * 16 + 4 * c) = acc[4 * j + c] * rstd2 * *(const f32x4*)(a.g_fin + j * 1024 + lane * 16 + 4 * c);
        LDS_WAIT(); asm volatile("" ::: "memory");
    }
}

#ifndef N_LAUNCHES
#define N_LAUNCHES 1
#endif
constexpr int NPHASE = 9;
__global__ void __launch_bounds__(NWAVES * 64, 2) mk_fwd(Args args) {
    extern __shared__ __attribute__((aligned(16))) unsigned char lds_raw[];
    LAS unsigned char* lds = (LAS unsigned char*)lds_raw;
    volatile LAS unsigned* MISC = (volatile LAS unsigned*)(lds + MISC_OFF);
    const int wave = __builtin_amdgcn_readfirstlane(threadIdx.x >> 6);
#define lane (lane_id())
#define tid (wave * 64 + lane)
    const int G = gridDim.x; const int bx = blockIdx.x; const int vcu = (G % 8 == 0) ? (bx % 8) * (G / 8) + bx / 8 : bx;
    unsigned char* ws = args.ws;
    gu32* ctl = (gu32*)(ws + WS_CTL);
    for (int u = tid; u < (LDS_BYTES - LDSCTL_OFF) / 4; u += NWAVES * 64) ((LAS unsigned*)(lds + LDSCTL_OFF))[u] = 0u;
    __syncthreads();
    XcdBarrier bar; bar.bar = (unsigned*)(ctl + CW_BAR); bar.x = 0; bar.st = nullptr;
    if (N_LAUNCHES == 1) bar = xcd_barrier_post((unsigned*)(ctl + CW_BAR), MISC + 8);
    const int lo = args.ph_lo, hi = args.ph_hi;
#ifndef PHMASK
#define PHMASK 0x1ff
#endif
#define IN(k) (((PHMASK >> (k)) & 1) && lo <= (k) && (k) < hi)
#define GRID_BAR(k) do { if (IN(k) && IN((k) + 1)) xcd_barrier(bar, wave == 0 && lane == 0); } while (0)

    if (IN(0)) { p0_prologue(args, lds, vcu, G, wave, lane); }
    GRID_BAR(0);
    if (IN(1)) {
        pg8::Gemm g{(const bf16*)(ws + WS_XN), (const bf16*)(ws + WS_XN), M, N1, D}; Order<1> S; S.init(64, 30, G, bx);
        Epi1 E{ws, (bf16*)args.out};
        pg8::gemm_phase<Epi1, Order<1>, true, true>(lds + RING_OFF, g, S, E, wave);
    }
    GRID_BAR(1);
    if (IN(2)) { p2_rowstats(ws, vcu, G, wave, lane); p2_indexer(ws, lds, bx, G, wave, lane); }
    GRID_BAR(2);
    if (IN(3)) {
        { pg8::Gemm g{(const bf16*)(ws + WS_CQ), (const bf16*)(ws + WS_WUQ), M, 1536, 512}; Order<0> S; S.init(64, 6, G, bx); Epi3q E{ws};
          pg8::gemm_phase<Epi3q, Order<0>, true, true>(lds + RING_OFF, g, S, E, wave); }
        { pg8::Gemm g{(const bf16*)(ws + WS_CKV), (const bf16*)(ws + WS_CKV), M, 2048, 256}; Order<2> S; S.init(64, 8, G, bx); Epi3k E{ws};
          pg8::gemm_phase<Epi3k, Order<2>, true, true>(lds + RING_OFF, g, S, E, wave); }
        p3_select(ws, vcu, G, wave, lane);
    }
    GRID_BAR(3);
    if (IN(4)) { p4_attention(ws, lds, bx, G, wave, lane); }
    GRID_BAR(4);
    if (IN(5)) {
        pg8::Gemm g{(const bf16*)(ws + WS_OA), (const bf16*)(ws + WS_WAB), 2 * M, 4096, 1024}; Order<3> S; S.init(64, 8, G, bx); Epi5 E{ws, (const bf16*)args.out};
        pg8::gemm_phase<Epi5, Order<3>, true, true>(lds + RING_OFF, g, S, E, wave);
    }
    GRID_BAR(5);
    if (IN(6)) {
        pg8::Gemm g{(const bf16*)(ws + WS_MRG), (const bf16*)(ws + WS_WO), M, D, D}; Order<0> S; S.init(64, 8, G, bx); Epi6 E{ws, args.x, args.out};
        pg8::gemm_phase<Epi6, Order<0>, true, true>(lds + RING_OFF, g, S, E, wave);
    }
    GRID_BAR(6);
    if (IN(7)) {
        pg8::Gemm g{(const bf16*)(ws + WS_X1B), (const bf16*)(ws + WS_W2), M, D, D}; Order<0> S; S.init(64, 8, G, bx); Epi7 E{ws};
        pg8::gemm_phase<Epi7, Order<0>, true, true>(lds + RING_OFF, g, S, E, wave);
    }
    GRID_BAR(7);
    if (IN(8)) { p8_peer(args, lds, vcu, G, wave, lane); }
#undef IN
#undef GRID_BAR
#undef lane
#undef tid
}

extern "C" void kernel_launch(void* const* d_in, const int* in_sizes, int n_in, void* d_out, int out_size, void* d_ws, size_t ws_size, hipStream_t stream) {
    static int grid = 0;
    if (grid == 0) {
        if (n_in != 18 || in_sizes[0] != M * D || out_size != M * D || ws_size < WS_END) { fprintf(stderr, "kernel_launch: unexpected problem (n_in %d, in0 %d, out %d, ws %zu)\n", n_in, n_in > 0 ? in_sizes[0] : -1, out_size, ws_size); grid = -1; return; }
        int dev = 0, cus = 0, per_cu = 0;
        if (hipGetDevice(&dev) != hipSuccess || hipDeviceGetAttribute(&cus, hipDeviceAttributeMultiprocessorCount, dev) != hipSuccess) { grid = -1; return; }
        if (hipFuncSetAttribute((const void*)mk_fwd, hipFuncAttributeMaxDynamicSharedMemorySize, LDS_BYTES) != hipSuccess) { fprintf(stderr, "kernel_launch: hipFuncSetAttribute failed\n"); grid = -1; return; }
        if (hipOccupancyMaxActiveBlocksPerMultiprocessor(&per_cu, (const void*)mk_fwd, NWAVES * 64, LDS_BYTES) != hipSuccess || per_cu < 1)
            fprintf(stderr, "kernel_launch: note: occupancy query reports %d workgroups per CU\n", per_cu);
        (void)hipGetLastError();
        grid = cus;
    }
    if (grid < 0) return;
    if (hipMemsetAsync((char*)d_ws + WS_CTL, 0, CTL_ZERO_BYTES, stream) != hipSuccess) return;
    Args a{};
    a.x = (const float*)d_in[0]; a.pos = (const int*)d_in[1]; a.g_mix = (const float*)d_in[2]; a.w_in = (const float*)d_in[3]; a.g_q = (const float*)d_in[4]; a.g_kv = (const float*)d_in[5];
    a.w_uq = (const float*)d_in[6]; a.w_uk = (const float*)d_in[7]; a.w_uv = (const float*)d_in[8]; a.w_a = (const float*)d_in[9]; a.w_b = (const float*)d_in[10]; a.w_o = (const float*)d_in[11];
    a.g_ffn = (const float*)d_in[12]; a.w_pq = (const float*)d_in[13]; a.subk = (const float*)d_in[14]; a.pu = (const float*)d_in[15]; a.pv = (const float*)d_in[16]; a.g_fin = (const float*)d_in[17];
    a.out = (float*)d_out; a.ws = (unsigned char*)d_ws;
    for (int i = 0; i < 32; ++i) a.invf[i] = pow(500000.0, -(2.0 * i) / 64.0);
    for (int i = 0; i < 16; ++i) a.invf[32 + i] = pow(500000.0, -(2.0 * i) / 32.0);
    for (int i = 0; i < 8; ++i) a.invf[48 + i] = pow(500000.0, -(2.0 * i) / 16.0);
    if (N_LAUNCHES == 1) { a.ph_lo = 0; a.ph_hi = NPHASE; hipLaunchKernelGGL(mk_fwd, dim3(grid), dim3(NWAVES * 64), LDS_BYTES, stream, a); }
    else for (int li = 0; li < NPHASE; ++li) { a.ph_lo = li; a.ph_hi = li + 1; hipLaunchKernelGGL(mk_fwd, dim3(grid), dim3(NWAVES * 64), LDS_BYTES, stream, a); }
}
```

```cpp
#include <hip/hip_runtime.h>
#include <cstdio>
#include <cstdint>
#include <cmath>
namespace pg8 {
#define PG8_LAS __attribute__((address_space(3)))
typedef unsigned short bf16_t;
typedef short bf16x8 __attribute__((ext_vector_type(8)));
typedef float f32x4 __attribute__((ext_vector_type(4)));
typedef unsigned u32x4 __attribute__((ext_vector_type(4)));
constexpr int BM = 256, BK = 64, HALF = 128, HTB = HALF * BK * 2  , STAGE_BYTES = 8 * HTB, NXCD = 8, WGM = 8;

__host__ __device__ __forceinline__ int lds_byte(int r, int c) { const int st = (r >> 4) * 2 + (c >> 5), rr = r & 15, cc = c & 31, ob = rr * 64 + cc * 2; return st * 1024 + (ob ^ (((ob >> 9) & 1) << 5)); }
__host__ __device__ __forceinline__ void stage_rc(int b, int& R, int& C) { const int st = b / 1024, sb = b % 1024, swz = sb ^ (((sb >> 9) & 1) << 5); R = (st >> 1) * 16 + swz / 64; C = (st & 1) * 32 + (swz % 64) / 2; }
__host__ __device__ __forceinline__ int perm32(int rho) { const int n = rho >> 4, i = rho & 15; return 8 * (i >> 2) + 4 * n + (i & 3); }

struct Unit { int pm, pn; };
struct Gemm { const bf16_t* A; const bf16_t* Bt; int M, N, K; };

template <class Epi, class Sched, bool ALIGN_EPI = false, bool SP2 = false>
__device__ __forceinline__ void gemm_phase(PG8_LAS unsigned char* lds, const Gemm g, const Sched& S, const Epi& E, const int wid) {
    int lane; asm volatile("v_mbcnt_lo_u32_b32 %0, -1, 0\n\tv_mbcnt_hi_u32_b32 %0, -1, %0" : "=v"(lane)); const int tid = wid * 64 + lane, wr = wid >> 2, wc = wid & 3, fr = lane & 15, fq = lane >> 4;
    const int K = g.K, nt = K / BK;
    unsigned voffA[2], voffB[2];
#pragma unroll
    for (int i = 0; i < 2; ++i) { int R, C; stage_rc(tid * 16 + i * 8192, R, C); const int Rb = Epi::PERM ? ((R & ~31) + perm32(R & 31)) : R;
        voffA[i] = (unsigned)(R * K + C) * 2u; voffB[i] = (unsigned)(Rb * K + C) * 2u; }
    const size_t kstep = (size_t)(BK * 2);
    const size_t hstep = (size_t)HALF * K * 2;
    const size_t tstep = 2 * hstep;
    const unsigned ldsw = (unsigned)wid * 1024u;
    const int aoff = lds_byte(wr * 64 + fr, fq * 8), boff = lds_byte(wc * 32 + fr, fq * 8);
#define PG8_SA(b, h) (((b) * 2 + (h)) * HTB)
#define PG8_SB(b, h) ((4 + (b) * 2 + (h)) * HTB)
#define PG8_STAGE(bufoff, gbase, voff) do { _Pragma("unroll") for (int _i = 0; _i < 2; ++_i) \
        __builtin_amdgcn_global_load_lds((const unsigned*)((const char*)(gbase) + (voff)[_i]), (PG8_LAS unsigned*)(lds + (bufoff) + ldsw + _i * 8192), 16, 0, 0); } while (0)
#define PG8_LDA(dst, b, h) do { _Pragma("unroll") for (int m = 0; m < 4; ++m) _Pragma("unroll") for (int k = 0; k < 2; ++k) dst[m][k] = *(const PG8_LAS bf16x8*)(lds + PG8_SA(b, h) + aoff + m * 2048 + k * 1024); } while (0)
#define PG8_LDB(dst, b, h) do { _Pragma("unroll") for (int n = 0; n < 2; ++n) _Pragma("unroll") for (int k = 0; k < 2; ++k) dst[n][k] = *(const PG8_LAS bf16x8*)(lds + PG8_SB(b, h) + boff + n * 2048 + k * 1024); } while (0)
#define PG8_MMA(ai, bj, At, Bt) do { __builtin_amdgcn_s_setprio(1); _Pragma("unroll") for (int m = 0; m < 4; ++m) _Pragma("unroll") for (int n = 0; n < 2; ++n) _Pragma("unroll") for (int k = 0; k < 2; ++k) \
        acc[ai][bj][m][n] = __builtin_amdgcn_mfma_f32_16x16x32_bf16(Bt[n][k], At[m][k], acc[ai][bj][m][n], 0, 0, 0); __builtin_amdgcn_s_setprio(0); } while (0)
#define PG8_WAIT_V(n) asm volatile("s_waitcnt vmcnt(" #n ")" ::: "memory")
#define PG8_WAIT_L(n) asm volatile("s_waitcnt lgkmcnt(" #n ")" ::: "memory")
#define PG8_BAR __builtin_amdgcn_s_barrier()
#define PG8_SCHED __builtin_amdgcn_sched_barrier(0)
    Unit cur, nxt; int ui = 0;
    if (!S.next(0, cur)) return;
    f32x4 acc[2][2][4][2];
#pragma unroll
    for (int a = 0; a < 2; ++a)
#pragma unroll
        for (int b = 0; b < 2; ++b)
#pragma unroll
            for (int m = 0; m < 4; ++m)
#pragma unroll
                for (int n = 0; n < 2; ++n) acc[a][b][m][n] = (f32x4){0.f, 0.f, 0.f, 0.f};
    bf16x8 At[4][2], B0[2][2], B1[2][2];
    const char* cA = (const char*)g.A + (size_t)cur.pm * tstep; const char* cB = (const char*)g.Bt + (size_t)cur.pn * tstep;
    S.a_ready(cur);
    if constexpr (SP2) {
        PG8_STAGE(PG8_SB(0, 0), cB, voffB); PG8_STAGE(PG8_SB(0, 1), cB + hstep, voffB); PG8_STAGE(PG8_SA(0, 0), cA, voffA); PG8_STAGE(PG8_SA(0, 1), cA + hstep, voffA);
        if (wr == 1) PG8_BAR;
        PG8_WAIT_V(2); PG8_BAR;
        PG8_STAGE(PG8_SB(1, 0), cB + kstep, voffB); PG8_STAGE(PG8_SA(1, 0), cA + kstep, voffA); PG8_STAGE(PG8_SB(1, 1), cB + hstep + kstep, voffB);
        PG8_WAIT_V(6); PG8_BAR;
    } else {
        PG8_STAGE(PG8_SB(0, 0), cB, voffB); PG8_STAGE(PG8_SA(0, 0), cA, voffA); PG8_STAGE(PG8_SB(0, 1), cB + hstep, voffB); PG8_STAGE(PG8_SA(0, 1), cA + hstep, voffA);
        if (wr == 1) PG8_BAR;
        PG8_WAIT_V(4); PG8_BAR;
        PG8_STAGE(PG8_SB(1, 0), cB + kstep, voffB); PG8_STAGE(PG8_SA(1, 0), cA + kstep, voffA); PG8_STAGE(PG8_SB(1, 1), cB + hstep + kstep, voffB);
        PG8_WAIT_V(6); PG8_BAR;
    }
    for (;;) {
        const bool has_next = S.next(ui + 1, nxt);
        const char* nA = has_next ? (const char*)g.A + (size_t)nxt.pm * tstep : cA; const char* nB = has_next ? (const char*)g.Bt + (size_t)nxt.pn * tstep : cB;
        for (int t = 0; t < nt; t += 2) {
            const bool last = (t == nt - 2);
            const char* a1 = cA + (size_t)(t + 1) * kstep;
            const char* a2 = last ? nA : cA + (size_t)(t + 2) * kstep; const char* b2 = last ? nB : cB + (size_t)(t + 2) * kstep;
            const char* a3 = a2 + kstep; const char* b3 = b2 + kstep;
            if (last && has_next) S.a_ready(nxt);
            if constexpr (SP2) {
            PG8_LDB(B0, 0, 0); PG8_LDB(B1, 0, 1); PG8_SCHED; PG8_LDA(At, 0, 0); PG8_STAGE(PG8_SA(1, 1), a1 + hstep, voffA);
            PG8_WAIT_V(8); PG8_WAIT_L(0); PG8_BAR; PG8_MMA(0, 0, At, B0); PG8_MMA(0, 1, At, B1); PG8_BAR; PG8_SCHED;
            PG8_LDA(At, 0, 1); PG8_STAGE(PG8_SB(0, 0), b2, voffB); PG8_STAGE(PG8_SB(0, 1), b2 + hstep, voffB); PG8_STAGE(PG8_SA(0, 0), a2, voffA);
            PG8_WAIT_V(8); PG8_WAIT_L(0); PG8_BAR; PG8_MMA(1, 0, At, B0); PG8_MMA(1, 1, At, B1); PG8_BAR; PG8_SCHED;
            PG8_LDB(B0, 1, 0); PG8_LDB(B1, 1, 1); PG8_SCHED; PG8_LDA(At, 1, 0); PG8_STAGE(PG8_SA(0, 1), a2 + hstep, voffA);
            PG8_WAIT_V(8); PG8_WAIT_L(0); PG8_BAR; PG8_MMA(0, 0, At, B0); PG8_MMA(0, 1, At, B1); PG8_BAR; PG8_SCHED;
            PG8_LDA(At, 1, 1); PG8_STAGE(PG8_SB(1, 0), b3, voffB); PG8_STAGE(PG8_SB(1, 1), b3 + hstep, voffB); PG8_STAGE(PG8_SA(1, 0), a3, voffA);
            PG8_WAIT_V(8); PG8_WAIT_L(0); PG8_BAR; PG8_MMA(1, 0, At, B0); PG8_MMA(1, 1, At, B1); PG8_BAR; PG8_SCHED;
            } else {
            PG8_LDB(B0, 0, 0); PG8_SCHED; PG8_LDA(At, 0, 0); PG8_STAGE(PG8_SA(1, 1), a1 + hstep, voffA);
            PG8_WAIT_L(8); PG8_BAR; PG8_WAIT_L(0); PG8_MMA(0, 0, At, B0); PG8_BAR; PG8_SCHED;
            PG8_LDB(B1, 0, 1); PG8_STAGE(PG8_SB(0, 0), b2, voffB);
            PG8_BAR; PG8_WAIT_L(0); PG8_MMA(0, 1, At, B1); PG8_BAR;
            PG8_LDA(At, 0, 1); PG8_STAGE(PG8_SA(0, 0), a2, voffA);
            PG8_BAR; PG8_WAIT_L(0); PG8_MMA(1, 0, At, B0); PG8_BAR; PG8_SCHED;
            PG8_STAGE(PG8_SB(0, 1), b2 + hstep, voffB);
            PG8_WAIT_V(6); PG8_BAR; PG8_MMA(1, 1, At, B1); PG8_BAR;
            PG8_LDB(B0, 1, 0); PG8_SCHED; PG8_LDA(At, 1, 0); PG8_STAGE(PG8_SA(0, 1), a2 + hstep, voffA);
            PG8_WAIT_L(8); PG8_BAR; PG8_WAIT_L(0); PG8_MMA(0, 0, At, B0); PG8_BAR; PG8_SCHED;
            PG8_LDB(B1, 1, 1); PG8_STAGE(PG8_SB(1, 0), b3, voffB);
            PG8_BAR; PG8_WAIT_L(0); PG8_MMA(0, 1, At, B1); PG8_BAR;
            PG8_LDA(At, 1, 1); PG8_STAGE(PG8_SA(1, 0), a3, voffA);
            PG8_BAR; PG8_WAIT_L(0); PG8_MMA(1, 0, At, B0); PG8_BAR; PG8_SCHED;
            PG8_STAGE(PG8_SB(1, 1), b3 + hstep, voffB);
            PG8_WAIT_V(6); PG8_BAR; PG8_MMA(1, 1, At, B1); PG8_BAR;
            }
        }
        if constexpr (ALIGN_EPI) { if (wr == 0) PG8_BAR; }
        if constexpr (!Epi::AFTER_DRAIN) { E(acc, cur, wr, wc, fr, fq); S.done(cur); }
        if (!has_next) break;
#pragma unroll
        for (int a = 0; a < 2; ++a)
#pragma unroll
            for (int b = 0; b < 2; ++b)
#pragma unroll
                for (int m = 0; m < 4; ++m)
#pragma unroll
                    for (int n = 0; n < 2; ++n) acc[a][b][m][n] = (f32x4){0.f, 0.f, 0.f, 0.f};
        cur = nxt; cA = nA; cB = nB; ++ui;
        if constexpr (ALIGN_EPI) { if (wr == 1) PG8_BAR; }
    }
    PG8_WAIT_V(0);
    if constexpr (!ALIGN_EPI) { if (wr == 0) PG8_BAR; }
    PG8_BAR;
    if constexpr (Epi::AFTER_DRAIN) { E.fused(acc, cur, wr, wc, fr, fq, lds, wid, lane); S.done(cur); }
#undef PG8_SA
#undef PG8_SB
#undef PG8_STAGE
#undef PG8_LDA
#undef PG8_LDB
#undef PG8_MMA
#undef PG8_WAIT_V
#undef PG8_WAIT_L
#undef PG8_BAR
#undef PG8_SCHED
}
}

constexpr int NWAVES = 8;
constexpr int NB = 8, SEQ = 2048, D = 2048, M = NB * SEQ;
constexpr int IN_WIDTH = 7568;
constexpr int N1 = 7680;
constexpr int NEXP = 16384;
constexpr float EPS = 1e-6f;
constexpr float LOG2E = 1.4426950408889634f;
constexpr float MLA_QSCALE = 0.07216878364870322f * LOG2E;
constexpr float DSA_QSCALE = 0.08838834764831845f * LOG2E;

constexpr size_t MiB = 1u << 20;
constexpr size_t WS_CTL = 0, CTL_ZERO_BYTES = 1 * MiB;
constexpr size_t WS_T64 = 1 * MiB;
constexpr size_t WS_T32 = 5 * MiB;
constexpr size_t WS_T16 = 7 * MiB;
constexpr size_t WS_RS  = 8 * MiB;
constexpr size_t WS_USC = 8 * MiB + 256 * 1024;
constexpr size_t WS_VSC = 8 * MiB + 512 * 1024;
constexpr size_t WS_MB  = 9 * MiB;
constexpr size_t WS_SC  = 16 * MiB;
constexpr size_t WS_XN  = 18 * MiB;
constexpr size_t WS_OA  = 16 * MiB;
constexpr size_t WS_OB  = 48 * MiB;
constexpr size_t WS_X1B = 16 * MiB;
constexpr size_t WS_WIN = 82 * MiB;
constexpr size_t WS_WUQ = 112 * MiB;
constexpr size_t WS_CKV = 114 * MiB;
constexpr size_t WS_WUK = 122 * MiB;
constexpr size_t WS_WUV = 122 * MiB + 512 * 1024;
constexpr size_t WS_WAB = 123 * MiB;
constexpr size_t WS_WO  = 131 * MiB;
constexpr size_t WS_W2  = 139 * MiB;
constexpr size_t WS_U   = 147 * MiB;
constexpr size_t WS_V   = 211 * MiB;
constexpr size_t WS_CQ  = 275 * MiB;
constexpr size_t WS_DQ  = 291 * MiB;
constexpr size_t WS_DK  = 323 * MiB;
constexpr size_t WS_DVT = 331 * MiB;
constexpr size_t WS_IQ  = 339 * MiB;
constexpr size_t WS_KR  = 371 * MiB;
constexpr size_t WS_IK  = 373 * MiB;
constexpr size_t WS_IW  = 375 * MiB;
constexpr size_t WS_Q   = 376 * MiB;
constexpr size_t WS_KN  = 424 * MiB;
constexpr size_t WS_VT  = 456 * MiB;
constexpr size_t WS_PA  = 275 * MiB;
constexpr size_t WS_MRG = 339 * MiB;
constexpr size_t WS_S   = 275 * MiB;
constexpr size_t WS_END = 488 * MiB;
constexpr int CW_BAR = 4096;

constexpr int RING_OFF = 0, RING_BYTES = 131072;
constexpr int LDSCTL_OFF = RING_BYTES, MISC_OFF = LDSCTL_OFF + 320;
constexpr int LDS_BYTES = 147456;

#define GAS __attribute__((address_space(1)))
#define LAS __attribute__((address_space(3)))
typedef unsigned short bf16;
typedef unsigned v4u __attribute__((ext_vector_type(4)));
typedef unsigned v2u __attribute__((ext_vector_type(2)));
typedef float f32x4 __attribute__((ext_vector_type(4)));
typedef float f32x2 __attribute__((ext_vector_type(2)));
typedef float f32x16 __attribute__((ext_vector_type(16)));
typedef short bf16x8 __attribute__((ext_vector_type(8)));
typedef GAS unsigned gu32;
#define RLX_AGENT __ATOMIC_RELAXED, __HIP_MEMORY_SCOPE_AGENT
#define LDS_WAIT() asm volatile("s_waitcnt lgkmcnt(0)" ::: "memory")
#define VM_WAIT() asm volatile("s_waitcnt vmcnt(0)" ::: "memory")
__device__ __forceinline__ unsigned f2bf(float f) { unsigned u = __builtin_bit_cast(unsigned, f); return (u + 0x7fffu + ((u >> 16) & 1u)) >> 16; }
__device__ __forceinline__ unsigned pk2(float lo, float hi) { unsigned r; asm volatile("v_cvt_pk_bf16_f32 %0, %1, %2" : "=v"(r) : "v"(lo), "v"(hi)); return r; }
__device__ __forceinline__ float bflo(unsigned w) { return __builtin_bit_cast(float, w << 16); }
__device__ __forceinline__ float bfhi(unsigned w) { return __builtin_bit_cast(float, w & 0xffff0000u); }
__device__ __forceinline__ float wave_sum(float v) {
#pragma unroll
    for (int o = 1; o < 64; o <<= 1) v += __shfl_xor(v, o);
    return v;
}
__device__ __forceinline__ int lane_id() { int l; asm volatile("v_mbcnt_lo_u32_b32 %0, -1, 0\n\tv_mbcnt_hi_u32_b32 %0, -1, %0" : "=v"(l)); return l; }
#define XB_TMO      128
#define XB_XCNT(j)  (256  + 64 * (j))
#define XB_XSUB(j)  (1280 + 64 * (j))
#define XB_XGEN(j)  (2304 + 64 * (j))
#define XB_TOP      3328
#define XB_TOPGEN   3392
#define XCD_BAR_WORDS 3456
#define XB_SPIN_CAP (1u << 18)

__device__ __forceinline__ unsigned xb_ld(unsigned* p)              { return __hip_atomic_load(p, __ATOMIC_RELAXED, __HIP_MEMORY_SCOPE_AGENT); }
__device__ __forceinline__ unsigned xb_add(unsigned* p, unsigned v) { return __hip_atomic_fetch_add(p, v, __ATOMIC_RELAXED, __HIP_MEMORY_SCOPE_AGENT); }
__device__ __forceinline__ unsigned xb_xcc_id() { return (unsigned)__builtin_amdgcn_s_getreg((3 << 11) | 20) & 0xFu; }
#define XB_SPIN(cond, bar) do { unsigned _sp = 0; while (cond) { __builtin_amdgcn_s_sleep(1); \
    if ((++_sp & 255u) == 0u) { if (xb_ld(&(bar)[XB_TMO])) break; if (_sp > XB_SPIN_CAP) { atomicAdd(&(bar)[XB_TMO], 1u); break; } } } } while (0)

struct XcdBarrier {
    unsigned* bar; unsigned x;
    volatile LAS unsigned* st;
};

__device__ __forceinline__ XcdBarrier xcd_barrier_post(unsigned* bar, volatile LAS unsigned* st) {
    XcdBarrier b; b.bar = bar; b.x = xb_xcc_id(); b.st = st;
    if (threadIdx.x == 0) (void)xb_add(&bar[XB_XCNT(b.x)], 1u);
    return b;
}
__device__ __forceinline__ void xcd_barrier_complete(unsigned* bar, unsigned x, unsigned& nloc, unsigned& nx) {
    const unsigned G = gridDim.x * gridDim.y * gridDim.z;
    unsigned sum, cnt, mine, sp = 0u;
    for (;;) {
        sum = 0u; cnt = 0u; mine = 0u;
#pragma unroll
        for (unsigned j = 0; j < 16; ++j) { const unsigned c = xb_ld(&bar[XB_XCNT(j)]); sum += c; cnt += (c > 0u) ? 1u : 0u; mine = (j == x) ? c : mine; }
        if (sum == G) break;
        __builtin_amdgcn_s_sleep(1);
        if ((++sp & 255u) == 0u) { if (xb_ld(&bar[XB_TMO])) break; if (sp > XB_SPIN_CAP) { atomicAdd(&bar[XB_TMO], 1u); break; } }
    }
    nloc = mine > 0u ? mine : 1u; nx = cnt > 0u ? cnt : 1u;
}

__device__ __forceinline__ void xcd_barrier(const XcdBarrier& b, const bool leader  ) {
    asm volatile("s_waitcnt vmcnt(0)" ::: "memory");
    __syncthreads();
    if (leader) {
        unsigned* bar = b.bar;
        __builtin_amdgcn_s_waitcnt(0);
        unsigned nloc = b.st[0], nx = b.st[1];
        if (nloc == 0u) { xcd_barrier_complete(bar, b.x, nloc, nx); b.st[0] = nloc; b.st[1] = nx; }
        const unsigned old = xb_add(&bar[XB_XSUB(b.x)], 1u);
        const unsigned gen = old / nloc;
        if (old + 1u == (gen + 1u) * nloc) {
            __builtin_amdgcn_fence(__ATOMIC_RELEASE, "agent");
            asm volatile("s_waitcnt vmcnt(0)" ::: "memory");
            const unsigned og = xb_add(&bar[XB_TOP], 1u);
            const unsigned tg = og / nx;
            if (og + 1u == (tg + 1u) * nx) xb_add(&bar[XB_TOPGEN], 1u);
            else XB_SPIN(xb_ld(&bar[XB_TOPGEN]) == tg, bar);
            __builtin_amdgcn_fence(__ATOMIC_ACQUIRE, "agent");
            xb_add(&bar[XB_XGEN(b.x)], 1u);
            asm volatile("s_waitcnt vmcnt(0)" ::: "memory");
        } else {
            XB_SPIN(xb_ld(&bar[XB_XGEN(b.x)]) == gen, bar);
            __builtin_amdgcn_fence(__ATOMIC_ACQUIRE, "agent");
            asm volatile("s_waitcnt vmcnt(0)" ::: "memory");
        }
    }
    __syncthreads();
}

struct Args {
    const float* x; const int* pos; const float* g_mix; const float* w_in; const float* g_q; const float* g_kv;
    const float* w_uq; const float* w_uk; const float* w_uv; const float* w_a; const float* w_b; const float* w_o;
    const float* g_ffn; const float* w_pq; const float* subk; const float* pu; const float* pv; const float* g_fin;
    float* out; unsigned char* ws;
    double invf[56];
    int ph_lo, ph_hi;
};

__device__ __forceinline__ int src_win(int n) {
    if (n < 768) return n;
    if (n < 2048) { const int r = n - 768, head = r >> 7, j = r & 127; const int sj = j < 32 ? ((j & 1) * 16 + (j >> 1)) : j; return 832 + head * 128 + sj; }
    if (n < 2304) return 2112 + (n - 2048);
    if (n < 3328) { const int r = n - 2304, head = r >> 6, j = r & 63; const int sj = j < 16 ? ((j & 1) * 8 + (j >> 1)) : j; return 2368 + head * 64 + sj; }
    if (n < 3584) { const int r = n - 3328;
        if (r < 64) return 768 + (r & 1) * 32 + (r >> 1);
        if (r < 128) { const int j = r - 64; return 3392 + (j < 16 ? ((j & 1) * 8 + (j >> 1)) : j); }
        if (r < 144) return 3456 + (r - 128);
        return -1; }
    return 3472 + (n - 3584);
}
__device__ __forceinline__ int src_wuq(int n) {
    if (n < 1024) return (n >> 7) * 192 + (n & 127);
    const int r = n - 1024, head = r >> 6, j = r & 63; return head * 192 + 128 + (j & 1) * 32 + (j >> 1);
}
template <int MODE> __device__ __forceinline__ int src_map(int n) { if (MODE == 1) return src_win(n); if (MODE == 2) return src_wuq(n); return n; }

template <int MODE> __device__ __forceinline__ void p0_transpose_item(const float* W, int K, int N, int nblk, bf16* WT, int row_off, LAS float* scr, int item, int lane, const float* kscale) {
    const int kb = item / nblk, nb = item % nblk, k0 = 64 * kb, n0 = 32 * nb;
    const int sc = src_map<MODE>(n0 + (lane & 31));
#pragma unroll 8
    for (int i = 0; i < 32; ++i) { const int kk = 2 * i + (lane >> 5); float v = sc >= 0 ? W[(size_t)(k0 + kk) * N + sc] : 0.f; if (kscale) v *= kscale[k0 + kk]; scr[kk * 33 + (lane & 31)] = v; }
    LDS_WAIT(); asm volatile("" ::: "memory");
    const int c = lane & 7;
#pragma unroll
    for (int j = 0; j < 4; ++j) { const int n = (lane >> 3) + 8 * j; const LAS float* s = scr + (8 * c) * 33 + n;
        v4u o; o.x = pk2(s[0 * 33], s[1 * 33]); o.y = pk2(s[2 * 33], s[3 * 33]); o.z = pk2(s[4 * 33], s[5 * 33]); o.w = pk2(s[6 * 33], s[7 * 33]);
        *(GAS v4u*)(WT + (size_t)(row_off + n0 + n) * K + k0 + 8 * c) = o; }
    LDS_WAIT(); asm volatile("" ::: "memory");
}

__device__ __forceinline__ void p0_w2_item(const Args& a, bf16* W2, LAS float* scr, int item, int lane) {
    const int hp = item >> 6, d0 = (item & 63) * 32;
#pragma unroll 4
    for (int dd = 0; dd < 32; ++dd) scr[dd * 64 + lane] = a.w_pq[(size_t)(d0 + dd) * 1024 + hp * 64 + lane];
    LDS_WAIT(); asm volatile("" ::: "memory");
    for (int pass = 0; pass < 2; ++pass) {
        const int n = lane + 64 * pass;
        const f32x4* skp = (const f32x4*)(a.subk + ((size_t)hp * 128 + n) * 64);
        float acc[32];
#pragma unroll
        for (int i = 0; i < 32; ++i) acc[i] = 0.f;
#pragma unroll 2
        for (int c4 = 0; c4 < 16; ++c4) { const f32x4 sk = skp[c4];
#pragma unroll
            for (int dd = 0; dd < 32; ++dd) { const f32x4 w = *(const LAS f32x4*)(scr + dd * 64 + c4 * 4); acc[dd] += w.x * sk.x + w.y * sk.y + w.z * sk.z + w.w * sk.w; } }
        bf16* o = W2 + (size_t)(hp * 128 + n) * D + d0;
#pragma unroll
        for (int q = 0; q < 4; ++q) { v4u w; const float* g = a.g_ffn + d0 + 8 * q;
            w.x = pk2(acc[8 * q + 0] * g[0], acc[8 * q + 1] * g[1]); w.y = pk2(acc[8 * q + 2] * g[2], acc[8 * q + 3] * g[3]);
            w.z = pk2(acc[8 * q + 4] * g[4], acc[8 * q + 5] * g[5]); w.w = pk2(acc[8 * q + 6] * g[6], acc[8 * q + 7] * g[7]);
            *(GAS v4u*)(o + 8 * q) = w; }
    }
    LDS_WAIT(); asm volatile("" ::: "memory");
}

__device__ __forceinline__ void rms_row_to_bf16(const float* xrow, const float* g, bf16* orow, int lane) {
    f32x4 v[8]; float s = 0.f;
#pragma unroll
    for (int j = 0; j < 4; ++j) { const GAS f32x4* p = (const GAS f32x4*)(xrow + j * 512 + lane * 8); v[2 * j] = p[0]; v[2 * j + 1] = p[1]; }
#pragma unroll
    for (int j = 0; j < 8; ++j) s += (v[j].x * v[j].x + v[j].y * v[j].y) + (v[j].z * v[j].z + v[j].w * v[j].w);
    const float rstd = 1.0f / sqrtf(wave_sum(s) * (1.f / D) + EPS);
#pragma unroll
    for (int j = 0; j < 4; ++j) { const f32x4 g0 = *(const f32x4*)(g + j * 512 + lane * 8), g1 = *(const f32x4*)(g + j * 512 + lane * 8 + 4);
        const f32x4 a0 = v[2 * j] * rstd * g0, a1 = v[2 * j + 1] * rstd * g1;
        v4u w; w.x = pk2(a0.x, a0.y); w.y = pk2(a0.z, a0.w); w.z = pk2(a1.x, a1.y); w.w = pk2(a1.z, a1.w);
        *(GAS v4u*)(orow + j * 512 + lane * 8) = w; }
}
__device__ __forceinline__ void quant_row_fp8(const float* xrow, unsigned char* orow, float* scale, int lane) {
    f32x4 v[8]; float mx = 0.f;
#pragma unroll
    for (int j = 0; j < 2; ++j)
#pragma unroll
        for (int c = 0; c < 4; ++c) v[4 * j + c] = __builtin_nontemporal_load((const GAS f32x4*)(xrow + j * 1024 + lane * 16 + 4 * c));
#pragma unroll
    for (int j = 0; j < 8; ++j) mx = fmaxf(fmaxf(mx, fmaxf(fabsf(v[j].x), fabsf(v[j].y))), fmaxf(fabsf(v[j].z), fabsf(v[j].w)));
#pragma unroll
    for (int o = 1; o < 64; o <<= 1) mx = fmaxf(mx, __shfl_xor(mx, o));
    const float sc = mx > 0.f ? mx * (1.0f / 448.0f) : 1.0f, inv = 1.0f / sc;
#pragma unroll
    for (int j = 0; j < 2; ++j) { v4u w;
#pragma unroll
        for (int c = 0; c < 4; ++c) { const f32x4 t = v[4 * j + c] * inv; int p = __builtin_amdgcn_cvt_pk_fp8_f32(t.x, t.y, 0, false); p = __builtin_amdgcn_cvt_pk_fp8_f32(t.z, t.w, p, true); w[c] = (unsigned)p; }
        *(GAS v4u*)(orow + j * 1024 + lane * 16) = w; }
    if (lane == 0) *scale = sc;
}
__device__ __forceinline__ void p0_prologue(const Args& a, LAS unsigned char* lds, int vcu, int G, int wave, int lane) {
    unsigned char* ws = a.ws;
    LAS float* scr = (LAS float*)(lds + RING_OFF + wave * 16384);
    const int gw = vcu * NWAVES + wave, NGW = G * NWAVES;
    constexpr int I_WIN = 32 * 240, I_WUQ = 8 * 48, I_WUK = 4 * 32, I_WUV = 4 * 32, I_WA = 16 * 64, I_WB = 16 * 64, I_WO = 32 * 64, I_W2 = 1024;
    constexpr int NITEMS = I_WIN + I_WUQ + I_WUK + I_WUV + I_WA + I_WB + I_WO + I_W2;
    for (int it = gw; it < NITEMS; it += NGW) {
        int r = it;
        if (r < I_WIN) { p0_transpose_item<1>(a.w_in, D, IN_WIDTH, 240, (bf16*)(ws + WS_WIN), 0, scr, r, lane, nullptr); continue; } r -= I_WIN;
        if (r < I_WUQ) { p0_transpose_item<2>(a.w_uq, 512, 1536, 48, (bf16*)(ws + WS_WUQ), 0, scr, r, lane, a.g_q); continue; } r -= I_WUQ;
        if (r < I_WUK) { p0_transpose_item<0>(a.w_uk, 256, 1024, 32, (bf16*)(ws + WS_WUK), 0, scr, r, lane, a.g_kv); continue; } r -= I_WUK;
        if (r < I_WUV) { p0_transpose_item<0>(a.w_uv, 256, 1024, 32, (bf16*)(ws + WS_WUV), 0, scr, r, lane, a.g_kv); continue; } r -= I_WUV;
        if (r < I_WA) { p0_transpose_item<0>(a.w_a, 1024, 2048, 64, (bf16*)(ws + WS_WAB), 0, scr, r, lane, nullptr); continue; } r -= I_WA;
        if (r < I_WB) { p0_transpose_item<0>(a.w_b, 1024, 2048, 64, (bf16*)(ws + WS_WAB), 2048, scr, r, lane, nullptr); continue; } r -= I_WB;
        if (r < I_WO) { p0_transpose_item<0>(a.w_o, 2048, 2048, 64, (bf16*)(ws + WS_WO), 0, scr, r, lane, nullptr); continue; } r -= I_WO;
        p0_w2_item(a, (bf16*)(ws + WS_W2), scr, r, lane);
    }
    for (int m = gw; m < M; m += NGW) rms_row_to_bf16(a.x + (size_t)m * D, a.g_mix, (bf16*)(ws + WS_XN) + (size_t)m * D, lane);
    for (int m = gw; m < 2 * NEXP; m += NGW) { const int e = m & (NEXP - 1);
        if (m < NEXP) quant_row_fp8(a.pu + (size_t)e * D, ws + WS_U + (size_t)e * D, (float*)(ws + WS_USC) + e, lane);
        else quant_row_fp8(a.pv + (size_t)e * D, ws + WS_V + (size_t)e * D, (float*)(ws + WS_VSC) + e, lane); }
    const int gt = gw * 64 + lane, NGT = NGW * 64;
    for (int idx = gt; idx < M * 56; idx += NGT) {
        const int t = idx / 56, i = idx - t * 56;
        const double ang = (double)a.pos[t] * a.invf[i];
        double rev = ang * 0.15915494309189535; rev -= __builtin_rint(rev);
        const float r = (float)(rev * 6.283185307179586);
        const float c = cosf(r), s = sinf(r);
        f32x2* dst = i < 32 ? (f32x2*)(ws + WS_T64) + (size_t)t * 32 + i : i < 48 ? (f32x2*)(ws + WS_T32) + (size_t)t * 16 + (i - 32) : (f32x2*)(ws + WS_T16) + (size_t)t * 8 + (i - 48);
        *dst = (f32x2){c, s};
    }
}

template <int KIND> struct Order {
    int nM, nN, nwg, G, c;
    __device__ void init(int nM_, int nN_, int G_, int c_) { nM = nM_; nN = nN_; nwg = nM * nN; G = G_; c = c_; }
    __device__ bool next(int i, pg8::Unit& u) const {
        const int ii = (KIND == 3) ? (i >> 1) : i;
        const long L = (long)ii * G + c; if (L >= nwg) return false;
        int wgid = (int)L; { const int q = nwg / 8, r = nwg % 8, xcd = wgid % 8, off = wgid / 8; wgid = (xcd < r ? xcd * (q + 1) : r * (q + 1) + (xcd - r) * q) + off; }
        const int nig = 8 * nN, gid = wgid / nig, fm = gid * 8, gsz = (nM - fm) < 8 ? (nM - fm) : 8;
        const int pm = fm + ((wgid % nig) % gsz), vn = (wgid % nig) / gsz;
        if (KIND == 0) { u.pm = pm; u.pn = vn; }
        if (KIND == 1) { if (vn == 8) { u.pm = 72; u.pn = pm; } else { u.pm = pm; u.pn = 64 + vn; } }
        if (KIND == 2) { if (vn >= 4) { u.pm = 64 + vn; u.pn = pm; } else { u.pm = pm; u.pn = 64 + vn; } }
        if (KIND == 3) { const int br = i & 1; u.pm = pm + 64 * br; u.pn = vn + 8 * br; }
        return true;
    }
    __device__ __forceinline__ void a_ready(const pg8::Unit&) const {}
    __device__ __forceinline__ void done(const pg8::Unit&) const {}
};

__device__ __forceinline__ void st8bf(bf16* p, f32x4 a, f32x4 b) { v4u w; w.x = pk2(a.x, a.y); w.y = pk2(a.z, a.w); w.z = pk2(b.x, b.y); w.w = pk2(b.z, b.w); *(GAS v4u*)p = w; }
__device__ __forceinline__ void rope8(f32x4& a, f32x4& b, const float* tab) {
    const f32x4 t0 = *(const f32x4*)tab, t1 = *(const f32x4*)(tab + 4);
    const f32x4 ra = {a.x * t0.x - a.y * t0.y, a.y * t0.x + a.x * t0.y, a.z * t0.z - a.w * t0.w, a.w * t0.z + a.z * t0.w};
    const f32x4 rb = {b.x * t1.x - b.y * t1.y, b.y * t1.x + b.x * t1.y, b.z * t1.z - b.w * t1.w, b.w * t1.z + b.z * t1.w};
    a = ra; b = rb;
}
__device__ __forceinline__ void st8_vt(bf16* rowp, int tk0, f32x4 a, f32x4 b) {
    bf16* p = rowp + (tk0 & ~15) + 4 * ((tk0 >> 3) & 1);
    v2u w0, w1; w0.x = pk2(a.x, a.y); w0.y = pk2(a.z, a.w); w1.x = pk2(b.x, b.y); w1.y = pk2(b.z, b.w);
    *(GAS v2u*)p = w0; *(GAS v2u*)(p + 8) = w1;
}
#define EPI_FOR _Pragma("unroll") for (int ai = 0; ai < 2; ++ai) _Pragma("unroll") for (int m = 0; m < 4; ++m) _Pragma("unroll") for (int bj = 0; bj < 2; ++bj)
#define EPI_VARS asm volatile("" ::: "memory"); const int rl = 128 * ai + 64 * wr + 16 * m + fr, lc = 128 * bj + 32 * wc + 8 * fq; f32x4 v0 = acc[ai][bj][m][0], v1 = acc[ai][bj][m][1]; (void)rl; (void)lc;

struct Epi1 {
    static constexpr bool PERM = true, AFTER_DRAIN = false;
    unsigned char* ws; bf16* G;
    __device__ __forceinline__ void operator()(const f32x4 (&acc)[2][2][4][2], const pg8::Unit& u, int wr, int wc, int fr_, int fq_) const {
        int fr = fr_, fq = fq_; asm volatile("" : "+v"(fr), "+v"(fq));
        if (u.pm >= 64) {
            bf16* DVT = (bf16*)(ws + WS_DVT);
            EPI_FOR { EPI_VARS st8_vt(DVT + (size_t)rl * M, u.pn * 256 + lc, v0, v1); }
            return;
        }
        const int ct = u.pn - 64; const size_t row0 = (size_t)u.pm * 256;
        if (ct < 2) { bf16* O = (bf16*)(ws + WS_CQ); EPI_FOR { EPI_VARS st8bf(O + (row0 + rl) * 512 + ct * 256 + lc, v0, v1); } }
        else if (ct == 2) { bf16* O = (bf16*)(ws + WS_CKV); EPI_FOR { EPI_VARS st8bf(O + (row0 + rl) * 256 + lc, v0, v1); } }
        else if (ct < 7) { bf16* O = (bf16*)(ws + WS_DQ); const float* T = (const float*)(ws + WS_T32);
            EPI_FOR { EPI_VARS const int gc = (ct - 3) * 256 + lc, j = gc & 127; const size_t row = row0 + rl;
                if (j < 32) rope8(v0, v1, T + row * 32 + j);
                st8bf(O + row * 1024 + gc, v0 * DSA_QSCALE, v1 * DSA_QSCALE); } }
        else if (ct == 7) { bf16* O = (bf16*)(ws + WS_DK); const float* T = (const float*)(ws + WS_T32);
            EPI_FOR { EPI_VARS const int j = lc & 127; const size_t row = row0 + rl;
                if (j < 32) rope8(v0, v1, T + row * 32 + j);
                st8bf(O + row * 256 + lc, v0, v1); } }
        else if (ct < 13) { bf16* O = (bf16*)(ws + WS_IQ); const float* T = (const float*)(ws + WS_T16);
            EPI_FOR { EPI_VARS const int gc = (ct - 9) * 256 + lc, j = gc & 63; const size_t row = row0 + rl;
                if (j < 16) rope8(v0, v1, T + row * 16 + j);
                st8bf(O + row * 1024 + gc, v0, v1); } }
        else if (ct == 13) {
            EPI_FOR { EPI_VARS const size_t row = row0 + rl;
                if (lc < 64) { rope8(v0, v1, (const float*)(ws + WS_T64) + row * 64 + lc); st8bf((bf16*)(ws + WS_KR) + row * 64 + lc, v0, v1); }
                else if (lc < 128) { const int j = lc - 64; if (j < 16) rope8(v0, v1, (const float*)(ws + WS_T16) + row * 16 + j); st8bf((bf16*)(ws + WS_IK) + row * 64 + j, v0, v1); }
                else if (lc < 144) { float* o = (float*)(ws + WS_IW) + row * 16 + (lc - 128); *(GAS f32x4*)o = v0 * 0.03125f; *(GAS f32x4*)(o + 4) = v1 * 0.03125f; } } }
        else {
            EPI_FOR { EPI_VARS const int gc = (ct - 14) * 256 + lc; const size_t row = row0 + rl;
                f32x4 s0, s1;
#pragma unroll
                for (int e = 0; e < 4; ++e) { s0[e] = __builtin_amdgcn_rcpf(1.f + __expf(-v0[e])); s1[e] = __builtin_amdgcn_rcpf(1.f + __expf(-v1[e])); }
                st8bf(G + row * 4096 + gc, s0, s1); } }
    }
};

struct Epi3q {
    static constexpr bool PERM = true, AFTER_DRAIN = false;
    unsigned char* ws;
    __device__ __forceinline__ void operator()(const f32x4 (&acc)[2][2][4][2], const pg8::Unit& u, int wr, int wc, int fr_, int fq_) const {
        int fr = fr_, fq = fq_; asm volatile("" : "+v"(fr), "+v"(fq));
        bf16* Q = (bf16*)(ws + WS_Q); const float* RSQ = (const float*)(ws + WS_RS); const float* T = (const float*)(ws + WS_T64);
        const size_t row0 = (size_t)u.pm * 256;
        EPI_FOR { EPI_VARS const size_t row = row0 + rl; const float sc = RSQ[row] * MLA_QSCALE; v0 = v0 * sc; v1 = v1 * sc;
            if (u.pn < 4) { const int gc = u.pn * 256 + lc; st8bf(Q + row * 1536 + (gc >> 7) * 192 + (gc & 127), v0, v1); }
            else { const int r = (u.pn - 4) * 256 + lc, j = r & 63; rope8(v0, v1, T + row * 64 + j); st8bf(Q + row * 1536 + (r >> 6) * 192 + 128 + j, v0, v1); } }
    }
};
struct Epi3k {
    static constexpr bool PERM = true, AFTER_DRAIN = false;
    unsigned char* ws;
    __device__ __forceinline__ void operator()(const f32x4 (&acc)[2][2][4][2], const pg8::Unit& u, int wr, int wc, int fr_, int fq_) const {
        int fr = fr_, fq = fq_; asm volatile("" : "+v"(fr), "+v"(fq));
        const float* RSK = (const float*)(ws + WS_RS) + M;
        if (u.pm >= 64) { bf16* VT = (bf16*)(ws + WS_VT); const int vt = u.pm - 68;
            EPI_FOR { EPI_VARS const int tk0 = u.pn * 256 + lc; const f32x4 r0 = *(const f32x4*)(RSK + tk0), r1 = *(const f32x4*)(RSK + tk0 + 4);
                st8_vt(VT + (size_t)(vt * 256 + rl) * M, tk0, v0 * r0, v1 * r1); }
            return; }
        bf16* KN = (bf16*)(ws + WS_KN); const int ct = u.pn - 64; const size_t row0 = (size_t)u.pm * 256;
        EPI_FOR { EPI_VARS const size_t row = row0 + rl; const float sc = RSK[row]; st8bf(KN + row * 1024 + ct * 256 + lc, v0 * sc, v1 * sc); }
    }
};
struct Epi5 {
    static constexpr bool PERM = true, AFTER_DRAIN = false;
    unsigned char* ws; const bf16* G;
    __device__ __forceinline__ void operator()(const f32x4 (&acc)[2][2][4][2], const pg8::Unit& u, int wr, int wc, int fr_, int fq_) const {
        int fr = fr_, fq = fq_; asm volatile("" : "+v"(fr), "+v"(fq));
        bf16* PA = (bf16*)(ws + WS_PA); bf16* MRG = (bf16*)(ws + WS_MRG);
        const size_t row0 = (size_t)(u.pm & 63) * 256; const int col0 = (u.pn & 7) * 256;
#ifdef DBG_ZERO_MLA
        if (u.pm < 64) { EPI_FOR { EPI_VARS st8bf(PA + (row0 + rl) * 2048 + col0 + lc, v0 * 0.f, v1 * 0.f); } return; }
#else
        if (u.pm < 64) { EPI_FOR { EPI_VARS st8bf(PA + (row0 + rl) * 2048 + col0 + lc, v0, v1); } return; }
#endif
        EPI_FOR { EPI_VARS const size_t row = row0 + rl; const int col = col0 + lc;
            const v4u ga = *(const GAS v4u*)(G + row * 4096 + col), gb = *(const GAS v4u*)(G + row * 4096 + 2048 + col), pa = *(const GAS v4u*)(PA + row * 2048 + col);
            f32x4 o0, o1;
#ifdef DBG_ZERO_DSA
            v0 = v0 * 0.f; v1 = v1 * 0.f;
#endif
            o0.x = bflo(ga.x) * bflo(pa.x) + bflo(gb.x) * v0.x; o0.y = bfhi(ga.x) * bfhi(pa.x) + bfhi(gb.x) * v0.y;
            o0.z = bflo(ga.y) * bflo(pa.y) + bflo(gb.y) * v0.z; o0.w = bfhi(ga.y) * bfhi(pa.y) + bfhi(gb.y) * v0.w;
            o1.x = bflo(ga.z) * bflo(pa.z) + bflo(gb.z) * v1.x; o1.y = bfhi(ga.z) * bfhi(pa.z) + bfhi(gb.z) * v1.y;
            o1.z = bflo(ga.w) * bflo(pa.w) + bflo(gb.w) * v1.z; o1.w = bfhi(ga.w) * bfhi(pa.w) + bfhi(gb.w) * v1.w;
            st8bf(MRG + row * 2048 + col, o0, o1); }
    }
};
struct Epi6 {
    static constexpr bool PERM = true, AFTER_DRAIN = false;
    unsigned char* ws; const float* x; float* out;
    __device__ __forceinline__ void operator()(const f32x4 (&acc)[2][2][4][2], const pg8::Unit& u, int wr, int wc, int fr_, int fq_) const {
        int fr = fr_, fq = fq_; asm volatile("" : "+v"(fr), "+v"(fq));
        bf16* X1B = (bf16*)(ws + WS_X1B);
        EPI_FOR { EPI_VARS const size_t off = ((size_t)u.pm * 256 + rl) * 2048 + u.pn * 256 + lc;
            const f32x4 a = *(const GAS f32x4*)(x + off) + v0, b = *(const GAS f32x4*)(x + off + 4) + v1;
            *(GAS f32x4*)(out + off) = a; *(GAS f32x4*)(out + off + 4) = b; st8bf(X1B + off, a, b); }
    }
};
struct Epi7 {
    static constexpr bool PERM = true, AFTER_DRAIN = false;
    unsigned char* ws;
    __device__ __forceinline__ void operator()(const f32x4 (&acc)[2][2][4][2], const pg8::Unit& u, int wr, int wc, int fr_, int fq_) const {
        int fr = fr_, fq = fq_; asm volatile("" : "+v"(fr), "+v"(fq));
        float* S = (float*)(ws + WS_S);
        EPI_FOR { EPI_VARS const size_t off = ((size_t)u.pm * 256 + rl) * 2048 + u.pn * 256 + lc;
            *(GAS f32x4*)(S + off) = v0; *(GAS f32x4*)(S + off + 4) = v1; }
    }
};

__device__ __forceinline__ void p2_rowstats(unsigned char* ws, int vcu, int G, int wave, int lane) {
    const bf16* CQ = (const bf16*)(ws + WS_CQ); const bf16* CKV = (const bf16*)(ws + WS_CKV); float* RS = (float*)(ws + WS_RS);
    const int gw = vcu * NWAVES + wave, NGW = G * NWAVES;
    for (int m = gw; m < M; m += NGW) {
        const v4u q = *(const GAS v4u*)(CQ + (size_t)m * 512 + lane * 8); const v2u k = *(const GAS v2u*)(CKV + (size_t)m * 256 + lane * 4);
        float sq = 0.f, sk = 0.f;
#pragma unroll
        for (int e = 0; e < 4; ++e) { const float a = bflo(q[e]), b = bfhi(q[e]); sq += a * a + b * b; }
#pragma unroll
        for (int e = 0; e < 2; ++e) { const float a = bflo(k[e]), b = bfhi(k[e]); sk += a * a + b * b; }
        sq = wave_sum(sq); sk = wave_sum(sk);
        if (lane == 0) { RS[m] = 1.0f / sqrtf(sq * (1.f / 512.f) + EPS); RS[M + m] = 1.0f / sqrtf(sk * (1.f / 256.f) + EPS); }
    }
}
__device__ __forceinline__ size_t sc_base(int b, int c) { return (size_t)b * 2162688u + (size_t)2048 * c * (c + 1); }
__device__ __forceinline__ void idx_segment(unsigned char* ws, LAS unsigned char* lds, int b, int c, int k0, int k1, int wave, int lane, int tid) {
    const bf16* IQ = (const bf16*)(ws + WS_IQ); const bf16* IK = (const bf16*)(ws + WS_IK); const float* IW = (const float*)(ws + WS_IW); float* SC = (float*)(ws + WS_SC);
    const int t0 = b * SEQ + 64 * c, r = lane & 31, hk = lane >> 5;
    bf16x8 af[4][4]; f32x4 wv[4][4];
#pragma unroll
    for (int rt = 0; rt < 4; ++rt) {
        const int tq = t0 + 8 * wave + 2 * rt + ((r >> 2) & 1), hh = (r & 3) + 4 * (r >> 3);
#pragma unroll
        for (int ks = 0; ks < 4; ++ks) af[rt][ks] = *(const GAS bf16x8*)(IQ + (size_t)tq * 1024 + hh * 64 + 16 * ks + 8 * hk);
        const int tw = t0 + 8 * wave + 2 * rt + hk;
#pragma unroll
        for (int q4 = 0; q4 < 4; ++q4) wv[rt][q4] = *(const GAS f32x4*)(IW + (size_t)tw * 16 + 4 * q4);
    }
#pragma unroll
    for (int rt = 0; rt < 4; ++rt)
#pragma unroll
        for (int ks = 0; ks < 4; ++ks) { asm volatile("" :: "v"(af[rt][ks])); asm volatile("" :: "v"(wv[rt][ks])); }
    const int skey = tid >> 3, sch = tid & 7;
    const bf16* src = IK + ((size_t)b * SEQ + skey) * 64 + sch * 8;
    const int sdst = skey * 144 + sch * 16;
    const int nrow = 64 * (c + 1);
    float* scrow = SC + sc_base(b, c);
    { const v4u t = *(const GAS v4u*)(src + (size_t)k0 * 64 * 64); *(LAS v4u*)(lds + sdst) = t; }
    __syncthreads();
    for (int kt = k0; kt < k1; ++kt) {
        const int cur = (kt - k0) & 1; v4u nx = {0u, 0u, 0u, 0u};
        if (kt + 1 < k1) nx = *(const GAS v4u*)(src + (size_t)(kt + 1) * 64 * 64);
        const LAS unsigned char* kb = lds + cur * 9216;
#pragma unroll
        for (int kh = 0; kh < 2; ++kh) {
            bf16x8 bfr[4];
#pragma unroll
            for (int ks = 0; ks < 4; ++ks) bfr[ks] = *(const LAS bf16x8*)(kb + (32 * kh + r) * 144 + (16 * ks + 8 * hk) * 2);
#pragma unroll
            for (int rt = 0; rt < 4; ++rt) {
                f32x16 cc;
#pragma unroll
                for (int e = 0; e < 16; ++e) cc[e] = 0.f;
#pragma unroll
                for (int ks = 0; ks < 4; ++ks) cc = __builtin_amdgcn_mfma_f32_32x32x16_bf16(af[rt][ks], bfr[ks], cc, 0, 0, 0);
                float s = 0.f;
#pragma unroll
                for (int e = 0; e < 16; ++e) s += wv[rt][e >> 2][e & 3] * fmaxf(cc[e], 0.f);
                scrow[(size_t)(8 * wave + 2 * rt + hk) * nrow + 64 * kt + 32 * kh + r] = s;
            }
        }
        if (kt + 1 < k1) *(LAS v4u*)(lds + (cur ^ 1) * 9216 + sdst) = nx;
        __syncthreads();
    }
}
__device__ __forceinline__ void p2_indexer(unsigned char* ws, LAS unsigned char* lds, int bx, int G, int wave, int lane) {
    const int tid = wave * 64 + lane;
    for (int i = bx; i < 256; i += G) {
        const int p = i >> 1, b = p >> 4, c = p & 15;
        if ((i & 1) == 0) { idx_segment(ws, lds, b, c, 0, c + 1, wave, lane, tid); idx_segment(ws, lds, b, 31 - c, 0, 16 - c, wave, lane, tid); }
        else idx_segment(ws, lds, b, 31 - c, 16 - c, 32 - c, wave, lane, tid);
    }
}

__device__ __forceinline__ void p3_select(unsigned char* ws, int vcu, int G, int wave, int lane_in) {
    const float* SC = (const float*)(ws + WS_SC); unsigned* MB = (unsigned*)(ws + WS_MB);
    const int gw = vcu * NWAVES + wave, NGW = G * NWAVES;
    for (int m = gw; m < M; m += NGW) {
        int lane = lane_in; asm volatile("" : "+v"(lane));
        const int b = m >> 11, c = (m & 2047) >> 6, qi = m & 63, n = 64 * (c + 1), nw = n >> 5;
        if (n <= 256) { MB[(size_t)m * 64 + lane] = lane < nw ? 0xffffffffu : 0u; continue; }
        unsigned key[32];
        const float* row = SC + sc_base(b, c) + (size_t)qi * n + lane * 32;
        const bool act = lane < nw;
#pragma unroll
        for (int q = 0; q < 8; ++q) { f32x4 t = {0.f, 0.f, 0.f, 0.f}; if (act) t = *(const GAS f32x4*)(row + 4 * q);
#pragma unroll
            for (int e = 0; e < 4; ++e) { const unsigned u = __builtin_bit_cast(unsigned, t[e] + 0.0f); key[4 * q + e] = act ? (u ^ ((u >> 31) ? 0xffffffffu : 0x80000000u)) : 0u; } }
        unsigned prefix = 0u;
#pragma unroll 1
        for (int bit = 31; bit >= 0; --bit) {
            const unsigned cand = prefix | (1u << bit); int cnt = 0;
#pragma unroll
            for (int i = 0; i < 32; ++i) cnt += __builtin_popcountll(__ballot(key[i] >= cand));
            if (cnt >= 256) prefix = cand;
        }
        int gt = 0, below = 0;
#pragma unroll
        for (int i = 0; i < 32; ++i) { gt += __builtin_popcountll(__ballot(key[i] > prefix)); const unsigned long long em = __ballot(key[i] == prefix);
            below += (int)__builtin_amdgcn_mbcnt_hi((unsigned)(em >> 32), __builtin_amdgcn_mbcnt_lo((unsigned)em, 0u)); }
        const int need = 256 - gt;
        int rk = below; unsigned word = 0u;
#pragma unroll
        for (int i = 0; i < 32; ++i) { const bool e = key[i] == prefix; const bool sel = (key[i] > prefix) || (e && rk < need); rk += e ? 1 : 0; word |= sel ? (1u << i) : 0u; }
        MB[(size_t)m * 64 + lane] = word;
    }
}

template <bool DSA> struct AttnCfg {
    static constexpr int DQK = DSA ? 128 : 192, NKS = DQK / 16, KSTR = DQK * 2 + 16, KBUF = 64 * KSTR, VSTR = 144, VBUF = 128 * VSTR, BUF = KBUF + VBUF;
    static constexpr int NKCH = DQK / 8, NKLD = 64 * NKCH / 512;
};
template <bool DSA>
__device__ __forceinline__ void attn_unit(unsigned char* ws, LAS unsigned char* lds, int b, int hh  , int blk  , int wave, int lane, int tid) {
    typedef AttnCfg<DSA> C;
    const int r = lane & 31, hk = lane >> 5;
    const int head = DSA ? 4 * hh + (wave >> 1) : hh;
    const int tok0 = DSA ? b * SEQ + 64 * blk + 32 * (wave & 1) : b * SEQ + 256 * blk + 32 * wave;
    const int ntw = DSA ? blk + 1 : 4 * blk + (wave >> 1) + 1;
    const int ntb = DSA ? blk + 1 : 4 * blk + 4;
    const bf16* Qp = DSA ? (const bf16*)(ws + WS_DQ) + (size_t)(tok0 + r) * 1024 + head * 128 : (const bf16*)(ws + WS_Q) + (size_t)(tok0 + r) * 1536 + head * 192;
    bf16x8 qf[C::NKS];
#pragma unroll
    for (int ks = 0; ks < C::NKS; ++ks) qf[ks] = *(const GAS bf16x8*)(Qp + 16 * ks + 8 * hk);
    const int skey = tid >> 3, sub = tid & 7;
    const bf16* ksrc0 = DSA ? (const bf16*)(ws + WS_DK) + ((size_t)b * SEQ + skey) * 256 + hh * 128 + sub * 8 : (const bf16*)(ws + WS_KN) + ((size_t)b * SEQ + skey) * 1024 + hh * 128 + sub * 8;
    const bf16* ksrc2 = (const bf16*)(ws + WS_KR) + ((size_t)b * SEQ + skey) * 64 + sub * 8;
    const int kdst = skey * C::KSTR + sub * 16;
    constexpr int KADV0 = DSA ? 64 * 256 : 64 * 1024, KADV2 = 64 * 64;
    const bf16* vsrc = (DSA ? (const bf16*)(ws + WS_DVT) : (const bf16*)(ws + WS_VT)) + (size_t)(hh * 128 + skey) * M + (size_t)b * SEQ + sub * 8;
    const int vdst = C::KBUF + skey * C::VSTR + sub * 16;
    v4u kreg[C::NKLD], vreg[2];
#define ATT_LOAD(kt_) do { kreg[0] = *(const GAS v4u*)(ksrc0 + (size_t)(kt_) * KADV0); kreg[1] = *(const GAS v4u*)(ksrc0 + (size_t)(kt_) * KADV0 + 64); \
        if (!DSA) kreg[C::NKLD - 1] = *(const GAS v4u*)(ksrc2 + (size_t)(kt_) * KADV2); \
        vreg[0] = *(const GAS v4u*)(vsrc + (size_t)(kt_) * 64); vreg[1] = *(const GAS v4u*)(vsrc + (size_t)64 * M + (size_t)(kt_) * 64); } while (0)
#define ATT_STORE(buf_) do { LAS unsigned char* bb_ = lds + (buf_) * C::BUF; *(LAS v4u*)(bb_ + kdst) = kreg[0]; *(LAS v4u*)(bb_ + kdst + 128) = kreg[1]; \
        if (!DSA) *(LAS v4u*)(bb_ + kdst + 256) = kreg[C::NKLD - 1]; \
        *(LAS v4u*)(bb_ + vdst) = vreg[0]; *(LAS v4u*)(bb_ + vdst + 64 * C::VSTR) = vreg[1]; } while (0)
    ATT_LOAD(0); ATT_STORE(0);
#pragma unroll
    for (int ks = 0; ks < C::NKS; ++ks) asm volatile("" :: "v"(qf[ks]));
    __syncthreads();
    f32x16 o[4];
#pragma unroll
    for (int dt = 0; dt < 4; ++dt)
#pragma unroll
        for (int e = 0; e < 16; ++e) o[dt][e] = 0.f;
    float mrun = -1e30f, lrun = 0.f;
    const unsigned long long* mbp = (const unsigned long long*)((const unsigned*)(ws + WS_MB) + (size_t)(tok0 + r) * 64);
    for (int kt = 0; kt < ntb; ++kt) {
        const int cur = kt & 1;
        if (kt + 1 < ntb) ATT_LOAD(kt + 1);
        if (kt < ntw) {
            const LAS unsigned char* kb = lds + cur * C::BUF; const LAS unsigned char* vb = kb + C::KBUF;
            f32x16 st[2];
#pragma unroll
            for (int kh = 0; kh < 2; ++kh) {
                asm volatile("" ::: "memory");
#pragma unroll
                for (int e = 0; e < 16; ++e) st[kh][e] = 0.f;
#pragma unroll
                for (int ks = 0; ks < C::NKS; ++ks) { if ((ks & 3) == 0 && ks) asm volatile("" ::: "memory"); const bf16x8 kf = *(const LAS bf16x8*)(kb + (32 * kh + r) * C::KSTR + (16 * ks + 8 * hk) * 2);
                    st[kh] = __builtin_amdgcn_mfma_f32_32x32x16_bf16(kf, qf[ks], st[kh], 0, 0, 0); }
            }
            if (DSA) {
                const unsigned long long w = mbp[kt];
                const unsigned w0 = (unsigned)w >> (4 * hk), w1 = (unsigned)(w >> 32) >> (4 * hk);
#pragma unroll
                for (int e = 0; e < 16; ++e) { const int cb = (e & 3) + 8 * (e >> 2);
                    st[0][e] = ((w0 >> cb) & 1u) ? st[0][e] : -__builtin_inff(); st[1][e] = ((w1 >> cb) & 1u) ? st[1][e] : -__builtin_inff(); }
            }
            float mx = st[0][0];
#pragma unroll
            for (int e = 1; e < 16; ++e) mx = fmaxf(mx, st[0][e]);
#pragma unroll
            for (int e = 0; e < 16; ++e) mx = fmaxf(mx, st[1][e]);
            mx = fmaxf(mx, __shfl_xor(mx, 32));
            const float mnew = fmaxf(mrun, mx), alpha = __builtin_amdgcn_exp2f(mrun - mnew);
            mrun = mnew;
            float ps = 0.f;
#pragma unroll
            for (int kh = 0; kh < 2; ++kh)
#pragma unroll
                for (int e = 0; e < 16; ++e) { st[kh][e] = __builtin_amdgcn_exp2f(st[kh][e] - mnew); ps += st[kh][e]; }
            ps += __shfl_xor(ps, 32);
            lrun = lrun * alpha + ps;
#pragma unroll
            for (int dt = 0; dt < 4; ++dt)
#pragma unroll
                for (int e = 0; e < 16; ++e) o[dt][e] *= alpha;
            bf16x8 pf[4];
#pragma unroll
            for (int s = 0; s < 4; ++s) { const int kh = s >> 1, e0 = 8 * (s & 1); v4u w;
                w.x = pk2(st[kh][e0], st[kh][e0 + 1]); w.y = pk2(st[kh][e0 + 2], st[kh][e0 + 3]); w.z = pk2(st[kh][e0 + 4], st[kh][e0 + 5]); w.w = pk2(st[kh][e0 + 6], st[kh][e0 + 7]);
                pf[s] = __builtin_bit_cast(bf16x8, w); }
#pragma unroll
            for (int dt = 0; dt < 4; ++dt) {
                asm volatile("" ::: "memory");
#pragma unroll
                for (int s = 0; s < 4; ++s) { const bf16x8 vf = *(const LAS bf16x8*)(vb + (32 * dt + r) * C::VSTR + (16 * s + 8 * hk) * 2);
                    o[dt] = __builtin_amdgcn_mfma_f32_32x32x16_bf16(vf, pf[s], o[dt], 0, 0, 0); } }
        }
        if (kt + 1 < ntb) ATT_STORE(cur ^ 1);
        __syncthreads();
    }
    const float inv = 1.0f / lrun;
    bf16* Op = (DSA ? (bf16*)(ws + WS_OB) : (bf16*)(ws + WS_OA)) + (size_t)(tok0 + r) * 1024 + head * 128 + 4 * hk;
#pragma unroll
    for (int dt = 0; dt < 4; ++dt)
#pragma unroll
        for (int g = 0; g < 4; ++g) { v2u w; w.x = pk2(o[dt][4 * g] * inv, o[dt][4 * g + 1] * inv); w.y = pk2(o[dt][4 * g + 2] * inv, o[dt][4 * g + 3] * inv);
            *(GAS v2u*)(Op + 32 * dt + 8 * g) = w; }
}
#undef ATT_LOAD
#undef ATT_STORE
__device__ __forceinline__ void p4_attention(unsigned char* ws, LAS unsigned char* lds, int bx, int G, int wave, int lane) {
    const int tid = wave * 64 + lane;
    for (int i = bx; i < 256; i += G) {
        const int xcd = i & 7, idx = i >> 3;
#ifndef NO_MLA
        { const int bh = (idx >> 2) * 8 + xcd, qp = idx & 3, b = bh >> 3, h = bh & 7;
          attn_unit<false>(ws, lds, b, h, 7 - qp, wave, lane, tid); attn_unit<false>(ws, lds, b, h, qp, wave, lane, tid); }
#endif
#ifndef NO_DSA
        { const int bg = (idx >> 4) * 8 + xcd, cp = idx & 15, b = bg >> 1, g = bg & 1;
          attn_unit<true>(ws, lds, b, g, 31 - cp, wave, lane, tid); attn_unit<true>(ws, lds, b, g, cp, wave, lane, tid); }
#endif
    }
}

typedef __bf16 bf16x2_t __attribute__((ext_vector_type(2)));
__device__ __forceinline__ float dot2bf(unsigned w, unsigned x, float acc) { return __builtin_amdgcn_fdot2_f32_bf16(__builtin_bit_cast(bf16x2_t, w), __builtin_bit_cast(bf16x2_t, x), acc, false); }
#ifndef P8_BATCH
#define P8_BATCH 2
#endif
typedef float f32x2v __attribute__((ext_vector_type(2)));
struct P8Set { v4u u[P8_BATCH][2], v[P8_BATCH][2]; float su[P8_BATCH], sv[P8_BATCH], g[P8_BATCH]; };
__device__ __forceinline__ void p8_load(P8Set& s, const unsigned char* U8, const unsigned char* V8, const float* USC, const float* VSC, const LAS int* EXi, const LAS float* EXg, int e0, int lane) {
#pragma unroll
    for (int q = 0; q < P8_BATCH; ++q) {
        const int ex = __builtin_amdgcn_readfirstlane(EXi[e0 + q]); s.g[q] = __builtin_bit_cast(float, __builtin_amdgcn_readfirstlane(__builtin_bit_cast(int, EXg[e0 + q])));
        const unsigned char* up = U8 + (size_t)ex * D + lane * 16; const unsigned char* vp = V8 + (size_t)ex * D + lane * 16;
        s.u[q][0] = *(const GAS v4u*)up; s.u[q][1] = *(const GAS v4u*)(up + 1024); s.v[q][0] = *(const GAS v4u*)vp; s.v[q][1] = *(const GAS v4u*)(vp + 1024);
        s.su[q] = USC[ex]; s.sv[q] = VSC[ex];
    }
}
__device__ __forceinline__ void p8_compute(const P8Set& s, const f32x4 (&xn)[8], f32x4 (&acc)[8]) {
#pragma unroll
    for (int q = 0; q < P8_BATCH; ++q) {
        float d0 = 0.f, d1 = 0.f, d2 = 0.f, d3 = 0.f;
#pragma unroll
        for (int j = 0; j < 2; ++j)
#pragma unroll
            for (int c = 0; c < 4; ++c) { const unsigned w = s.u[q][j][c]; const f32x2v lo = __builtin_amdgcn_cvt_pk_f32_fp8(w, false), hi = __builtin_amdgcn_cvt_pk_f32_fp8(w, true); const f32x4 x = xn[4 * j + c];
                d0 += lo.x * x.x; d1 += lo.y * x.y; d2 += hi.x * x.z; d3 += hi.y * x.w; }
        const float z = wave_sum((d0 + d1) + (d2 + d3)) * s.su[q];
        const float coef = s.g[q] * s.sv[q] * 0.5f * z * (1.0f + erff(z * 0.70710678118654752f));
#pragma unroll
        for (int j = 0; j < 2; ++j)
#pragma unroll
            for (int c = 0; c < 4; ++c) { const unsigned w = s.v[q][j][c]; const f32x2v lo = __builtin_amdgcn_cvt_pk_f32_fp8(w, false), hi = __builtin_amdgcn_cvt_pk_f32_fp8(w, true);
                acc[4 * j + c].x += coef * lo.x; acc[4 * j + c].y += coef * lo.y; acc[4 * j + c].z += coef * hi.x; acc[4 * j + c].w += coef * hi.y; }
    }
}
__device__ __forceinline__ void p8_peer(const Args& a, LAS unsigned char* lds, int vcu, int G, int wave, int lane_in) {
    unsigned char* ws = a.ws;
    const unsigned char* U8 = ws + WS_U; const unsigned char* V8 = ws + WS_V; const float* USC = (const float*)(ws + WS_USC); const float* VSC = (const float*)(ws + WS_VSC); const float* S = (const float*)(ws + WS_S);
    LAS float* T1v = (LAS float*)(lds + wave * 16384);
    LAS int*   T1i = (LAS int*)(lds + wave * 16384 + 1024);
    LAS float* EXg = (LAS float*)(lds + wave * 16384 + 2048);
    LAS int*   EXi = (LAS int*)(lds + wave * 16384 + 2560);
    const int gw = vcu * NWAVES + wave, NGW = G * NWAVES;
    const float NINF = -__builtin_inff();
    for (int m = gw; m < M; m += NGW) {
        int lane = lane_in; asm volatile("" : "+v"(lane));
        const float* xrow = a.out + (size_t)m * D;
        float rstd;
        { f32x4 xt[8]; float ss = 0.f;
#pragma unroll
          for (int j = 0; j < 2; ++j)
#pragma unroll
            for (int c = 0; c < 4; ++c) xt[4 * j + c] = *(const GAS f32x4*)(xrow + j * 1024 + lane * 16 + 4 * c);
#pragma unroll
          for (int j = 0; j < 8; ++j) ss += (xt[j].x * xt[j].x + xt[j].y * xt[j].y) + (xt[j].z * xt[j].z + xt[j].w * xt[j].w);
          rstd = 1.0f / sqrtf(wave_sum(ss) * (1.f / D) + EPS); }
        {
            float sv[32];
#pragma unroll
            for (int q = 0; q < 8; ++q) { const f32x4 t = *(const GAS f32x4*)(S + (size_t)m * 2048 + lane * 32 + q * 4); sv[4 * q] = t.x; sv[4 * q + 1] = t.y; sv[4 * q + 2] = t.z; sv[4 * q + 3] = t.w; }
            const int qb = (lane & 3) * 32;
#pragma unroll 1
            for (int it = 0; it < 16; ++it) {
                float mx = sv[0];
#pragma unroll
                for (int i = 1; i < 32; ++i) mx = fmaxf(mx, sv[i]);
                float qm = fmaxf(mx, __shfl_xor(mx, 1)); qm = fmaxf(qm, __shfl_xor(qm, 2));
                int bi = 1000;
#pragma unroll
                for (int i = 31; i >= 0; --i) bi = (sv[i] == qm) ? (qb + i) : bi;
                int qi = min(bi, __shfl_xor(bi, 1)); qi = min(qi, __shfl_xor(qi, 2));
                const int li = qi - qb;
#pragma unroll
                for (int i = 0; i < 32; ++i) sv[i] = (i == li) ? NINF : sv[i];
                if ((lane & 3) == 0) { T1v[(lane >> 2) * 16 + it] = qm; T1i[(lane >> 2) * 16 + it] = qi; }
            }
        }
        LDS_WAIT(); asm volatile("" ::: "memory");
        {
            const int h = lane >> 3, e = lane & 7;
            const LAS float* s1p = T1v + (2 * h) * 16; const LAS float* s2p = T1v + (2 * h + 1) * 16;
            const float s1a = s1p[e], s1b = s1p[e + 8];
            float cv[17];
#pragma unroll
            for (int k = 0; k < 16; ++k) cv[k] = ((e + 1) * (k + 1) <= 16) ? s1a + s2p[k] : NINF;
            cv[16] = s1b + s2p[0];
            float smax = 0.f, den = 0.f;
#pragma unroll 1
            for (int it = 0; it < 16; ++it) {
                float mx = cv[0];
#pragma unroll
                for (int k = 1; k < 17; ++k) mx = fmaxf(mx, cv[k]);
                float gm = fmaxf(mx, __shfl_xor(mx, 1)); gm = fmaxf(gm, __shfl_xor(gm, 2)); gm = fmaxf(gm, __shfl_xor(gm, 4));
                int bp = 100000;
                bp = (cv[16] == gm) ? ((e + 8) * 16) : bp;
#pragma unroll
                for (int k = 15; k >= 0; --k) bp = (cv[k] == gm) ? (e * 16 + k) : bp;
                int gp = min(bp, __shfl_xor(bp, 1)); gp = min(gp, __shfl_xor(gp, 2)); gp = min(gp, __shfl_xor(gp, 4));
                const int lk = (gp == (e + 8) * 16) ? 16 : (((gp >> 4) == e) ? (gp & 15) : -1);
#pragma unroll
                for (int k = 0; k < 17; ++k) cv[k] = (k == lk) ? NINF : cv[k];
                if (it == 0) smax = gm;
                const float ex = __expf((gm - smax) * rstd); den += ex;
                if (e == 0) { const int r1 = gp >> 4, r2 = gp & 15; EXg[h * 16 + it] = ex; EXi[h * 16 + it] = T1i[(2 * h) * 16 + r1] * 128 + T1i[(2 * h + 1) * 16 + r2]; }
            }
            LDS_WAIT(); asm volatile("" ::: "memory");
            const float inv = 1.0f / den;
            EXg[h * 16 + 2 * e] *= inv; EXg[h * 16 + 2 * e + 1] *= inv;
        }
        LDS_WAIT(); asm volatile("" ::: "memory");
        f32x4 acc[8], xn[8];
#pragma unroll
        for (int j = 0; j < 8; ++j) acc[j] = (f32x4){0.f, 0.f, 0.f, 0.f};
#pragma unroll
        for (int j = 0; j < 2; ++j)
#pragma unroll
            for (int c = 0; c < 4; ++c) xn[4 * j + c] = *(const GAS f32x4*)(xrow + j * 1024 + lane * 16 + 4 * c) * rstd * *(const f32x4*)(a.g_ffn + j * 1024 + lane * 16 + 4 * c);
        {
            P8Set sa, sb;
            p8_load(sa, U8, V8, USC, VSC, EXi, EXg, 0, lane);
#pragma unroll 1
            for (int e0 = 0; e0 < 128; e0 += 2 * P8_BATCH) {
                p8_load(sb, U8, V8, USC, VSC, EXi, EXg, e0 + P8_BATCH, lane);
                p8_compute(sa, xn, acc);
                if (e0 + 2 * P8_BATCH < 128) p8_load(sa, U8, V8, USC, VSC, EXi, EXg, e0 + 2 * P8_BATCH, lane);
                p8_compute(sb, xn, acc);
            }
        }
        float s2 = 0.f;
#pragma unroll
        for (int j = 0; j < 2; ++j)
#pragma unroll
            for (int c = 0; c < 4; ++c) { acc[4 * j + c] = acc[4 * j + c] + *(const GAS f32x4*)(xrow + j * 1024 + lane * 16 + 4 * c); }
#pragma unroll
        for (int j = 0; j < 8; ++j) s2 += (acc[j].x * acc[j].x + acc[j].y * acc[j].y) + (acc[j].z * acc[j].z + acc[j].w * acc[j].w);
        const float rstd2 = 1.0f / sqrtf(wave_sum(s2) * (1.f / D) + EPS);
        float* orow = a.out + (size_t)m * D;
#pragma unroll
        for (int j = 0; j < 2; ++j)
#pragma unroll
            for (int c = 0; c < 4; ++c) *(GAS f32x4*)(orow + j * 1024 + lane * 16 + 4 * c) = acc[4 * j + c] * rstd2 * *(const f32x4*)(a.g_fin + j * 1024 + lane * 16 + 4 * c);
        LDS_WAIT(); asm volatile("" ::: "memory");
    }
}

#ifndef N_LAUNCHES
#define N_LAUNCHES 1
#endif
constexpr int NPHASE = 9;
__global__ void __launch_bounds__(NWAVES * 64, 2) mk_fwd(Args args) {
    extern __shared__ __attribute__((aligned(16))) unsigned char lds_raw[];
    LAS unsigned char* lds = (LAS unsigned char*)lds_raw;
    volatile LAS unsigned* MISC = (volatile LAS unsigned*)(lds + MISC_OFF);
    const int wave = __builtin_amdgcn_readfirstlane(threadIdx.x >> 6);
#define lane (lane_id())
#define tid (wave * 64 + lane)
    const int G = gridDim.x; const int bx = blockIdx.x; const int vcu = (G % 8 == 0) ? (bx % 8) * (G / 8) + bx / 8 : bx;
    unsigned char* ws = args.ws;
    gu32* ctl = (gu32*)(ws + WS_CTL);
    for (int u = tid; u < (LDS_BYTES - LDSCTL_OFF) / 4; u += NWAVES * 64) ((LAS unsigned*)(lds + LDSCTL_OFF))[u] = 0u;
    __syncthreads();
    XcdBarrier bar; bar.bar = (unsigned*)(ctl + CW_BAR); bar.x = 0; bar.st = nullptr;
    if (N_LAUNCHES == 1) bar = xcd_barrier_post((unsigned*)(ctl + CW_BAR), MISC + 8);
    const int lo = args.ph_lo, hi = args.ph_hi;
#ifndef PHMASK
#define PHMASK 0x1ff
#endif
#define IN(k) (((PHMASK >> (k)) & 1) && lo <= (k) && (k) < hi)
#define GRID_BAR(k) do { if (IN(k) && IN((k) + 1)) xcd_barrier(bar, wave == 0 && lane == 0); } while (0)
#ifndef REPEAT_PHASE
#define REPEAT_PHASE -1
#endif
#define REP(k) for (int rep_ = 0; rep_ < ((REPEAT_PHASE == (k)) ? 2 : 1); ++rep_, ((REPEAT_PHASE == (k)) && rep_ < 2 ? xcd_barrier(bar, wave == 0 && lane == 0) : (void)0))

    REP(0) if (IN(0)) { p0_prologue(args, lds, vcu, G, wave, lane); }
    GRID_BAR(0);
    REP(1) if (IN(1)) {
        pg8::Gemm g{(const bf16*)(ws + WS_XN), (const bf16*)(ws + WS_XN), M, N1, D}; Order<1> S; S.init(64, 30, G, bx);
        Epi1 E{ws, (bf16*)args.out};
        pg8::gemm_phase<Epi1, Order<1>, true, true>(lds + RING_OFF, g, S, E, wave);
    }
    GRID_BAR(1);
    REP(2) if (IN(2)) { p2_rowstats(ws, vcu, G, wave, lane); p2_indexer(ws, lds, bx, G, wave, lane);
#ifdef REP_INDEXER
        p2_indexer(ws, lds, bx, G, wave, lane);
#endif
    }
    GRID_BAR(2);
    REP(3) if (IN(3)) {
        { pg8::Gemm g{(const bf16*)(ws + WS_CQ), (const bf16*)(ws + WS_WUQ), M, 1536, 512}; Order<0> S; S.init(64, 6, G, bx); Epi3q E{ws};
          pg8::gemm_phase<Epi3q, Order<0>, true, true>(lds + RING_OFF, g, S, E, wave); }
        { pg8::Gemm g{(const bf16*)(ws + WS_CKV), (const bf16*)(ws + WS_CKV), M, 2048, 256}; Order<2> S; S.init(64, 8, G, bx); Epi3k E{ws};
          pg8::gemm_phase<Epi3k, Order<2>, true, true>(lds + RING_OFF, g, S, E, wave); }
        p3_select(ws, vcu, G, wave, lane);
#ifdef REP_SELECT
        p3_select(ws, vcu, G, wave, lane);
#endif
    }
    GRID_BAR(3);
    REP(4) if (IN(4)) { p4_attention(ws, lds, bx, G, wave, lane); }
    GRID_BAR(4);
    REP(5) if (IN(5)) {
        pg8::Gemm g{(const bf16*)(ws + WS_OA), (const bf16*)(ws + WS_WAB), 2 * M, 4096, 1024}; Order<3> S; S.init(64, 8, G, bx); Epi5 E{ws, (const bf16*)args.out};
        pg8::gemm_phase<Epi5, Order<3>, true, true>(lds + RING_OFF, g, S, E, wave);
    }
    GRID_BAR(5);
    REP(6) if (IN(6)) {
        pg8::Gemm g{(const bf16*)(ws + WS_MRG), (const bf16*)(ws + WS_WO), M, D, D}; Order<0> S; S.init(64, 8, G, bx); Epi6 E{ws, args.x, args.out};
        pg8::gemm_phase<Epi6, Order<0>, true, true>(lds + RING_OFF, g, S, E, wave);
    }
    GRID_BAR(6);
    REP(7) if (IN(7)) {
        pg8::Gemm g{(const bf16*)(ws + WS_X1B), (const bf16*)(ws + WS_W2), M, D, D}; Order<0> S; S.init(64, 8, G, bx); Epi7 E{ws};
        pg8::gemm_phase<Epi7, Order<0>, true, true>(lds + RING_OFF, g, S, E, wave);
    }
    GRID_BAR(7);
    if (IN(8)) { p8_peer(args, lds, vcu, G, wave, lane); }
#undef IN
#undef GRID_BAR
#undef lane
#undef tid
}

extern "C" void kernel_launch(void* const* d_in, const int* in_sizes, int n_in, void* d_out, int out_size, void* d_ws, size_t ws_size, hipStream_t stream) {
    static int grid = 0;
    if (grid == 0) {
        if (n_in != 18 || in_sizes[0] != M * D || out_size != M * D || ws_size < WS_END) { fprintf(stderr, "kernel_launch: unexpected problem (n_in %d, in0 %d, out %d, ws %zu)\n", n_in, n_in > 0 ? in_sizes[0] : -1, out_size, ws_size); grid = -1; return; }
        int dev = 0, cus = 0, per_cu = 0;
        if (hipGetDevice(&dev) != hipSuccess || hipDeviceGetAttribute(&cus, hipDeviceAttributeMultiprocessorCount, dev) != hipSuccess) { grid = -1; return; }
        if (hipFuncSetAttribute((const void*)mk_fwd, hipFuncAttributeMaxDynamicSharedMemorySize, LDS_BYTES) != hipSuccess) { fprintf(stderr, "kernel_launch: hipFuncSetAttribute failed\n"); grid = -1; return; }
        if (hipOccupancyMaxActiveBlocksPerMultiprocessor(&per_cu, (const void*)mk_fwd, NWAVES * 64, LDS_BYTES) != hipSuccess || per_cu < 1)
            fprintf(stderr, "kernel_launch: note: occupancy query reports %d workgroups per CU\n", per_cu);
        (void)hipGetLastError();
        grid = cus;
    }
    if (grid < 0) return;
    if (hipMemsetAsync((char*)d_ws + WS_CTL, 0, CTL_ZERO_BYTES, stream) != hipSuccess) return;
    Args a{};
    a.x = (const float*)d_in[0]; a.pos = (const int*)d_in[1]; a.g_mix = (const float*)d_in[2]; a.w_in = (const float*)d_in[3]; a.g_q = (const float*)d_in[4]; a.g_kv = (const float*)d_in[5];
    a.w_uq = (const float*)d_in[6]; a.w_uk = (const float*)d_in[7]; a.w_uv = (const float*)d_in[8]; a.w_a = (const float*)d_in[9]; a.w_b = (const float*)d_in[10]; a.w_o = (const float*)d_in[11];
    a.g_ffn = (const float*)d_in[12]; a.w_pq = (const float*)d_in[13]; a.subk = (const float*)d_in[14]; a.pu = (const float*)d_in[15]; a.pv = (const float*)d_in[16]; a.g_fin = (const float*)d_in[17];
    a.out = (float*)d_out; a.ws = (unsigned char*)d_ws;
    for (int i = 0; i < 32; ++i) a.invf[i] = pow(500000.0, -(2.0 * i) / 64.0);
    for (int i = 0; i < 16; ++i) a.invf[32 + i] = pow(500000.0, -(2.0 * i) / 32.0);
    for (int i = 0; i < 8; ++i) a.invf[48 + i] = pow(500000.0, -(2.0 * i) / 16.0);
    if (N_LAUNCHES == 1) { a.ph_lo = 0; a.ph_hi = NPHASE; hipLaunchKernelGGL(mk_fwd, dim3(grid), dim3(NWAVES * 64), LDS_BYTES, stream, a); }
    else for (int li = 0; li < NPHASE; ++li) { a.ph_lo = li; a.ph_hi = li + 1; hipLaunchKernelGGL(mk_fwd, dim3(grid), dim3(NWAVES * 64), LDS_BYTES, stream, a); }
}
```

```cpp
#include <hip/hip_runtime.h>
#include <cstdio>
#include <cstdint>
#include <cmath>
namespace pg8 {
#define PG8_LAS __attribute__((address_space(3)))
typedef unsigned short bf16_t;
typedef short bf16x8 __attribute__((ext_vector_type(8)));
typedef float f32x4 __attribute__((ext_vector_type(4)));
typedef unsigned u32x4 __attribute__((ext_vector_type(4)));
constexpr int BM = 256, BK = 64, HALF = 128, HTB = HALF * BK * 2  , STAGE_BYTES = 8 * HTB, NXCD = 8, WGM = 8;

__host__ __device__ __forceinline__ int lds_byte(int r, int c) { const int st = (r >> 4) * 2 + (c >> 5), rr = r & 15, cc = c & 31, ob = rr * 64 + cc * 2; return st * 1024 + (ob ^ (((ob >> 9) & 1) << 5)); }
__host__ __device__ __forceinline__ void stage_rc(int b, int& R, int& C) { const int st = b / 1024, sb = b % 1024, swz = sb ^ (((sb >> 9) & 1) << 5); R = (st >> 1) * 16 + swz / 64; C = (st & 1) * 32 + (swz % 64) / 2; }
__host__ __device__ __forceinline__ int perm32(int rho) { const int n = rho >> 4, i = rho & 15; return 8 * (i >> 2) + 4 * n + (i & 3); }

struct Unit { int pm, pn; };
struct Gemm { const bf16_t* A; const bf16_t* Bt; int M, N, K; int sA, sB; };
typedef int v8i_t __attribute__((ext_vector_type(8)));
typedef int v4i_t __attribute__((ext_vector_type(4)));
__device__ __forceinline__ v8i_t pg8_cat(bf16x8 lo, bf16x8 hi) { const v4i_t a = __builtin_bit_cast(v4i_t, lo), b = __builtin_bit_cast(v4i_t, hi); return (v8i_t){a.x, a.y, a.z, a.w, b.x, b.y, b.z, b.w}; }

template <class Epi, class Sched, bool ALIGN_EPI = false, bool SP2 = false, bool F8 = false  >
__device__ __forceinline__ void gemm_phase(PG8_LAS unsigned char* lds, const Gemm g, const Sched& S, const Epi& E, const int wid) {
    int lane; asm volatile("v_mbcnt_lo_u32_b32 %0, -1, 0\n\tv_mbcnt_hi_u32_b32 %0, -1, %0" : "=v"(lane)); const int tid = wid * 64 + lane, wr = wid >> 2, wc = wid & 3, fr = lane & 15, fq = lane >> 4;
    const int RB = F8 ? g.K : 2 * g.K, nt = RB / 128;
    unsigned voffA[2], voffB[2];
#pragma unroll
    for (int i = 0; i < 2; ++i) { int R, C; stage_rc(tid * 16 + i * 8192, R, C); const int Rb = Epi::PERM ? ((R & ~31) + perm32(R & 31)) : R;
        voffA[i] = (unsigned)(R * RB + 2 * C); voffB[i] = (unsigned)(Rb * RB + 2 * C); }
    const size_t kstep = (size_t)(BK * 2);
    const size_t hstep = (size_t)HALF * RB;
    const size_t tstep = 2 * hstep;
    const unsigned ldsw = (unsigned)wid * 1024u;
    const int aoff = lds_byte(wr * 64 + fr, fq * 8), boff = lds_byte(wc * 32 + fr, fq * 8);
    PG8_LAS unsigned char* ldsA = lds + aoff; PG8_LAS unsigned char* ldsB = lds + 65536 + boff; asm volatile("" : "+v"(ldsA), "+v"(ldsB));
#define PG8_SA(b, h) (((b) * 2 + (h)) * HTB)
#define PG8_SB(b, h) ((4 + (b) * 2 + (h)) * HTB)
#define PG8_STAGE(bufoff, gbase, voff) do { _Pragma("unroll") for (int _i = 0; _i < 2; ++_i) \
        __builtin_amdgcn_global_load_lds((const unsigned*)((const char*)(gbase) + (voff)[_i]), (PG8_LAS unsigned*)(lds + (bufoff) + ldsw + _i * 8192), 16, 0, 0); } while (0)
#define PG8_LD16A(off) (*(const PG8_LAS v4i_t*)(ldsA + (off)))
#define PG8_LD16B(off) (*(const PG8_LAS v4i_t*)(ldsB + (off)))
#define PG8_LDA(dst, b, h) do { _Pragma("unroll") for (int m = 0; m < 4; ++m) { if constexpr (F8) { const v4i_t lo_ = PG8_LD16A(PG8_SA(b, h) + m * 2048), hi_ = PG8_LD16A(PG8_SA(b, h) + m * 2048 + 1024); \
        dst##8[m] = (v8i_t){lo_.x, lo_.y, lo_.z, lo_.w, hi_.x, hi_.y, hi_.z, hi_.w}; } else { _Pragma("unroll") for (int k = 0; k < 2; ++k) dst[m][k] = *(const PG8_LAS bf16x8*)(ldsA + PG8_SA(b, h) + m * 2048 + k * 1024); } } } while (0)
#define PG8_LDB(dst, b, h) do { _Pragma("unroll") for (int n = 0; n < 2; ++n) { if constexpr (F8) { const v4i_t lo_ = PG8_LD16B(PG8_SB(b, h) - 65536 + n * 2048), hi_ = PG8_LD16B(PG8_SB(b, h) - 65536 + n * 2048 + 1024); \
        dst##8[n] = (v8i_t){lo_.x, lo_.y, lo_.z, lo_.w, hi_.x, hi_.y, hi_.z, hi_.w}; } else { _Pragma("unroll") for (int k = 0; k < 2; ++k) dst[n][k] = *(const PG8_LAS bf16x8*)(ldsB + PG8_SB(b, h) - 65536 + n * 2048 + k * 1024); } } } while (0)
#define PG8_MMA(ai, bj, At, Bt) do { __builtin_amdgcn_s_setprio(1); \
        if constexpr (F8) { _Pragma("unroll") for (int m = 0; m < 4; ++m) _Pragma("unroll") for (int n = 0; n < 2; ++n) \
            asm volatile("v_mfma_scale_f32_16x16x128_f8f6f4 %0, %1, %2, %0, %3, %4 op_sel_hi:[0,0,0]" : "+v"(acc[ai][bj][m][n]) : "v"(Bt##8[n]), "v"(At##8[m]), "v"(sclB), "v"(sclA)); } \
        else { _Pragma("unroll") for (int m = 0; m < 4; ++m) _Pragma("unroll") for (int n = 0; n < 2; ++n) _Pragma("unroll") for (int k = 0; k < 2; ++k) \
            acc[ai][bj][m][n] = __builtin_amdgcn_mfma_f32_16x16x32_bf16(Bt[n][k], At[m][k], acc[ai][bj][m][n], 0, 0, 0); } \
        __builtin_amdgcn_s_setprio(0); } while (0)
#define PG8_WAIT_V(n) asm volatile("s_waitcnt vmcnt(" #n ")" ::: "memory")
#define PG8_WAIT_L(n) asm volatile("s_waitcnt lgkmcnt(" #n ")" ::: "memory")
#define PG8_BAR __builtin_amdgcn_s_barrier()
#define PG8_SCHED __builtin_amdgcn_sched_barrier(0)
    Unit cur, nxt; int ui = 0;
    if (!S.next(0, cur)) return;
    f32x4 acc[2][2][4][2];
#pragma unroll
    for (int a = 0; a < 2; ++a)
#pragma unroll
        for (int b = 0; b < 2; ++b)
#pragma unroll
            for (int m = 0; m < 4; ++m)
#pragma unroll
                for (int n = 0; n < 2; ++n) acc[a][b][m][n] = (f32x4){0.f, 0.f, 0.f, 0.f};
    int sclA = g.sA, sclB = g.sB; asm volatile("" : "+v"(sclA), "+v"(sclB));
    bf16x8 At[4][2], B0[2][2], B1[2][2]; v8i_t At8[4], B08[2], B18[2]; (void)At; (void)B0; (void)B1; (void)At8; (void)B08; (void)B18;
    const char* cA = (const char*)g.A + (size_t)cur.pm * tstep; const char* cB = (const char*)g.Bt + (size_t)cur.pn * tstep;
    S.a_ready(cur);
    if constexpr (SP2) {
        PG8_STAGE(PG8_SB(0, 0), cB, voffB); PG8_STAGE(PG8_SB(0, 1), cB + hstep, voffB); PG8_STAGE(PG8_SA(0, 0), cA, voffA); PG8_STAGE(PG8_SA(0, 1), cA + hstep, voffA);
        if (wr == 1) PG8_BAR;
        PG8_WAIT_V(2); PG8_BAR;
        PG8_STAGE(PG8_SB(1, 0), cB + kstep, voffB); PG8_STAGE(PG8_SA(1, 0), cA + kstep, voffA); PG8_STAGE(PG8_SB(1, 1), cB + hstep + kstep, voffB);
        PG8_WAIT_V(6); PG8_BAR;
    } else {
        PG8_STAGE(PG8_SB(0, 0), cB, voffB); PG8_STAGE(PG8_SA(0, 0), cA, voffA); PG8_STAGE(PG8_SB(0, 1), cB + hstep, voffB); PG8_STAGE(PG8_SA(0, 1), cA + hstep, voffA);
        if (wr == 1) PG8_BAR;
        PG8_WAIT_V(4); PG8_BAR;
        PG8_STAGE(PG8_SB(1, 0), cB + kstep, voffB); PG8_STAGE(PG8_SA(1, 0), cA + kstep, voffA); PG8_STAGE(PG8_SB(1, 1), cB + hstep + kstep, voffB);
        PG8_WAIT_V(6); PG8_BAR;
    }
    for (;;) {
        const bool has_next = S.next(ui + 1, nxt);
        const char* nA = has_next ? (const char*)g.A + (size_t)nxt.pm * tstep : cA; const char* nB = has_next ? (const char*)g.Bt + (size_t)nxt.pn * tstep : cB;
        for (int t = 0; t < nt; t += 2) {
            const bool last = (t == nt - 2);
            const char* a1 = cA + (size_t)(t + 1) * kstep;
            const char* a2 = last ? nA : cA + (size_t)(t + 2) * kstep; const char* b2 = last ? nB : cB + (size_t)(t + 2) * kstep;
            const char* a3 = a2 + kstep; const char* b3 = b2 + kstep;
            if (last && has_next) S.a_ready(nxt);
            if constexpr (SP2) {
            PG8_LDB(B0, 0, 0); PG8_LDB(B1, 0, 1); PG8_SCHED; PG8_LDA(At, 0, 0); PG8_STAGE(PG8_SA(1, 1), a1 + hstep, voffA);
            PG8_WAIT_V(8); PG8_WAIT_L(0); PG8_BAR; PG8_MMA(0, 0, At, B0); PG8_MMA(0, 1, At, B1); PG8_BAR; PG8_SCHED;
            PG8_LDA(At, 0, 1); PG8_STAGE(PG8_SB(0, 0), b2, voffB); PG8_STAGE(PG8_SB(0, 1), b2 + hstep, voffB); PG8_STAGE(PG8_SA(0, 0), a2, voffA);
            PG8_WAIT_V(8); PG8_WAIT_L(0); PG8_BAR; PG8_MMA(1, 0, At, B0); PG8_MMA(1, 1, At, B1); PG8_BAR; PG8_SCHED;
            PG8_LDB(B0, 1, 0); PG8_LDB(B1, 1, 1); PG8_SCHED; PG8_LDA(At, 1, 0); PG8_STAGE(PG8_SA(0, 1), a2 + hstep, voffA);
            PG8_WAIT_V(8); PG8_WAIT_L(0); PG8_BAR; PG8_MMA(0, 0, At, B0); PG8_MMA(0, 1, At, B1); PG8_BAR; PG8_SCHED;
            PG8_LDA(At, 1, 1); PG8_STAGE(PG8_SB(1, 0), b3, voffB); PG8_STAGE(PG8_SB(1, 1), b3 + hstep, voffB); PG8_STAGE(PG8_SA(1, 0), a3, voffA);
            PG8_WAIT_V(8); PG8_WAIT_L(0); PG8_BAR; PG8_MMA(1, 0, At, B0); PG8_MMA(1, 1, At, B1); PG8_BAR; PG8_SCHED;
            } else {
            PG8_LDB(B0, 0, 0); PG8_SCHED; PG8_LDA(At, 0, 0); PG8_STAGE(PG8_SA(1, 1), a1 + hstep, voffA);
            PG8_WAIT_L(8); PG8_BAR; PG8_WAIT_L(0); PG8_MMA(0, 0, At, B0); PG8_BAR; PG8_SCHED;
            PG8_LDB(B1, 0, 1); PG8_STAGE(PG8_SB(0, 0), b2, voffB);
            PG8_BAR; PG8_WAIT_L(0); PG8_MMA(0, 1, At, B1); PG8_BAR;
            PG8_LDA(At, 0, 1); PG8_STAGE(PG8_SA(0, 0), a2, voffA);
            PG8_BAR; PG8_WAIT_L(0); PG8_MMA(1, 0, At, B0); PG8_BAR; PG8_SCHED;
            PG8_STAGE(PG8_SB(0, 1), b2 + hstep, voffB);
            PG8_WAIT_V(6); PG8_BAR; PG8_MMA(1, 1, At, B1); PG8_BAR;
            PG8_LDB(B0, 1, 0); PG8_SCHED; PG8_LDA(At, 1, 0); PG8_STAGE(PG8_SA(0, 1), a2 + hstep, voffA);
            PG8_WAIT_L(8); PG8_BAR; PG8_WAIT_L(0); PG8_MMA(0, 0, At, B0); PG8_BAR; PG8_SCHED;
            PG8_LDB(B1, 1, 1); PG8_STAGE(PG8_SB(1, 0), b3, voffB);
            PG8_BAR; PG8_WAIT_L(0); PG8_MMA(0, 1, At, B1); PG8_BAR;
            PG8_LDA(At, 1, 1); PG8_STAGE(PG8_SA(1, 0), a3, voffA);
            PG8_BAR; PG8_WAIT_L(0); PG8_MMA(1, 0, At, B0); PG8_BAR; PG8_SCHED;
            PG8_STAGE(PG8_SB(1, 1), b3 + hstep, voffB);
            PG8_WAIT_V(6); PG8_BAR; PG8_MMA(1, 1, At, B1); PG8_BAR;
            }
        }
        if constexpr (F8) {
            asm volatile("s_nop 15\n\ts_nop 15\n\ts_nop 15" : "+v"(acc[0][0][0][0]), "+v"(acc[0][0][0][1]), "+v"(acc[0][0][1][0]), "+v"(acc[0][0][1][1]), "+v"(acc[0][0][2][0]), "+v"(acc[0][0][2][1]), "+v"(acc[0][0][3][0]), "+v"(acc[0][0][3][1]), "+v"(acc[0][1][0][0]), "+v"(acc[0][1][0][1]), "+v"(acc[0][1][1][0]), "+v"(acc[0][1][1][1]), "+v"(acc[0][1][2][0]), "+v"(acc[0][1][2][1]), "+v"(acc[0][1][3][0]), "+v"(acc[0][1][3][1]) :: "memory");
            asm volatile("" : "+v"(acc[1][0][0][0]), "+v"(acc[1][0][0][1]), "+v"(acc[1][0][1][0]), "+v"(acc[1][0][1][1]), "+v"(acc[1][0][2][0]), "+v"(acc[1][0][2][1]), "+v"(acc[1][0][3][0]), "+v"(acc[1][0][3][1]), "+v"(acc[1][1][0][0]), "+v"(acc[1][1][0][1]), "+v"(acc[1][1][1][0]), "+v"(acc[1][1][1][1]), "+v"(acc[1][1][2][0]), "+v"(acc[1][1][2][1]), "+v"(acc[1][1][3][0]), "+v"(acc[1][1][3][1]));
            __builtin_amdgcn_sched_barrier(0); }
        if constexpr (ALIGN_EPI) { if (wr == 0) PG8_BAR; }
        if constexpr (!Epi::AFTER_DRAIN) { E(acc, cur, wr, wc, fr, fq); S.done(cur); }
        if (!has_next) break;
#pragma unroll
        for (int a = 0; a < 2; ++a)
#pragma unroll
            for (int b = 0; b < 2; ++b)
#pragma unroll
                for (int m = 0; m < 4; ++m)
#pragma unroll
                    for (int n = 0; n < 2; ++n) acc[a][b][m][n] = (f32x4){0.f, 0.f, 0.f, 0.f};
        cur = nxt; cA = nA; cB = nB; ++ui;
        if constexpr (ALIGN_EPI) { if (wr == 1) PG8_BAR; }
    }
    PG8_WAIT_V(0);
    if constexpr (!ALIGN_EPI) { if (wr == 0) PG8_BAR; }
    PG8_BAR;
    if constexpr (Epi::AFTER_DRAIN) { E.fused(acc, cur, wr, wc, fr, fq, lds, wid, lane); S.done(cur); }
#undef PG8_SA
#undef PG8_SB
#undef PG8_STAGE
#undef PG8_LD16A
#undef PG8_LD16B
#undef PG8_LDA
#undef PG8_LDB
#undef PG8_MMA
#undef PG8_WAIT_V
#undef PG8_WAIT_L
#undef PG8_BAR
#undef PG8_SCHED
}
}

#if !defined(P1_BF16) && !defined(P1_FP8)
#define P1_FP8 1
#endif
#if !defined(P1_FP8) || defined(P1_MASK)
#define P1_NEED_BF16 1
#endif
constexpr int NWAVES = 8;
constexpr int NB = 8, SEQ = 2048, D = 2048, M = NB * SEQ;
constexpr int IN_WIDTH = 7568;
constexpr int N1 = 7680;
constexpr int NEXP = 16384;
constexpr float EPS = 1e-6f;
constexpr float LOG2E = 1.4426950408889634f;
constexpr float MLA_QSCALE = 0.07216878364870322f * LOG2E;
constexpr float DSA_QSCALE = 0.08838834764831845f * LOG2E;

constexpr size_t MiB = 1u << 20;
constexpr size_t WS_CTL = 0, CTL_ZERO_BYTES = 64 * 1024;
constexpr size_t WS_T64 = 1 * MiB;
constexpr size_t WS_T32 = 5 * MiB;
constexpr size_t WS_T16 = 7 * MiB;
constexpr size_t WS_RS  = 8 * MiB;
constexpr size_t WS_USC = 8 * MiB + 256 * 1024;
constexpr size_t WS_VSC = 8 * MiB + 512 * 1024;
constexpr size_t WS_MB  = 9 * MiB;
constexpr size_t WS_SC  = 16 * MiB;
constexpr size_t WS_XN  = 18 * MiB;
constexpr size_t WS_OA  = 16 * MiB;
constexpr size_t WS_OB  = 32 * MiB;
constexpr size_t WS_X1B = 16 * MiB;
constexpr size_t WS_WIN = 82 * MiB;
constexpr size_t WS_WUQ = 112 * MiB;
constexpr size_t WS_CKV = 114 * MiB;
constexpr size_t WS_WUK = 122 * MiB;
constexpr size_t WS_WUV = 122 * MiB + 512 * 1024;
constexpr size_t WS_WAB = 123 * MiB;
constexpr size_t WS_WO  = 131 * MiB;
constexpr size_t WS_W2  = 139 * MiB;
constexpr size_t WS_U   = 147 * MiB;
constexpr size_t WS_V   = WS_U + 1536;
#ifndef V_FP6
#define V_FP4 1
#endif
#ifdef V_FP4
constexpr int EROW = 2688;
#else
constexpr int EROW = 3072;
#endif
constexpr size_t WS_CQ  = 275 * MiB;
constexpr size_t WS_DQ  = 291 * MiB;
constexpr size_t WS_DK  = 323 * MiB;
constexpr size_t WS_DVT = 331 * MiB;
constexpr size_t WS_IQ  = 339 * MiB;
constexpr size_t WS_KR  = 371 * MiB;
constexpr size_t WS_IK  = 373 * MiB;
constexpr size_t WS_IW  = 375 * MiB;
constexpr size_t WS_Q   = 82 * MiB;
constexpr size_t WS_KN  = 424 * MiB;
constexpr size_t WS_VT  = 456 * MiB;
constexpr size_t WS_PA  = 275 * MiB;
constexpr size_t WS_MRG = 339 * MiB;
constexpr size_t WS_S   = 275 * MiB;
constexpr size_t WS_XN8 = 376 * MiB;
constexpr size_t WS_WG8 = 408 * MiB;
constexpr size_t WS_WIN8 = 416 * MiB;
constexpr size_t WS_END = 488 * MiB;
constexpr int CW_BAR = 4096;

constexpr int RING_OFF = 0, RING_BYTES = 131072;
constexpr int LDSCTL_OFF = RING_BYTES, MISC_OFF = LDSCTL_OFF + 320;
constexpr int LDS_BYTES = 147456;

#define GAS __attribute__((address_space(1)))
#define LAS __attribute__((address_space(3)))
typedef unsigned short bf16;
typedef unsigned v4u __attribute__((ext_vector_type(4)));
typedef unsigned v2u __attribute__((ext_vector_type(2)));
typedef float f32x4 __attribute__((ext_vector_type(4)));
typedef float f32x2 __attribute__((ext_vector_type(2)));
typedef float f32x16 __attribute__((ext_vector_type(16)));
typedef short bf16x8 __attribute__((ext_vector_type(8)));
typedef GAS unsigned gu32;
typedef int v8i_t __attribute__((ext_vector_type(8)));
typedef int v4i_t __attribute__((ext_vector_type(4)));
#define RLX_AGENT __ATOMIC_RELAXED, __HIP_MEMORY_SCOPE_AGENT
#define LDS_WAIT() asm volatile("s_waitcnt lgkmcnt(0)" ::: "memory")
#define VM_WAIT() asm volatile("s_waitcnt vmcnt(0)" ::: "memory")
__device__ __forceinline__ unsigned f2bf(float f) { unsigned u = __builtin_bit_cast(unsigned, f); return (u + 0x7fffu + ((u >> 16) & 1u)) >> 16; }
__device__ __forceinline__ unsigned pk2(float lo, float hi) { unsigned r; asm volatile("v_cvt_pk_bf16_f32 %0, %1, %2" : "=v"(r) : "v"(lo), "v"(hi)); return r; }
__device__ __forceinline__ float bflo(unsigned w) { return __builtin_bit_cast(float, w << 16); }
__device__ __forceinline__ float bfhi(unsigned w) { return __builtin_bit_cast(float, w & 0xffff0000u); }
__device__ __forceinline__ float wave_sum(float v) {
#pragma unroll
    for (int o = 1; o < 64; o <<= 1) v += __shfl_xor(v, o);
    return v;
}
__device__ __forceinline__ int lane_id() { int l; asm volatile("v_mbcnt_lo_u32_b32 %0, -1, 0\n\tv_mbcnt_hi_u32_b32 %0, -1, %0" : "=v"(l)); return l; }
#define SWAP_ASM(op, a, b) asm volatile("s_nop 1\n\t" op " %0, %1\n\ts_nop 1" : "+v"(a), "+v"(b))
__device__ __forceinline__ float swap16_sum(float x) { float a = x, b = x; SWAP_ASM("v_permlane16_swap_b32", a, b); return a + b; }
__device__ __forceinline__ float swap32_sum(float x) { float a = x, b = x; SWAP_ASM("v_permlane32_swap_b32", a, b); return a + b; }
__device__ __forceinline__ float swap16_max(float x) { float a = x, b = x; SWAP_ASM("v_permlane16_swap_b32", a, b); return fmaxf(a, b); }
__device__ __forceinline__ float swap32_max(float x) { float a = x, b = x; SWAP_ASM("v_permlane32_swap_b32", a, b); return fmaxf(a, b); }
template <int CTRL> __device__ __forceinline__ float dpp_f(float x) { return __builtin_bit_cast(float, __builtin_amdgcn_mov_dpp(__builtin_bit_cast(int, x), CTRL, 0xf, 0xf, true)); }
template <int CTRL> __device__ __forceinline__ int dpp_i(int x) { return __builtin_amdgcn_mov_dpp(x, CTRL, 0xf, 0xf, true); }
__device__ __forceinline__ float wave_sum_fast(float x) {
    x += dpp_f<0xB1>(x); x += dpp_f<0x4E>(x); x += dpp_f<0x124>(x); x += dpp_f<0x128>(x);
    return swap32_sum(swap16_sum(x));
}
__device__ __forceinline__ float wave_sum_uniform(float x) {
    x += dpp_f<0xB1>(x); x += dpp_f<0x4E>(x); x += dpp_f<0x124>(x); x += dpp_f<0x128>(x);
    x += __builtin_bit_cast(float, __builtin_amdgcn_update_dpp(0, __builtin_bit_cast(int, x), 0x142, 0xa, 0xf, false));
    x += __builtin_bit_cast(float, __builtin_amdgcn_update_dpp(0, __builtin_bit_cast(int, x), 0x143, 0xc, 0xf, false));
    return __builtin_bit_cast(float, __builtin_amdgcn_readlane(__builtin_bit_cast(int, x), 63));
}
__device__ __forceinline__ float wave_max_fast(float x) {
    x = fmaxf(x, dpp_f<0xB1>(x)); x = fmaxf(x, dpp_f<0x4E>(x)); x = fmaxf(x, dpp_f<0x124>(x)); x = fmaxf(x, dpp_f<0x128>(x));
    return swap32_max(swap16_max(x));
}
__device__ __forceinline__ float xor32_max(float x) { return swap32_max(x); }
__device__ __forceinline__ float xor32_sum(float x) { return swap32_sum(x); }
__device__ __forceinline__ float gelu_as(float v) {
    const float av = fabsf(v), t = __builtin_amdgcn_rcpf(av * 0.2316418882f + 1.0f);
    float q = t * 0.5307027145f + (-0.7265760135f); q = q * t + 0.7107068705f; q = q * t + (-0.142248368f); q = q * t + 0.127414796f; q = q * t;
    const float e = __builtin_amdgcn_exp2f((v * v) * (-0.72134752044f));
    const float m = v * (q * e);
    return v < 0.f ? m : v - m;
}
#define XB_TMO      128
#define XB_XCNT(j)  (256  + 64 * (j))
#define XB_XSUB(j)  (1280 + 64 * (j))
#define XB_XGEN(j)  (2304 + 64 * (j))
#define XB_TOP      3328
#define XB_TOPGEN   3392
#define XCD_BAR_WORDS 3456
#define XB_SPIN_CAP (1u << 18)

__device__ __forceinline__ unsigned xb_ld(unsigned* p)              { return __hip_atomic_load(p, __ATOMIC_RELAXED, __HIP_MEMORY_SCOPE_AGENT); }
__device__ __forceinline__ unsigned xb_add(unsigned* p, unsigned v) { return __hip_atomic_fetch_add(p, v, __ATOMIC_RELAXED, __HIP_MEMORY_SCOPE_AGENT); }
__device__ __forceinline__ unsigned xb_xcc_id() { return (unsigned)__builtin_amdgcn_s_getreg((3 << 11) | 20) & 0xFu; }
#define XB_SPIN(cond, bar) do { unsigned _sp = 0; while (cond) { __builtin_amdgcn_s_sleep(1); \
    if ((++_sp & 255u) == 0u) { if (xb_ld(&(bar)[XB_TMO])) break; if (_sp > XB_SPIN_CAP) { atomicAdd(&(bar)[XB_TMO], 1u); break; } } } } while (0)

struct XcdBarrier {
    unsigned* bar; unsigned x;
    volatile LAS unsigned* st;
};

__device__ __forceinline__ XcdBarrier xcd_barrier_post(unsigned* bar, volatile LAS unsigned* st) {
    XcdBarrier b; b.bar = bar; b.x = xb_xcc_id(); b.st = st;
    if (threadIdx.x == 0) (void)xb_add(&bar[XB_XCNT(b.x)], 1u);
    return b;
}
__device__ __forceinline__ void xcd_barrier_complete(unsigned* bar, unsigned x, unsigned& nloc, unsigned& nx) {
    const unsigned G = gridDim.x * gridDim.y * gridDim.z;
    unsigned sum, cnt, mine, sp = 0u;
    for (;;) {
        sum = 0u; cnt = 0u; mine = 0u;
#pragma unroll
        for (unsigned j = 0; j < 16; ++j) { const unsigned c = xb_ld(&bar[XB_XCNT(j)]); sum += c; cnt += (c > 0u) ? 1u : 0u; mine = (j == x) ? c : mine; }
        if (sum == G) break;
        __builtin_amdgcn_s_sleep(1);
        if ((++sp & 255u) == 0u) { if (xb_ld(&bar[XB_TMO])) break; if (sp > XB_SPIN_CAP) { atomicAdd(&bar[XB_TMO], 1u); break; } }
    }
    nloc = mine > 0u ? mine : 1u; nx = cnt > 0u ? cnt : 1u;
}

__device__ __forceinline__ void xcd_barrier(const XcdBarrier& b, const bool leader  ) {
    asm volatile("s_waitcnt vmcnt(0)" ::: "memory");
    __syncthreads();
    if (leader) {
        unsigned* bar = b.bar;
        __builtin_amdgcn_s_waitcnt(0);
        unsigned nloc = b.st[0], nx = b.st[1];
        if (nloc == 0u) { xcd_barrier_complete(bar, b.x, nloc, nx); b.st[0] = nloc; b.st[1] = nx; }
        const unsigned old = xb_add(&bar[XB_XSUB(b.x)], 1u);
        const unsigned gen = old / nloc;
        if (old + 1u == (gen + 1u) * nloc) {
            __builtin_amdgcn_fence(__ATOMIC_RELEASE, "agent");
            asm volatile("s_waitcnt vmcnt(0)" ::: "memory");
            const unsigned og = xb_add(&bar[XB_TOP], 1u);
            const unsigned tg = og / nx;
            if (og + 1u == (tg + 1u) * nx) xb_add(&bar[XB_TOPGEN], 1u);
            else XB_SPIN(xb_ld(&bar[XB_TOPGEN]) == tg, bar);
            __builtin_amdgcn_fence(__ATOMIC_ACQUIRE, "agent");
            xb_add(&bar[XB_XGEN(b.x)], 1u);
            asm volatile("s_waitcnt vmcnt(0)" ::: "memory");
        } else {
            XB_SPIN(xb_ld(&bar[XB_XGEN(b.x)]) == gen, bar);
            __builtin_amdgcn_fence(__ATOMIC_ACQUIRE, "agent");
            asm volatile("s_waitcnt vmcnt(0)" ::: "memory");
        }
    }
    __syncthreads();
}

struct Args {
    const float* x; const int* pos; const float* g_mix; const float* w_in; const float* g_q; const float* g_kv;
    const float* w_uq; const float* w_uk; const float* w_uv; const float* w_a; const float* w_b; const float* w_o;
    const float* g_ffn; const float* w_pq; const float* subk; const float* pu; const float* pv; const float* g_fin;
    float* out; unsigned char* ws;
    double invf[56];
    int ph_lo, ph_hi;
};

__device__ __forceinline__ int src_win(int n) {
    if (n < 768) return n;
    if (n < 2048) { const int r = n - 768, head = r >> 7, j = r & 127; const int sj = j < 32 ? ((j & 1) * 16 + (j >> 1)) : j; return 832 + head * 128 + sj; }
    if (n < 2304) return 2112 + (n - 2048);
    if (n < 3328) { const int r = n - 2304, head = r >> 6, j = r & 63; const int sj = j < 16 ? ((j & 1) * 8 + (j >> 1)) : j; return 2368 + head * 64 + sj; }
    if (n < 3584) { const int r = n - 3328;
        if (r < 64) return 768 + (r & 1) * 32 + (r >> 1);
        if (r < 128) { const int j = r - 64; return 3392 + (j < 16 ? ((j & 1) * 8 + (j >> 1)) : j); }
        if (r < 144) return 3456 + (r - 128);
        return -1; }
    return 3472 + (n - 3584);
}
__device__ __forceinline__ int src_wuq(int n) {
    if (n < 1024) return (n >> 7) * 192 + (n & 127);
    const int r = n - 1024, head = r >> 6, j = r & 63; return head * 192 + 128 + (j & 1) * 32 + (j >> 1);
}
template <int MODE> __device__ __forceinline__ int src_map(int n) { if (MODE == 1) return src_win(n); if (MODE == 2) return src_wuq(n); if (MODE == 3) return 3472 + n; return n; }

template <int MODE, bool OUT8> __device__ __forceinline__ void p0_transpose_item(const float* W, int K, int N, int nblk, void* WTv, int row_off, LAS float* scr, int item, int lane, const float* kscale, float oscale) {
    const int kb = item / nblk, nb = item % nblk, k0 = 64 * kb, n0 = 32 * nb;
    const int sc = src_map<MODE>(n0 + (lane & 31));
    float tv[32];
#pragma unroll
    for (int i = 0; i < 32; ++i) { const int kk = 2 * i + (lane >> 5); tv[i] = sc >= 0 ? W[(size_t)(k0 + kk) * N + sc] : 0.f; }
#pragma unroll
    for (int i = 0; i < 32; ++i) { const int kk = 2 * i + (lane >> 5); float v = tv[i]; if (kscale) v *= kscale[k0 + kk]; scr[kk * 33 + (lane & 31)] = v; }
    LDS_WAIT(); asm volatile("" ::: "memory");
    const int c = lane & 7;
#pragma unroll
    for (int j = 0; j < 4; ++j) { const int n = (lane >> 3) + 8 * j; const LAS float* s = scr + (8 * c) * 33 + n;
        if (OUT8) { int p0 = __builtin_amdgcn_cvt_pk_fp8_f32(s[0 * 33] * oscale, s[1 * 33] * oscale, 0, false); p0 = __builtin_amdgcn_cvt_pk_fp8_f32(s[2 * 33] * oscale, s[3 * 33] * oscale, p0, true);
            int p1 = __builtin_amdgcn_cvt_pk_fp8_f32(s[4 * 33] * oscale, s[5 * 33] * oscale, 0, false); p1 = __builtin_amdgcn_cvt_pk_fp8_f32(s[6 * 33] * oscale, s[7 * 33] * oscale, p1, true);
            *(GAS v2u*)((unsigned char*)WTv + (size_t)(row_off + n0 + n) * K + k0 + 8 * c) = (v2u){(unsigned)p0, (unsigned)p1}; }
        else { v4u o; o.x = pk2(s[0 * 33], s[1 * 33]); o.y = pk2(s[2 * 33], s[3 * 33]); o.z = pk2(s[4 * 33], s[5 * 33]); o.w = pk2(s[6 * 33], s[7 * 33]);
            *(GAS v4u*)((bf16*)WTv + (size_t)(row_off + n0 + n) * K + k0 + 8 * c) = o; } }
    LDS_WAIT(); asm volatile("" ::: "memory");
}

__device__ __forceinline__ void p0_w2_item(const Args& a, bf16* W2, LAS float* scr, int item, int lane) {
    const int pass = item & 1, hp = item >> 7, d0 = ((item >> 1) & 63) * 32;
#pragma unroll 4
    for (int dd = 0; dd < 32; ++dd) scr[dd * 64 + lane] = a.w_pq[(size_t)(d0 + dd) * 1024 + hp * 64 + lane];
    LDS_WAIT(); asm volatile("" ::: "memory");
    {
        const int n = lane + 64 * pass;
        const f32x4* skp = (const f32x4*)(a.subk + ((size_t)hp * 128 + n) * 64);
        float acc[32];
#pragma unroll
        for (int i = 0; i < 32; ++i) acc[i] = 0.f;
#pragma unroll 2
        for (int c4 = 0; c4 < 16; ++c4) { const f32x4 sk = skp[c4];
#pragma unroll
            for (int dd = 0; dd < 32; ++dd) { const f32x4 w = *(const LAS f32x4*)(scr + dd * 64 + c4 * 4); acc[dd] += w.x * sk.x + w.y * sk.y + w.z * sk.z + w.w * sk.w; } }
        bf16* o = W2 + (size_t)(hp * 128 + n) * D + d0;
#pragma unroll
        for (int q = 0; q < 4; ++q) { v4u w; const float* g = a.g_ffn + d0 + 8 * q;
            w.x = pk2(acc[8 * q + 0] * g[0], acc[8 * q + 1] * g[1]); w.y = pk2(acc[8 * q + 2] * g[2], acc[8 * q + 3] * g[3]);
            w.z = pk2(acc[8 * q + 4] * g[4], acc[8 * q + 5] * g[5]); w.w = pk2(acc[8 * q + 6] * g[6], acc[8 * q + 7] * g[7]);
            *(GAS v4u*)(o + 8 * q) = w; }
    }
    LDS_WAIT(); asm volatile("" ::: "memory");
}

__device__ __forceinline__ void rms_row_load(const float* xrow, f32x4 (&v)[8], int lane) {
#pragma unroll
    for (int j = 0; j < 4; ++j) { const GAS f32x4* p = (const GAS f32x4*)(xrow + j * 512 + lane * 8); v[2 * j] = p[0]; v[2 * j + 1] = p[1]; }
}
__device__ __forceinline__ void rms_row_finish(const f32x4 (&v)[8], const float* g, bf16* orow, unsigned char* orow8, int lane) {
    float s = 0.f;
#pragma unroll
    for (int j = 0; j < 8; ++j) s += (v[j].x * v[j].x + v[j].y * v[j].y) + (v[j].z * v[j].z + v[j].w * v[j].w);
    const float rstd = 1.0f / sqrtf(wave_sum_fast(s) * (1.f / D) + EPS);
#pragma unroll
    for (int j = 0; j < 4; ++j) { const f32x4 g0 = *(const f32x4*)(g + j * 512 + lane * 8), g1 = *(const f32x4*)(g + j * 512 + lane * 8 + 4);
        const f32x4 a0 = v[2 * j] * rstd * g0, a1 = v[2 * j + 1] * rstd * g1;
        v4u w; w.x = pk2(a0.x, a0.y); w.y = pk2(a0.z, a0.w); w.z = pk2(a1.x, a1.y); w.w = pk2(a1.z, a1.w);
#ifdef P1_NEED_BF16
        *(GAS v4u*)(orow + j * 512 + lane * 8) = w;
#endif
        int p0 = __builtin_amdgcn_cvt_pk_fp8_f32(a0.x, a0.y, 0, false); p0 = __builtin_amdgcn_cvt_pk_fp8_f32(a0.z, a0.w, p0, true);
        int p1 = __builtin_amdgcn_cvt_pk_fp8_f32(a1.x, a1.y, 0, false); p1 = __builtin_amdgcn_cvt_pk_fp8_f32(a1.z, a1.w, p1, true);
        *(GAS v2u*)(orow8 + j * 512 + lane * 8) = (v2u){(unsigned)p0, (unsigned)p1}; }
}
typedef float v16f_p0 __attribute__((ext_vector_type(16)));
typedef unsigned v6u_p0 __attribute__((ext_vector_type(6)));
__device__ __forceinline__ void quant_row_load(const float* xrow, f32x4 (&v)[8], int lane) {
#pragma unroll
    for (int q = 0; q < 8; ++q) v[q] = __builtin_nontemporal_load((const GAS f32x4*)(xrow + q * 256 + lane * 4));
}
__device__ __forceinline__ void quant_row_finish(const f32x4 (&v)[8], unsigned char* orow, float* scale, int lane) {
    float mx = 0.f;
#pragma unroll
    for (int j = 0; j < 8; ++j) mx = fmaxf(fmaxf(mx, fmaxf(fabsf(v[j].x), fabsf(v[j].y))), fmaxf(fabsf(v[j].z), fabsf(v[j].w)));
    mx = wave_max_fast(mx);
    const float sc = mx > 0.f ? mx * (1.0f / 7.5f) : 1.0f, inv = 1.0f / sc;
    v16f_p0 pa, pb;
#pragma unroll
    for (int q = 0; q < 4; ++q)
#pragma unroll
        for (int e = 0; e < 4; ++e) { pa[4 * q + e] = v[q][e] * inv; pb[4 * q + e] = v[4 + q][e] * inv; }
    const v6u_p0 p = __builtin_amdgcn_cvt_scalef32_2xpk16_fp6_f32(pa, pb, 1.0f);
    *(GAS v4u*)(orow + lane * 16) = (v4u){p[0], p[1], p[2], p[3]};
    *(GAS v2u*)(orow + 1024 + lane * 8) = (v2u){p[4], p[5]};
    if (lane == 0) *scale = sc;
}
__device__ __forceinline__ void quant_row_finish_fp4(const f32x4 (&v)[8], unsigned char* orow, int lane) {
    float bm = 0.f;
#pragma unroll
    for (int j = 0; j < 8; ++j) bm = fmaxf(fmaxf(bm, fmaxf(fabsf(v[j].x), fabsf(v[j].y))), fmaxf(fabsf(v[j].z), fabsf(v[j].w)));
    const unsigned sbits = bm > 0.f ? f2bf(bm * (1.0f / 6.0f)) : 0x3f80u;
    const float sb = __builtin_bit_cast(float, sbits << 16), inv = 1.0f / sb;
    v4u w;
#pragma unroll
    for (int d = 0; d < 4; ++d) { unsigned p = 0u; const f32x4 a = v[2 * d] * inv, b = v[2 * d + 1] * inv;
        p = __builtin_amdgcn_cvt_scalef32_pk_fp4_f32(p, a.x, a.y, 1.0f, 0); p = __builtin_amdgcn_cvt_scalef32_pk_fp4_f32(p, a.z, a.w, 1.0f, 1);
        p = __builtin_amdgcn_cvt_scalef32_pk_fp4_f32(p, b.x, b.y, 1.0f, 2); p = __builtin_amdgcn_cvt_scalef32_pk_fp4_f32(p, b.z, b.w, 1.0f, 3); w[d] = p; }
    *(GAS v4u*)(orow + lane * 16) = w;
    *(GAS unsigned short*)(orow + 1024 + lane * 2) = (unsigned short)sbits;
}
__device__ __forceinline__ void p0_prologue(const Args& a, LAS unsigned char* lds, int vcu, int G, int wave, int lane) {
    unsigned char* ws = a.ws;
    LAS float* scr = (LAS float*)(lds + RING_OFF + wave * 16384);
    const int gw = vcu * NWAVES + wave, NGW = G * NWAVES;
    constexpr int I_WIN = 32 * 112, I_WG = 32 * 128, I_WUQ = 8 * 48, I_WUK = 4 * 32, I_WUV = 4 * 32, I_WA = 16 * 64, I_WB = 16 * 64, I_WO = 32 * 64, I_W2 = 2048;
#if defined(P1_FP8) && defined(P1_MASK)
    constexpr int I_WINX = I_WIN;
#else
    constexpr int I_WINX = 0;
#endif
    constexpr int NITEMS = I_WINX + I_WIN + I_WG + I_WUQ + I_WUK + I_WUV + I_WA + I_WB + I_WO + I_W2;
    for (int it = gw; it < NITEMS; it += NGW) {
        int r = it;
#ifdef P1_FP8
        if (r < I_WIN) { p0_transpose_item<1, true>(a.w_in, D, IN_WIDTH, 112, ws + WS_WIN8, 0, scr, r, lane, nullptr, 64.f); continue; } r -= I_WIN;
#endif
#ifdef P1_NEED_BF16
        if (r < I_WIN) { p0_transpose_item<1, false>(a.w_in, D, IN_WIDTH, 112, ws + WS_WIN, 0, scr, r, lane, nullptr, 1.f); continue; } r -= I_WIN;
#endif
        if (r < I_WG) { p0_transpose_item<3, true>(a.w_in, D, IN_WIDTH, 128, ws + WS_WG8, 0, scr, r, lane, nullptr, 64.f); continue; } r -= I_WG;
        if (r < I_WUQ) { p0_transpose_item<2, false>(a.w_uq, 512, 1536, 48, ws + WS_WUQ, 0, scr, r, lane, a.g_q, 1.f); continue; } r -= I_WUQ;
        if (r < I_WUK) { p0_transpose_item<0, false>(a.w_uk, 256, 1024, 32, ws + WS_WUK, 0, scr, r, lane, a.g_kv, 1.f); continue; } r -= I_WUK;
        if (r < I_WUV) { p0_transpose_item<0, false>(a.w_uv, 256, 1024, 32, ws + WS_WUV, 0, scr, r, lane, a.g_kv, 1.f); continue; } r -= I_WUV;
        if (r < I_WA) { p0_transpose_item<0, true>(a.w_a, 1024, 2048, 64, ws + WS_WAB, 0, scr, r, lane, nullptr, 32.f); continue; } r -= I_WA;
        if (r < I_WB) { p0_transpose_item<0, true>(a.w_b, 1024, 2048, 64, ws + WS_WAB, 2048, scr, r, lane, nullptr, 32.f); continue; } r -= I_WB;
        if (r < I_WO) { p0_transpose_item<0, true>(a.w_o, 2048, 2048, 64, ws + WS_WO, 0, scr, r, lane, nullptr, 64.f); continue; } r -= I_WO;
        p0_w2_item(a, (bf16*)(ws + WS_W2), scr, r, lane);
    }
#ifdef TS_A
#define P0STAMP(k) do { if (blockIdx.x == 0 && wave == 0) { const unsigned t_ = (unsigned)__builtin_amdgcn_s_memrealtime(); if (lane == 0) ((volatile LAS unsigned*)(lds + MISC_OFF))[16 + (k)] = t_; } } while (0)
#else
#define P0STAMP(k) do {} while (0)
#endif
    P0STAMP(20);
    for (int m = gw; m < M; m += 2 * NGW) {
        f32x4 va[8], vb[8]; const int m2 = m + NGW;
        rms_row_load(a.x + (size_t)m * D, va, lane); rms_row_load(a.x + (size_t)m2 * D, vb, lane);
        rms_row_finish(va, a.g_mix, (bf16*)(ws + WS_XN) + (size_t)m * D, ws + WS_XN8 + (size_t)m * D, lane); rms_row_finish(vb, a.g_mix, (bf16*)(ws + WS_XN) + (size_t)m2 * D, ws + WS_XN8 + (size_t)m2 * D, lane);
    }
    P0STAMP(21);
    for (int m = gw; m < 2 * NEXP; m += 2 * NGW) {
        f32x4 va[8], vb[8]; const int e = m & (NEXP - 1), e2 = e + NGW; const bool isu = m < NEXP;
        const float* src = isu ? a.pu : a.pv; unsigned char* dst = ws + (isu ? WS_U : WS_V); float* scl = (float*)(ws + (isu ? WS_USC : WS_VSC));
        quant_row_load(src + (size_t)e * D, va, lane); quant_row_load(src + (size_t)e2 * D, vb, lane);
#ifdef V_FP4
        if (!isu) { quant_row_finish_fp4(va, dst + (size_t)e * EROW, lane); quant_row_finish_fp4(vb, dst + (size_t)e2 * EROW, lane); } else
#endif
        { quant_row_finish(va, dst + (size_t)e * EROW, scl + e, lane); quant_row_finish(vb, dst + (size_t)e2 * EROW, scl + e2, lane); }
    }
    P0STAMP(22);
    const int gt = gw * 64 + lane, NGT = NGW * 64;
    for (int idx = gt; idx < M * 56; idx += NGT) {
        const int t = idx / 56, i = idx - t * 56;
        const double ang = (double)a.pos[t] * a.invf[i];
        double rev = ang * 0.15915494309189535; rev -= __builtin_rint(rev);
        const float r = (float)(rev * 6.283185307179586);
        const float c = cosf(r), s = sinf(r);
        f32x2* dst = i < 32 ? (f32x2*)(ws + WS_T64) + (size_t)t * 32 + i : i < 48 ? (f32x2*)(ws + WS_T32) + (size_t)t * 16 + (i - 32) : (f32x2*)(ws + WS_T16) + (size_t)t * 8 + (i - 48);
        *dst = (f32x2){c, s};
    }
}

template <int KIND> struct Order {
    int nM, nN, nwg, G, c;
    __device__ void init(int nM_, int nN_, int G_, int c_) { nM = nM_; nN = nN_; nwg = nM * nN; G = G_; c = c_; }
    __device__ bool next(int i, pg8::Unit& u) const {
        const int ii = (KIND == 3) ? (i >> 1) : i;
        const long L = (long)ii * G + c; if (L >= nwg) return false;
        int wgid = (int)L; { const int q = nwg / 8, r = nwg % 8, xcd = wgid % 8, off = wgid / 8; wgid = (xcd < r ? xcd * (q + 1) : r * (q + 1) + (xcd - r) * q) + off; }
        const int nig = 8 * nN, gid = wgid / nig, fm = gid * 8, gsz = (nM - fm) < 8 ? (nM - fm) : 8;
        const int pm = fm + ((wgid % nig) % gsz), vn = (wgid % nig) / gsz;
        if (KIND == 0) { u.pm = pm; u.pn = vn; }
        if (KIND == 1) { if (vn == 8) { u.pm = 72; u.pn = pm; } else { u.pm = pm; u.pn = 64 + vn; } }
        if (KIND == 4) { if (vn == 8) { u.pm = 88; u.pn = pm; } else { u.pm = pm; u.pn = 80 + vn; } }
        if (KIND == 2) { if (vn >= 4) { u.pm = 64 + vn; u.pn = pm; } else { u.pm = pm; u.pn = 64 + vn; } }
        if (KIND == 3) { const int br = i & 1; u.pm = pm + 64 * br; u.pn = vn + 8 * br; }
        return true;
    }
    __device__ __forceinline__ void a_ready(const pg8::Unit&) const {}
    __device__ __forceinline__ void done(const pg8::Unit&) const {}
};

__device__ __forceinline__ void st8bf(bf16* p, f32x4 a, f32x4 b) { v4u w; w.x = pk2(a.x, a.y); w.y = pk2(a.z, a.w); w.z = pk2(b.x, b.y); w.w = pk2(b.z, b.w); *(GAS v4u*)p = w; }
__device__ __forceinline__ void rope8(f32x4& a, f32x4& b, const float* tab) {
    const f32x4 t0 = *(const f32x4*)tab, t1 = *(const f32x4*)(tab + 4);
    const f32x4 ra = {a.x * t0.x - a.y * t0.y, a.y * t0.x + a.x * t0.y, a.z * t0.z - a.w * t0.w, a.w * t0.z + a.z * t0.w};
    const f32x4 rb = {b.x * t1.x - b.y * t1.y, b.y * t1.x + b.x * t1.y, b.z * t1.z - b.w * t1.w, b.w * t1.z + b.z * t1.w};
    a = ra; b = rb;
}
__device__ __forceinline__ void st8_vt(bf16* rowp, int tk0, f32x4 a, f32x4 b) {
    bf16* p = rowp + (tk0 & ~15) + 4 * ((tk0 >> 3) & 1);
    v2u w0, w1; w0.x = pk2(a.x, a.y); w0.y = pk2(a.z, a.w); w1.x = pk2(b.x, b.y); w1.y = pk2(b.z, b.w);
    *(GAS v2u*)p = w0; *(GAS v2u*)(p + 8) = w1;
}
__device__ __forceinline__ void st8f8(unsigned char* p, f32x4 a, f32x4 b) { int p0 = __builtin_amdgcn_cvt_pk_fp8_f32(a.x, a.y, 0, false); p0 = __builtin_amdgcn_cvt_pk_fp8_f32(a.z, a.w, p0, true);
    int p1 = __builtin_amdgcn_cvt_pk_fp8_f32(b.x, b.y, 0, false); p1 = __builtin_amdgcn_cvt_pk_fp8_f32(b.z, b.w, p1, true); *(GAS v2u*)p = (v2u){(unsigned)p0, (unsigned)p1}; }
__device__ __forceinline__ void st8_vt8(unsigned char* rowp, int tk0, f32x4 a, f32x4 b) {
    const int k0 = tk0 & 63, kh = k0 >> 5, kk0 = k0 & 31;
    unsigned char* p = rowp + (tk0 & ~63) + 16 * kh + 4 * (kk0 >> 3);
    int w0 = __builtin_amdgcn_cvt_pk_fp8_f32(a.x, a.y, 0, false); w0 = __builtin_amdgcn_cvt_pk_fp8_f32(a.z, a.w, w0, true);
    int w1 = __builtin_amdgcn_cvt_pk_fp8_f32(b.x, b.y, 0, false); w1 = __builtin_amdgcn_cvt_pk_fp8_f32(b.z, b.w, w1, true);
    *(GAS unsigned*)p = (unsigned)w0; *(GAS unsigned*)(p + 32) = (unsigned)w1;
}
#define EPI_FOR _Pragma("unroll") for (int ai = 0; ai < 2; ++ai) _Pragma("unroll") for (int m = 0; m < 4; ++m) _Pragma("unroll") for (int bj = 0; bj < 2; ++bj)
#ifndef EPI_BAR
#define EPI_BAR (bj == 0 && (m & 1) == 0)
#endif
#define EPI_VARS if (EPI_BAR) asm volatile("" ::: "memory"); const int rl = 128 * ai + 64 * wr + 16 * m + fr, lc = 128 * bj + 32 * wc + 8 * fq; f32x4 v0 = acc[ai][bj][m][0], v1 = acc[ai][bj][m][1]; (void)rl; (void)lc;

template <int WOFF> struct Epi1T {
    static constexpr bool PERM = true, AFTER_DRAIN = false;
    unsigned char* ws; bf16* G;
    __device__ __forceinline__ void operator()(const f32x4 (&acc)[2][2][4][2], const pg8::Unit& u, int wr, int wc, int fr_, int fq_) const {
        int fr = fr_, fq = fq_; asm volatile("" : "+v"(fr), "+v"(fq));
#ifdef P1_MASK
        { const int ctm = (u.pm >= 64) ? 8 : u.pn - WOFF; if (!(((WOFF == 80 ? P1_MASK : ~P1_MASK) >> ctm) & 1)) return; }
#endif
        if (u.pm >= 64) {
            unsigned char* DVT = ws + WS_DVT;
            EPI_FOR { EPI_VARS st8_vt8(DVT + (size_t)rl * M, u.pn * 256 + lc, v0, v1); }
            return;
        }
        const int ct = u.pn - WOFF; const size_t row0 = (size_t)u.pm * 256;
        if (ct < 2) { bf16* O = (bf16*)(ws + WS_CQ); EPI_FOR { EPI_VARS st8bf(O + (row0 + rl) * 512 + ct * 256 + lc, v0, v1); } }
        else if (ct == 2) { bf16* O = (bf16*)(ws + WS_CKV); EPI_FOR { EPI_VARS st8bf(O + (row0 + rl) * 256 + lc, v0, v1); } }
        else if (ct < 7) { unsigned char* O = ws + WS_DQ; const float* T = (const float*)(ws + WS_T32);
            EPI_FOR { EPI_VARS const int gc = (ct - 3) * 256 + lc, j = gc & 127; const size_t row = row0 + rl;
                if (j < 32) rope8(v0, v1, T + row * 32 + j);
                st8f8(O + row * 1024 + gc, v0 * (DSA_QSCALE * 16.f), v1 * (DSA_QSCALE * 16.f)); } }
        else if (ct == 7) { unsigned char* O = ws + WS_DK; const float* T = (const float*)(ws + WS_T32);
            EPI_FOR { EPI_VARS const int j = lc & 127; const size_t row = row0 + rl;
                if (j < 32) rope8(v0, v1, T + row * 32 + j);
                st8f8(O + row * 256 + lc, v0, v1); } }
        else if (ct < 13) { bf16* O = (bf16*)(ws + WS_IQ); const float* T = (const float*)(ws + WS_T16);
            EPI_FOR { EPI_VARS const int gc = (ct - 9) * 256 + lc, j = gc & 63; const size_t row = row0 + rl;
                if (j < 16) rope8(v0, v1, T + row * 16 + j);
                st8bf(O + row * 1024 + gc, v0, v1); } }
        else if (ct == 13) {
            EPI_FOR { EPI_VARS const size_t row = row0 + rl;
                if (lc < 64) { rope8(v0, v1, (const float*)(ws + WS_T64) + row * 64 + lc); st8f8(ws + WS_KR + row * 64 + lc, v0, v1); }
                else if (lc < 128) { const int j = lc - 64; if (j < 16) rope8(v0, v1, (const float*)(ws + WS_T16) + row * 16 + j); st8bf((bf16*)(ws + WS_IK) + row * 64 + j, v0, v1); }
                else if (lc < 144) { float* o = (float*)(ws + WS_IW) + row * 16 + (lc - 128); *(GAS f32x4*)o = v0 * 0.03125f; *(GAS f32x4*)(o + 4) = v1 * 0.03125f; } } }
    }
};
typedef Epi1T<64> Epi1;
template <int TOFF> struct Epi1gT {
    static constexpr bool PERM = true, AFTER_DRAIN = false;
    bf16* G;
    __device__ __forceinline__ void operator()(const f32x4 (&acc)[2][2][4][2], const pg8::Unit& u, int wr, int wc, int fr_, int fq_) const {
        int fr = fr_, fq = fq_; asm volatile("" : "+v"(fr), "+v"(fq));
        EPI_FOR { EPI_VARS const int gc = (u.pn + TOFF) * 256 + lc; const size_t row = (size_t)u.pm * 256 + rl;
            f32x4 s0, s1;
#pragma unroll
            for (int e = 0; e < 4; ++e) { s0[e] = __builtin_amdgcn_rcpf(1.f + __expf(-v0[e])); s1[e] = __builtin_amdgcn_rcpf(1.f + __expf(-v1[e])); }
            st8bf(G + row * 4096 + gc, s0, s1); }
    }
};
typedef Epi1gT<0> Epi1g;

struct Epi3q {
    static constexpr bool PERM = true, AFTER_DRAIN = false;
    unsigned char* ws;
    __device__ __forceinline__ void operator()(const f32x4 (&acc)[2][2][4][2], const pg8::Unit& u, int wr, int wc, int fr_, int fq_) const {
        int fr = fr_, fq = fq_; asm volatile("" : "+v"(fr), "+v"(fq));
        unsigned char* Q = ws + WS_Q; const float* RSQ = (const float*)(ws + WS_RS); const float* T = (const float*)(ws + WS_T64);
        const size_t row0 = (size_t)u.pm * 256;
        EPI_FOR { EPI_VARS const size_t row = row0 + rl; const float sc = RSQ[row] * (MLA_QSCALE * 16.f); v0 = v0 * sc; v1 = v1 * sc;
            if (u.pn < 4) { const int gc = u.pn * 256 + lc; st8f8(Q + row * 1536 + (gc >> 7) * 192 + (gc & 127), v0, v1); }
            else { const int r = (u.pn - 4) * 256 + lc, j = r & 63; rope8(v0, v1, T + row * 64 + j); st8f8(Q + row * 1536 + (r >> 6) * 192 + 128 + j, v0, v1); } }
    }
};
struct Epi3k {
    static constexpr bool PERM = true, AFTER_DRAIN = false;
    unsigned char* ws;
    __device__ __forceinline__ void operator()(const f32x4 (&acc)[2][2][4][2], const pg8::Unit& u, int wr, int wc, int fr_, int fq_) const {
        int fr = fr_, fq = fq_; asm volatile("" : "+v"(fr), "+v"(fq));
        const float* RSK = (const float*)(ws + WS_RS) + M;
        if (u.pm >= 64) { unsigned char* VT = ws + WS_VT; const int vt = u.pm - 68;
            EPI_FOR { EPI_VARS const int tk0 = u.pn * 256 + lc; const f32x4 r0 = *(const f32x4*)(RSK + tk0), r1 = *(const f32x4*)(RSK + tk0 + 4);
                st8_vt8(VT + (size_t)(vt * 256 + rl) * M, tk0, v0 * r0, v1 * r1); }
            return; }
        unsigned char* KN = ws + WS_KN; const int ct = u.pn - 64; const size_t row0 = (size_t)u.pm * 256;
        EPI_FOR { EPI_VARS const size_t row = row0 + rl; const float sc = RSK[row]; st8f8(KN + row * 1024 + ct * 256 + lc, v0 * sc, v1 * sc); }
    }
};
struct Epi5 {
    static constexpr bool PERM = true, AFTER_DRAIN = false;
    unsigned char* ws; const bf16* G;
    __device__ __forceinline__ void operator()(const f32x4 (&acc)[2][2][4][2], const pg8::Unit& u, int wr, int wc, int fr_, int fq_) const {
        int fr = fr_, fq = fq_; asm volatile("" : "+v"(fr), "+v"(fq));
        bf16* PA = (bf16*)(ws + WS_PA); unsigned char* MRG = ws + WS_MRG;
        const size_t row0 = (size_t)(u.pm & 63) * 256; const int col0 = (u.pn & 7) * 256;
#ifdef DBG_ZERO_MLA
        if (u.pm < 64) { EPI_FOR { EPI_VARS st8bf(PA + (row0 + rl) * 2048 + col0 + lc, v0 * 0.f, v1 * 0.f); } return; }
#else
        if (u.pm < 64) { EPI_FOR { EPI_VARS st8bf(PA + (row0 + rl) * 2048 + col0 + lc, v0, v1); } return; }
#endif
        EPI_FOR { EPI_VARS const size_t row = row0 + rl; const int col = col0 + lc;
            const v4u ga = *(const GAS v4u*)(G + row * 4096 + col), gb = *(const GAS v4u*)(G + row * 4096 + 2048 + col), pa = *(const GAS v4u*)(PA + row * 2048 + col);
            f32x4 o0, o1;
#ifdef DBG_ZERO_DSA
            v0 = v0 * 0.f; v1 = v1 * 0.f;
#endif
            o0.x = bflo(ga.x) * bflo(pa.x) + bflo(gb.x) * v0.x; o0.y = bfhi(ga.x) * bfhi(pa.x) + bfhi(gb.x) * v0.y;
            o0.z = bflo(ga.y) * bflo(pa.y) + bflo(gb.y) * v0.z; o0.w = bfhi(ga.y) * bfhi(pa.y) + bfhi(gb.y) * v0.w;
            o1.x = bflo(ga.z) * bflo(pa.z) + bflo(gb.z) * v1.x; o1.y = bfhi(ga.z) * bfhi(pa.z) + bfhi(gb.z) * v1.y;
            o1.z = bflo(ga.w) * bflo(pa.w) + bflo(gb.w) * v1.z; o1.w = bfhi(ga.w) * bfhi(pa.w) + bfhi(gb.w) * v1.w;
            st8f8(MRG + row * 2048 + col, o0 * 16.f, o1 * 16.f); }
    }
};
struct Epi6 {
    static constexpr bool PERM = true, AFTER_DRAIN = false;
    unsigned char* ws; const float* x; float* out;
    __device__ __forceinline__ void operator()(const f32x4 (&acc)[2][2][4][2], const pg8::Unit& u, int wr, int wc, int fr_, int fq_) const {
        int fr = fr_, fq = fq_; asm volatile("" : "+v"(fr), "+v"(fq));
        bf16* X1B = (bf16*)(ws + WS_X1B);
        EPI_FOR { EPI_VARS const size_t off = ((size_t)u.pm * 256 + rl) * 2048 + u.pn * 256 + lc;
            const f32x4 a = *(const GAS f32x4*)(x + off) + v0, b = *(const GAS f32x4*)(x + off + 4) + v1;
            st8bf(X1B + off, a, b); }
    }
};
struct Epi7 {
    static constexpr bool PERM = true, AFTER_DRAIN = false;
    unsigned char* ws;
    __device__ __forceinline__ void operator()(const f32x4 (&acc)[2][2][4][2], const pg8::Unit& u, int wr, int wc, int fr_, int fq_) const {
        int fr = fr_, fq = fq_; asm volatile("" : "+v"(fr), "+v"(fq));
        float* S = (float*)(ws + WS_S);
        EPI_FOR { EPI_VARS const size_t off = ((size_t)u.pm * 256 + rl) * 2048 + u.pn * 256 + lc;
            *(GAS f32x4*)(S + off) = v0; *(GAS f32x4*)(S + off + 4) = v1; }
    }
};

__device__ __forceinline__ void p2_rowstats(unsigned char* ws, int vcu, int G, int wave, int lane) {
    const bf16* CQ = (const bf16*)(ws + WS_CQ); const bf16* CKV = (const bf16*)(ws + WS_CKV); float* RS = (float*)(ws + WS_RS);
    const int gw = vcu * NWAVES + wave, NGW = G * NWAVES;
    for (int m = gw; m < M; m += NGW) {
        const v4u q = *(const GAS v4u*)(CQ + (size_t)m * 512 + lane * 8); const v2u k = *(const GAS v2u*)(CKV + (size_t)m * 256 + lane * 4);
        float sq = 0.f, sk = 0.f;
#pragma unroll
        for (int e = 0; e < 4; ++e) { const float a = bflo(q[e]), b = bfhi(q[e]); sq += a * a + b * b; }
#pragma unroll
        for (int e = 0; e < 2; ++e) { const float a = bflo(k[e]), b = bfhi(k[e]); sk += a * a + b * b; }
        sq = wave_sum_fast(sq); sk = wave_sum_fast(sk);
        if (lane == 0) { RS[m] = 1.0f / sqrtf(sq * (1.f / 512.f) + EPS); RS[M + m] = 1.0f / sqrtf(sk * (1.f / 256.f) + EPS); }
    }
}
__device__ __forceinline__ size_t sc_base(int b, int c) { return (size_t)b * 2162688u + (size_t)2048 * c * (c + 1); }
__device__ __forceinline__ void idx_segment(unsigned char* ws, LAS unsigned char* lds, int b, int c, int k0, int k1, int wave, int lane, int tid) {
    const bf16* IQ = (const bf16*)(ws + WS_IQ); const bf16* IK = (const bf16*)(ws + WS_IK); const float* IW = (const float*)(ws + WS_IW); float* SC = (float*)(ws + WS_SC);
    const int t0 = b * SEQ + 64 * c, r = lane & 31, hk = lane >> 5;
    bf16x8 af[4][4]; f32x4 wv[4][4];
#pragma unroll
    for (int rt = 0; rt < 4; ++rt) {
        const int tq = t0 + 8 * wave + 2 * rt + ((r >> 2) & 1), hh = (r & 3) + 4 * (r >> 3);
#pragma unroll
        for (int ks = 0; ks < 4; ++ks) af[rt][ks] = *(const GAS bf16x8*)(IQ + (size_t)tq * 1024 + hh * 64 + 16 * ks + 8 * hk);
        const int tw = t0 + 8 * wave + 2 * rt + hk;
#pragma unroll
        for (int q4 = 0; q4 < 4; ++q4) wv[rt][q4] = *(const GAS f32x4*)(IW + (size_t)tw * 16 + 4 * q4);
    }
#pragma unroll
    for (int rt = 0; rt < 4; ++rt)
#pragma unroll
        for (int ks = 0; ks < 4; ++ks) { asm volatile("" :: "v"(af[rt][ks])); asm volatile("" :: "v"(wv[rt][ks])); }
#ifdef TS_A
    if (blockIdx.x == 0 && wave == 0 && c == 31) { const unsigned t_ = (unsigned)__builtin_amdgcn_s_memrealtime(); if (lane == 0) ((volatile LAS unsigned*)(lds + MISC_OFF))[16 + 13] = t_; }
#endif
    const int skey = tid >> 3, sch = tid & 7;
    const bf16* src = IK + ((size_t)b * SEQ + skey) * 64 + sch * 8;
    const int sdst = skey * 144 + sch * 16;
    const int nrow = 64 * (c + 1);
    float* scrow = SC + sc_base(b, c);
    { const v4u t = *(const GAS v4u*)(src + (size_t)k0 * 64 * 64); *(LAS v4u*)(lds + sdst) = t; }
    __syncthreads();
    for (int kt = k0; kt < k1; ++kt) {
        const int cur = (kt - k0) & 1; v4u nx = {0u, 0u, 0u, 0u};
        if (kt + 1 < k1) nx = *(const GAS v4u*)(src + (size_t)(kt + 1) * 64 * 64);
        const LAS unsigned char* kb = lds + cur * 9216;
#pragma unroll
        for (int kh = 0; kh < 2; ++kh) {
            bf16x8 bfr[4];
#pragma unroll
            for (int ks = 0; ks < 4; ++ks) bfr[ks] = *(const LAS bf16x8*)(kb + (32 * kh + r) * 144 + (16 * ks + 8 * hk) * 2);
#pragma unroll
            for (int rt = 0; rt < 4; ++rt) {
                f32x16 cc;
#pragma unroll
                for (int e = 0; e < 16; ++e) cc[e] = 0.f;
#pragma unroll
                for (int ks = 0; ks < 4; ++ks) cc = __builtin_amdgcn_mfma_f32_32x32x16_bf16(af[rt][ks], bfr[ks], cc, 0, 0, 0);
                float s = 0.f;
#pragma unroll
                for (int e = 0; e < 16; ++e) s += wv[rt][e >> 2][e & 3] * fmaxf(cc[e], 0.f);
                scrow[(size_t)(8 * wave + 2 * rt + hk) * nrow + 64 * kt + 32 * kh + r] = s;
            }
        }
        if (kt + 1 < k1) *(LAS v4u*)(lds + (cur ^ 1) * 9216 + sdst) = nx;
        __syncthreads();
#ifdef TS_A
        if (blockIdx.x == 0 && wave == 0 && c == 31 && kt == k0 + 7) { const unsigned t_ = (unsigned)__builtin_amdgcn_s_memrealtime(); if (lane == 0) ((volatile LAS unsigned*)(lds + MISC_OFF))[16 + 14] = t_; }
#endif
    }
#ifdef TS_A
    if (blockIdx.x == 0 && wave == 0 && c == 31) { const unsigned t_ = (unsigned)__builtin_amdgcn_s_memrealtime(); if (lane == 0) ((volatile LAS unsigned*)(lds + MISC_OFF))[16 + 15] = t_; }
#endif
}
__device__ __forceinline__ void p2_indexer(unsigned char* ws, LAS unsigned char* lds, int bx, int G, int wave, int lane) {
    const int tid = wave * 64 + lane;
    for (int i = bx; i < 256; i += G) {
        const int p = i >> 1, b = p >> 4, c = p & 15;
        if ((i & 1) == 0) { idx_segment(ws, lds, b, c, 0, c + 1, wave, lane, tid); idx_segment(ws, lds, b, 31 - c, 0, 16 - c, wave, lane, tid); }
        else idx_segment(ws, lds, b, 31 - c, 16 - c, 32 - c, wave, lane, tid);
    }
}

__device__ __forceinline__ unsigned or16(unsigned x) { unsigned a = x, b = x; asm volatile("s_nop 1\n\tv_permlane16_swap_b32 %0, %1\n\ts_nop 1" : "+v"(a), "+v"(b)); return a | b; }
__device__ __forceinline__ unsigned or32(unsigned x) { unsigned a = x, b = x; asm volatile("s_nop 1\n\tv_permlane32_swap_b32 %0, %1\n\ts_nop 1" : "+v"(a), "+v"(b)); return a | b; }
__device__ __forceinline__ void p3_select(unsigned char* ws, LAS unsigned char* lds, int vcu, int G, int wave, int lane_in) {
    const float* SC = (const float*)(ws + WS_SC); unsigned* MB = (unsigned*)(ws + WS_MB);
    LAS unsigned* hist = (LAS unsigned*)(lds + wave * 16384);
    const int gw = vcu * NWAVES + wave, NGW = G * NWAVES;
    for (int mi = gw; mi < M; mi += NGW) {
        int lane = lane_in; asm volatile("" : "+v"(lane));
        const int m = (mi & ~2047) | ((mi + 331 * (mi >> 11)) & 2047);
        const int b = m >> 11, c = (m & 2047) >> 6, qi = m & 63, n = 64 * (c + 1), nw = n >> 5;
        if (n <= 256) { MB[(size_t)m * 64 + lane] = lane < nw ? 0xffffffffu : 0u; continue; }
        unsigned key[32];
        const float* row = SC + sc_base(b, c) + (size_t)qi * n + lane * 32;
        const bool act = lane < nw;
#pragma unroll
        for (int q = 0; q < 8; ++q) { f32x4 t = {0.f, 0.f, 0.f, 0.f}; if (act) t = *(const GAS f32x4*)(row + 4 * q);
#pragma unroll
            for (int e = 0; e < 4; ++e) { const unsigned u = __builtin_bit_cast(unsigned, t[e] + 0.0f); key[4 * q + e] = u ^ ((u >> 31) ? 0xffffffffu : 0x80000000u); } }
        const int hbase = (lane & 3) * 256, hdummy = 1024 + lane;
        unsigned prefix = 0u; int k = 256, eqtot = 0, shift = 24;
#pragma unroll 1
        for (int pass = 0; pass < 4; ++pass) {
            shift = 24 - 8 * pass;
#pragma unroll
            for (int cp = 0; cp < 4; ++cp) *(LAS v4u*)(hist + cp * 256 + 4 * lane) = (v4u){0u, 0u, 0u, 0u};
            LDS_WAIT(); asm volatile("" ::: "memory");
            const unsigned hmask = pass == 0 ? 0u : (0xffffffffu << (shift + 8));
#pragma unroll
            for (int i = 0; i < 32; ++i) { const bool mt = act && (((key[i] ^ prefix) & hmask) == 0u); const int ad = mt ? hbase + (int)((key[i] >> shift) & 255u) : hdummy;
                __hip_atomic_fetch_add(hist + ad, 1u, __ATOMIC_RELAXED, __HIP_MEMORY_SCOPE_WORKGROUP); }
            LDS_WAIT(); asm volatile("" ::: "memory");
            v4u h = *(const LAS v4u*)(hist + 4 * lane);
#pragma unroll
            for (int cp = 1; cp < 4; ++cp) h += *(const LAS v4u*)(hist + cp * 256 + 4 * lane);
            const int t = (int)(h.x + h.y + h.z + h.w);
            int x = t;
            x += __builtin_amdgcn_update_dpp(0, x, 0x111, 0xf, 0xf, true); x += __builtin_amdgcn_update_dpp(0, x, 0x112, 0xf, 0xf, true);
            x += __builtin_amdgcn_update_dpp(0, x, 0x114, 0xf, 0xf, true); x += __builtin_amdgcn_update_dpp(0, x, 0x118, 0xf, 0xf, true);
            const int r0 = __builtin_amdgcn_readlane(x, 15), r1 = __builtin_amdgcn_readlane(x, 31), r2 = __builtin_amdgcn_readlane(x, 47), r3 = __builtin_amdgcn_readlane(x, 63);
            const int rw = lane >> 4, rbase = rw == 0 ? 0 : rw == 1 ? r0 : rw == 2 ? r0 + r1 : r0 + r1 + r2, total = r0 + r1 + r2 + r3;
            const int incl = total - (x + rbase - t);
            const int above = incl - t;
            const bool mine = (above < k) && (k <= incl);
            const int c3 = above + (int)h.w, c2 = c3 + (int)h.z, c1 = c2 + (int)h.y;
            int digit, knew, eqc;
            if (k <= c3) { digit = 4 * lane + 3; knew = k - above; eqc = (int)h.w; }
            else if (k <= c2) { digit = 4 * lane + 2; knew = k - c3; eqc = (int)h.z; }
            else if (k <= c1) { digit = 4 * lane + 1; knew = k - c2; eqc = (int)h.y; }
            else { digit = 4 * lane; knew = k - c1; eqc = (int)h.x; }
            const unsigned long long bm = __ballot(mine);
            const int src = __builtin_ctzll(bm);
            digit = __builtin_amdgcn_readlane(digit, src); k = __builtin_amdgcn_readlane(knew, src); eqtot = __builtin_amdgcn_readlane(eqc, src);
            prefix |= (unsigned)digit << shift;
            if (k == eqtot) break;
        }
        unsigned word = 0u;
        if (eqtot == k) {
            const unsigned pf = prefix >> shift;
#pragma unroll
            for (int i = 0; i < 32; ++i) word |= ((key[i] >> shift) >= pf) ? (1u << i) : 0u;
        } else {
            int below = 0;
#pragma unroll
            for (int i = 0; i < 32; ++i) { const unsigned long long em = __ballot(act && key[i] == prefix);
                below += (int)__builtin_amdgcn_mbcnt_hi((unsigned)(em >> 32), __builtin_amdgcn_mbcnt_lo((unsigned)em, 0u)); }
            int rk = below;
#pragma unroll
            for (int i = 0; i < 32; ++i) { const bool e = key[i] == prefix; const bool sel = (key[i] > prefix) || (e && rk < k); rk += e ? 1 : 0; word |= sel ? (1u << i) : 0u; }
        }
        MB[(size_t)m * 64 + lane] = act ? word : 0u;
    }
}

template <bool DSA> struct AttnCfg {
    static constexpr int DQK = DSA ? 128 : 192, NKB = DQK / 64, KSTR = DQK + 16, KBUF = 64 * KSTR, VSTR = 80, VBUF = 128 * VSTR, BUF = KBUF + VBUF;
};
template <bool DSA>
__device__ __forceinline__ void attn_unit(unsigned char* ws, LAS unsigned char* lds, int b, int hh  , int blk  , int wave, int lane, int tid) {
    typedef AttnCfg<DSA> C;
    const int r = lane & 31, hk = lane >> 5;
    const int head = DSA ? 4 * hh + (wave >> 1) : hh;
    const int tok0 = DSA ? b * SEQ + 64 * blk + 32 * (wave & 1) : b * SEQ + 256 * blk + 32 * wave;
    const int ntw = DSA ? blk + 1 : 4 * blk + (wave >> 1) + 1;
    const int ntb = DSA ? blk + 1 : 4 * blk + 4;
    const unsigned char* Qp = DSA ? ws + WS_DQ + (size_t)(tok0 + r) * 1024 + head * 128 : ws + WS_Q + (size_t)(tok0 + r) * 1536 + head * 192;
    v8i_t qf[C::NKB];
#pragma unroll
    for (int kb = 0; kb < C::NKB; ++kb) { const v4i_t lo = *(const GAS v4i_t*)(Qp + 64 * kb + 32 * hk), hi = *(const GAS v4i_t*)(Qp + 64 * kb + 32 * hk + 16); qf[kb] = (v8i_t){lo.x, lo.y, lo.z, lo.w, hi.x, hi.y, hi.z, hi.w}; }
    int sclK = 0x7f7f7f7f, sclQ = 0x7b7b7b7b, sclP = 0x7a7a7a7a; asm volatile("" : "+v"(sclK), "+v"(sclQ), "+v"(sclP));
    const int skey = tid >> 3, sub = tid & 7;
    const unsigned char* ksrc0 = DSA ? ws + WS_DK + ((size_t)b * SEQ + skey) * 256 + hh * 128 + sub * 16 : ws + WS_KN + ((size_t)b * SEQ + skey) * 1024 + hh * 128 + sub * 16;
    const unsigned char* ksrc2 = ws + WS_KR + ((size_t)b * SEQ + skey) * 64 + (sub & 3) * 16;
    const int kdst = skey * C::KSTR + sub * 16, kdst2 = skey * C::KSTR + 128 + (sub & 3) * 16;
    constexpr int KADV0 = DSA ? 64 * 256 : 64 * 1024, KADV2 = 64 * 64;
    const unsigned char* vsrc = (DSA ? ws + WS_DVT : ws + WS_VT) + (size_t)(hh * 128 + (tid >> 2)) * M + (size_t)b * SEQ + (tid & 3) * 16;
    const int vdst = C::KBUF + (tid >> 2) * C::VSTR + (tid & 3) * 16;
    v4u kreg[2], vreg[1];
#define ATT_LOAD(kt_) do { kreg[0] = *(const GAS v4u*)(ksrc0 + (size_t)(kt_) * KADV0); \
        if (!DSA) { if (sub < 4) kreg[1] = *(const GAS v4u*)(ksrc2 + (size_t)(kt_) * KADV2); } \
        vreg[0] = *(const GAS v4u*)(vsrc + (size_t)(kt_) * 64); } while (0)
#define ATT_STORE(buf_) do { LAS unsigned char* bb_ = lds + (buf_) * C::BUF; *(LAS v4u*)(bb_ + kdst) = kreg[0]; \
        if (!DSA) { if (sub < 4) *(LAS v4u*)(bb_ + kdst2) = kreg[1]; } \
        *(LAS v4u*)(bb_ + vdst) = vreg[0]; } while (0)
    kreg[1] = (v4u){0u, 0u, 0u, 0u};
    ATT_LOAD(0); ATT_STORE(0);
#pragma unroll
    for (int kb = 0; kb < C::NKB; ++kb) asm volatile("" :: "v"(qf[kb]));
    __syncthreads();
    f32x16 o[4];
#pragma unroll
    for (int dt = 0; dt < 4; ++dt)
#pragma unroll
        for (int e = 0; e < 16; ++e) o[dt][e] = 0.f;
    float mrun = -1e30f, lrun = 0.f;
    const unsigned long long* mbp = (const unsigned long long*)((const unsigned*)(ws + WS_MB) + (size_t)(tok0 + r) * 64);
    for (int kt = 0; kt < ntb; ++kt) {
        const int cur = kt & 1;
        if (kt + 1 < ntb) ATT_LOAD(kt + 1);
        if (kt < ntw) {
            const LAS unsigned char* kb_ = lds + cur * C::BUF; const LAS unsigned char* vb = kb_ + C::KBUF;
            unsigned long long mw = 0ull; if (DSA) mw = mbp[kt];
            f32x16 st[2];
#pragma unroll
            for (int kh = 0; kh < 2; ++kh)
#pragma unroll
                for (int kb = 0; kb < C::NKB; ++kb) { const LAS unsigned char* kp = kb_ + (32 * kh + r) * C::KSTR + 64 * kb + 32 * hk;
                    const v4i_t lo = *(const LAS v4i_t*)kp, hi = *(const LAS v4i_t*)(kp + 16); const v8i_t kf = {lo.x, lo.y, lo.z, lo.w, hi.x, hi.y, hi.z, hi.w};
                    if (kb == 0) asm volatile("v_mfma_scale_f32_32x32x64_f8f6f4 %0, %1, %2, 0, %3, %4 op_sel_hi:[0,0,0]" : "=&v"(st[kh]) : "v"(kf), "v"(qf[kb]), "v"(sclK), "v"(sclQ));
                    else asm volatile("v_mfma_scale_f32_32x32x64_f8f6f4 %0, %1, %2, %0, %3, %4 op_sel_hi:[0,0,0]" : "+v"(st[kh]) : "v"(kf), "v"(qf[kb]), "v"(sclK), "v"(sclQ)); }
            asm volatile("s_nop 15\n\ts_nop 7" : "+v"(st[0]), "+v"(st[1]));
            if (DSA) {
#pragma unroll
                for (int kh = 0; kh < 2; ++kh) { const unsigned wk = (kh ? (unsigned)(mw >> 32) : (unsigned)mw) >> (4 * hk);
#pragma unroll
                    for (int e = 0; e < 16; ++e) { const int cb = (e & 3) + 8 * (e >> 2); st[kh][e] = ((wk >> cb) & 1u) ? st[kh][e] : -__builtin_inff(); } }
            }
            float mx = st[0][0];
#pragma unroll
            for (int e = 1; e < 16; ++e) mx = fmaxf(mx, st[0][e]);
#pragma unroll
            for (int e = 0; e < 16; ++e) mx = fmaxf(mx, st[1][e]);
            mx = xor32_max(mx);
            if (__any(mx > mrun + 3.0f)) {
                const float mnew = fmaxf(mrun, mx), alpha = __builtin_amdgcn_exp2f(mrun - mnew);
                mrun = mnew; lrun *= alpha;
#pragma unroll
                for (int dt = 0; dt < 4; ++dt)
#pragma unroll
                    for (int e = 0; e < 16; ++e) o[dt][e] *= alpha;
            }
            const float mnew8 = mrun - 5.0f;
            float ps;
            {
                typedef float f32x2q __attribute__((ext_vector_type(2)));
                const f32x2q m2 = {mnew8, mnew8};
                f32x2q s2 = {0.f, 0.f};
#pragma unroll
                for (int kh = 0; kh < 2; ++kh)
#pragma unroll
                    for (int e = 0; e < 16; e += 2) { const f32x2q d = (f32x2q){st[kh][e], st[kh][e + 1]} - m2;
                        const f32x2q pq = {__builtin_amdgcn_exp2f(d.x), __builtin_amdgcn_exp2f(d.y)};
                        st[kh][e] = pq.x; st[kh][e + 1] = pq.y; s2 += pq; }
                ps = s2.x + s2.y;
            }
            ps = xor32_sum(ps);
            lrun += ps;
            v8i_t pf;
#pragma unroll
            for (int j = 0; j < 8; ++j) { const int kh = j >> 2, e0 = 4 * (j & 3);
                int w = __builtin_amdgcn_cvt_pk_fp8_f32(st[kh][e0], st[kh][e0 + 1], 0, false); w = __builtin_amdgcn_cvt_pk_fp8_f32(st[kh][e0 + 2], st[kh][e0 + 3], w, true); pf[j] = w; }
            asm volatile("s_nop 3" : "+v"(pf), "+v"(o[0]), "+v"(o[1]), "+v"(o[2]), "+v"(o[3]));
#pragma unroll
            for (int dt = 0; dt < 4; ++dt) { const LAS unsigned char* vp = vb + (32 * dt + r) * C::VSTR + 32 * hk;
                const v4i_t lo = *(const LAS v4i_t*)vp, hi = *(const LAS v4i_t*)(vp + 16); const v8i_t vf = {lo.x, lo.y, lo.z, lo.w, hi.x, hi.y, hi.z, hi.w};
                asm volatile("v_mfma_scale_f32_32x32x64_f8f6f4 %0, %1, %2, %0, %3, %4 op_sel_hi:[0,0,0]" : "+v"(o[dt]) : "v"(vf), "v"(pf), "v"(sclK), "v"(sclP)); }
        }
        if (kt + 1 < ntb) ATT_STORE(cur ^ 1);
        __syncthreads();
    }
    asm volatile("s_nop 15\n\ts_nop 7" : "+v"(o[0]), "+v"(o[1]), "+v"(o[2]), "+v"(o[3]));
    __builtin_amdgcn_sched_barrier(0);
    const float inv = 512.0f / lrun;
    unsigned char* Op = ws + (DSA ? WS_OB : WS_OA) + (size_t)(tok0 + r) * 1024 + head * 128 + 4 * hk;
#pragma unroll
    for (int dt = 0; dt < 4; ++dt)
#pragma unroll
        for (int g = 0; g < 4; ++g) { int p0 = __builtin_amdgcn_cvt_pk_fp8_f32(o[dt][4 * g] * inv, o[dt][4 * g + 1] * inv, 0, false); p0 = __builtin_amdgcn_cvt_pk_fp8_f32(o[dt][4 * g + 2] * inv, o[dt][4 * g + 3] * inv, p0, true);
            *(GAS unsigned*)(Op + 32 * dt + 8 * g) = (unsigned)p0; }
}
#undef ATT_LOAD
#undef ATT_STORE
__device__ __forceinline__ void p4_attention(unsigned char* ws, LAS unsigned char* lds, int bx, int G, int wave, int lane) {
    const int tid = wave * 64 + lane;
    for (int i = bx; i < 256; i += G) {
        const int xcd = i & 7, idx = i >> 3;
#ifndef NO_MLA
        { const int bh = (idx >> 2) * 8 + xcd, qp = idx & 3, b = bh >> 3, h = bh & 7;
          attn_unit<false>(ws, lds, b, h, 7 - qp, wave, lane, tid); attn_unit<false>(ws, lds, b, h, qp, wave, lane, tid); }
#endif
#ifndef NO_DSA
        { const int bg = (idx >> 4) * 8 + xcd, cp = idx & 15, b = bg >> 1, g = bg & 1;
          attn_unit<true>(ws, lds, b, g, 31 - cp, wave, lane, tid); attn_unit<true>(ws, lds, b, g, cp, wave, lane, tid); }
#endif
    }
}
typedef __bf16 bf16x2_t __attribute__((ext_vector_type(2)));
__device__ __forceinline__ float dot2bf(unsigned w, unsigned x, float acc) { return __builtin_amdgcn_fdot2_f32_bf16(__builtin_bit_cast(bf16x2_t, w), __builtin_bit_cast(bf16x2_t, x), acc, false); }
#ifndef P8_BATCH
#define P8_BATCH 1
#endif
typedef float f32x2v __attribute__((ext_vector_type(2)));
typedef float v16f __attribute__((ext_vector_type(16)));
typedef float v32f __attribute__((ext_vector_type(32)));
typedef unsigned v6u __attribute__((ext_vector_type(6)));
#ifdef V_FP4
typedef unsigned p8vb_t;
#else
typedef v2u p8vb_t;
#endif
#define P8_DECL(n) v4u ua##n[P8_BATCH], va##n[P8_BATCH]; v2u ub##n[P8_BATCH]; p8vb_t vb##n[P8_BATCH]; float su##n[P8_BATCH], sv##n[P8_BATCH], gg##n[P8_BATCH]
#define P8_ARGS(n) ua##n, va##n, ub##n, vb##n, su##n, sv##n, gg##n
__device__ __forceinline__ void p8_load(v4u (&s_ua)[P8_BATCH], v4u (&s_va)[P8_BATCH], v2u (&s_ub)[P8_BATCH], p8vb_t (&s_vb)[P8_BATCH], float (&s_su)[P8_BATCH], float (&s_sv)[P8_BATCH], float (&s_g)[P8_BATCH], const unsigned char* U6, const unsigned char* V6, const float* USC, const float* VSC, const LAS int* EXi, const LAS float* EXg, int e0, int lane) {
#pragma unroll
    for (int q = 0; q < P8_BATCH; ++q) {
        const int ex = __builtin_amdgcn_readfirstlane(EXi[e0 + q]); s_g[q] = __builtin_bit_cast(float, __builtin_amdgcn_readfirstlane(__builtin_bit_cast(int, EXg[e0 + q])));
        const unsigned char* up = U6 + (size_t)ex * EROW; asm("" : "+s"(up));
        const unsigned char* vp = up + 1536; (void)V6;
        const unsigned ul = (unsigned)lane;
        s_ua[q] = *(const GAS v4u*)(up + (size_t)(ul * 16u)); s_ub[q] = *(const GAS v2u*)(up + 1024 + (size_t)(ul * 8u));
#ifdef V_FP4
        s_va[q] = *(const GAS v4u*)(vp + (size_t)(ul * 16u)); s_vb[q] = (unsigned)*(const GAS unsigned short*)(vp + 1024 + (size_t)(ul * 2u));
        s_su[q] = USC[ex]; s_sv[q] = 1.0f; (void)VSC;
#else
        s_va[q] = *(const GAS v4u*)(vp + lane * 16); s_vb[q] = *(const GAS v2u*)(vp + 1024 + lane * 8);
        s_su[q] = USC[ex]; s_sv[q] = VSC[ex];
#endif
    }
}
__device__ __forceinline__ void p8_compute(const v4u (&s_ua)[P8_BATCH], const v4u (&s_va)[P8_BATCH], const v2u (&s_ub)[P8_BATCH], const p8vb_t (&s_vb)[P8_BATCH], const float (&s_su)[P8_BATCH], const float (&s_sv)[P8_BATCH], const float (&s_g)[P8_BATCH], const LAS f32x4* xnl  , float (&acc)[32]) {
#pragma unroll
    for (int q = 0; q < P8_BATCH; ++q) {
        float z;
        { const v6u pu = {s_ua[q].x, s_ua[q].y, s_ua[q].z, s_ua[q].w, s_ub[q].x, s_ub[q].y};
          const v32f ru = __builtin_amdgcn_cvt_scalef32_pk32_f32_fp6(pu, 1.0f);
          f32x2v d0 = {0.f, 0.f}, d1 = {0.f, 0.f};
#pragma unroll
          for (int c = 0; c < 8; ++c) { const f32x4 x = xnl[c * 64];
              d0 += (f32x2v){ru[4 * c], ru[4 * c + 1]} * (f32x2v){x.x, x.y}; d1 += (f32x2v){ru[4 * c + 2], ru[4 * c + 3]} * (f32x2v){x.z, x.w}; }
          z = wave_sum_uniform((d0.x + d0.y) + (d1.x + d1.y)) * s_su[q]; }
        const float coef = s_g[q] * s_sv[q] * gelu_as(z);
#ifdef V_FP4
        const float cb = coef * __builtin_bit_cast(float, s_vb[q] << 16);
#pragma unroll
        for (int d = 0; d < 4; ++d) {
            const f32x2v f0 = __builtin_amdgcn_cvt_scalef32_pk_f32_fp4(s_va[q][d], 1.0f, 0), f1 = __builtin_amdgcn_cvt_scalef32_pk_f32_fp4(s_va[q][d], 1.0f, 1);
            const f32x2v f2 = __builtin_amdgcn_cvt_scalef32_pk_f32_fp4(s_va[q][d], 1.0f, 2), f3 = __builtin_amdgcn_cvt_scalef32_pk_f32_fp4(s_va[q][d], 1.0f, 3);
            acc[8 * d] += cb * f0.x; acc[8 * d + 1] += cb * f0.y; acc[8 * d + 2] += cb * f1.x; acc[8 * d + 3] += cb * f1.y;
            acc[8 * d + 4] += cb * f2.x; acc[8 * d + 5] += cb * f2.y; acc[8 * d + 6] += cb * f3.x; acc[8 * d + 7] += cb * f3.y; }
#else
        const v6u pv = {s_va[q].x, s_va[q].y, s_va[q].z, s_va[q].w, s_vb[q].x, s_vb[q].y};
        const v32f rv = __builtin_amdgcn_cvt_scalef32_pk32_f32_fp6(pv, 1.0f);
#pragma unroll
        for (int j = 0; j < 32; ++j) acc[j] += coef * rv[j];
#endif
    }
}
__device__ __forceinline__ void p8_req_u(v4u& ua, v2u& ub, const unsigned char* U6, const LAS int* EXi, int e, int lane) {
    const int ex = __builtin_amdgcn_readfirstlane(EXi[e]);
    const unsigned char* up = U6 + (size_t)ex * EROW; asm("" : "+s"(up));
    const unsigned ul = (unsigned)lane;
    ua = *(const GAS v4u*)(up + (size_t)(ul * 16u)); ub = *(const GAS v2u*)(up + 1024 + (size_t)(ul * 8u));
}
__device__ __forceinline__ void p8_req_v(v4u& va, unsigned& vb, float& su, float& gg, const unsigned char* U6, const float* USC, const LAS int* EXi, const LAS float* EXg, int e, int lane) {
    const int ex = __builtin_amdgcn_readfirstlane(EXi[e]); gg = __builtin_bit_cast(float, __builtin_amdgcn_readfirstlane(__builtin_bit_cast(int, EXg[e])));
    const unsigned char* vp = U6 + (size_t)ex * EROW + 1536; asm("" : "+s"(vp));
    const unsigned ul = (unsigned)lane;
    va = *(const GAS v4u*)(vp + (size_t)(ul * 16u)); vb = (unsigned)*(const GAS unsigned short*)(vp + 1024 + (size_t)(ul * 2u));
    su = USC[ex];
}
__device__ __forceinline__ void p8_req_u_id(v4u& ua, v2u& ub, const unsigned char* U6, int ex_, int lane) {
    const int ex = __builtin_amdgcn_readfirstlane(ex_);
    const unsigned char* up = U6 + (size_t)ex * EROW; asm("" : "+s"(up));
    const unsigned ul = (unsigned)lane;
    ua = *(const GAS v4u*)(up + (size_t)(ul * 16u)); ub = *(const GAS v2u*)(up + 1024 + (size_t)(ul * 8u));
}
__device__ __forceinline__ void p8_req_v_id(v4u& va, unsigned& vb, float& su, float& gg, const unsigned char* U6, const float* USC, int ex_, float g_, int lane) {
    const int ex = __builtin_amdgcn_readfirstlane(ex_); gg = __builtin_bit_cast(float, __builtin_amdgcn_readfirstlane(__float_as_int(g_)));
    const unsigned char* vp = U6 + (size_t)ex * EROW + 1536; asm("" : "+s"(vp));
    const unsigned ul = (unsigned)lane;
    va = *(const GAS v4u*)(vp + (size_t)(ul * 16u)); vb = (unsigned)*(const GAS unsigned short*)(vp + 1024 + (size_t)(ul * 2u));
    su = USC[ex];
}
__device__ __forceinline__ float p8_udot(const v4u& ua, const v2u& ub, const LAS f32x4* xnl  ) {
    const v6u pu = {ua.x, ua.y, ua.z, ua.w, ub.x, ub.y};
    const v32f ru = __builtin_amdgcn_cvt_scalef32_pk32_f32_fp6(pu, 1.0f);
    f32x2v d0 = {0.f, 0.f}, d1 = {0.f, 0.f};
#pragma unroll
    for (int c = 0; c < 8; ++c) { const f32x4 x = xnl[c * 64];
        d0 += (f32x2v){ru[4 * c], ru[4 * c + 1]} * (f32x2v){x.x, x.y}; d1 += (f32x2v){ru[4 * c + 2], ru[4 * c + 3]} * (f32x2v){x.z, x.w}; }
    return (d0.x + d0.y) + (d1.x + d1.y);
}
__device__ __forceinline__ void p8_udot2(const v4u& uaA, const v2u& ubA, const v4u& uaB, const v2u& ubB, const LAS f32x4* xnl, float& pA, float& pB) {
    const v6u pa = {uaA.x, uaA.y, uaA.z, uaA.w, ubA.x, ubA.y}, pb = {uaB.x, uaB.y, uaB.z, uaB.w, ubB.x, ubB.y};
    const v32f ra = __builtin_amdgcn_cvt_scalef32_pk32_f32_fp6(pa, 1.0f), rb = __builtin_amdgcn_cvt_scalef32_pk32_f32_fp6(pb, 1.0f);
    f32x2v a0 = {0.f, 0.f}, a1 = {0.f, 0.f}, b0 = {0.f, 0.f}, b1 = {0.f, 0.f};
#pragma unroll
    for (int c = 0; c < 8; ++c) { const f32x4 x = xnl[c * 64]; const f32x2v xl = {x.x, x.y}, xh = {x.z, x.w};
        a0 += (f32x2v){ra[4 * c], ra[4 * c + 1]} * xl; a1 += (f32x2v){ra[4 * c + 2], ra[4 * c + 3]} * xh;
        b0 += (f32x2v){rb[4 * c], rb[4 * c + 1]} * xl; b1 += (f32x2v){rb[4 * c + 2], rb[4 * c + 3]} * xh; }
    pA = (a0.x + a0.y) + (a1.x + a1.y); pB = (b0.x + b0.y) + (b1.x + b1.y);
}
__device__ __forceinline__ void p8_vpart(const v4u& va, unsigned vb, float cg  , float (&acc)[32]) {
    const float cb = cg * __builtin_bit_cast(float, vb << 16);
#pragma unroll
    for (int d = 0; d < 4; ++d) {
        const f32x2v f0 = __builtin_amdgcn_cvt_scalef32_pk_f32_fp4(va[d], 1.0f, 0), f1 = __builtin_amdgcn_cvt_scalef32_pk_f32_fp4(va[d], 1.0f, 1);
        const f32x2v f2 = __builtin_amdgcn_cvt_scalef32_pk_f32_fp4(va[d], 1.0f, 2), f3 = __builtin_amdgcn_cvt_scalef32_pk_f32_fp4(va[d], 1.0f, 3);
        acc[8 * d] += cb * f0.x; acc[8 * d + 1] += cb * f0.y; acc[8 * d + 2] += cb * f1.x; acc[8 * d + 3] += cb * f1.y;
        acc[8 * d + 4] += cb * f2.x; acc[8 * d + 5] += cb * f2.y; acc[8 * d + 6] += cb * f3.x; acc[8 * d + 7] += cb * f3.y; }
}
__device__ __forceinline__ float p8_reduce4(float p0, float p1, float p2, float p3, int lane) {
    const bool b0 = (lane & 1) != 0, b1 = (lane & 2) != 0;
    const float a = b0 ? p1 : p0, as = b0 ? p0 : p1, c = b0 ? p3 : p2, cs = b0 ? p2 : p3;
    const float A = a + dpp_f<0xB1>(as), C = c + dpp_f<0xB1>(cs);
    const float r = b1 ? C : A, rs = b1 ? A : C;
    float R = r + dpp_f<0x4E>(rs);
    R += dpp_f<0x124>(R); R += dpp_f<0x128>(R);
    { float a = R, b = R; asm("s_nop 1\n\tv_permlane16_swap_b32 %0, %1\n\ts_nop 1" : "+v"(a), "+v"(b)); R = a + b; }
    { float a = R, b = R; asm("s_nop 1\n\tv_permlane32_swap_b32 %0, %1\n\ts_nop 1" : "+v"(a), "+v"(b)); R = a + b; }
    return R;
}
__device__ __forceinline__ float p8_rdl(float v, int l) { return __builtin_bit_cast(float, __builtin_amdgcn_readlane(__builtin_bit_cast(int, v), l)); }
__device__ __forceinline__ float fp6_probe(int i) { return i < 8 ? 0.125f * i : i < 16 ? 1.0f + 0.125f * (i - 8) : i < 24 ? 2.0f + 0.25f * (i - 16) : 4.0f + 0.5f * (i - 24); }
__device__ __forceinline__ void p8_peer(const Args& a, LAS unsigned char* lds, int vcu, int G, int wave, int lane_in) {
    unsigned char* ws = a.ws;
    const unsigned char* U6 = ws + WS_U; const unsigned char* V6 = ws + WS_V; const float* USC = (const float*)(ws + WS_USC); const float* VSC = (const float*)(ws + WS_VSC); const float* S = (const float*)(ws + WS_S);
    LAS unsigned char* L = lds + wave * 16384;
    LAS float* T1v = (LAS float*)(L);
    LAS int*   T1i = (LAS int*)(L + 1024);
    LAS int*   OFF = (LAS int*)(L + 3072);
    LAS int*   INV = (LAS int*)(L + 3392);
    LAS int*   SIG = (LAS int*)(L + 3200);
#define P8_EXG(b) ((LAS float*)(L + ((b) ? 12288 : 2048)))
#define P8_EXI(b) ((LAS int*)(L + ((b) ? 12800 : 2560)))
    const int gw = vcu * NWAVES + wave, NGW = G * NWAVES;
    const float NINF = -__builtin_inff();
    {
        v16f pa, pb;
#pragma unroll
        for (int i = 0; i < 16; ++i) { pa[i] = fp6_probe(i); pb[i] = fp6_probe(16 + i); }
        asm volatile("" : "+v"(pa), "+v"(pb));
        const v6u pp = __builtin_amdgcn_cvt_scalef32_2xpk16_fp6_f32(pa, pb, 1.0f);
        const v32f pr = __builtin_amdgcn_cvt_scalef32_pk32_f32_fp6(pp, 1.0f);
#pragma unroll
        for (int j = 0; j < 32; ++j) { const float v = pr[j]; const int sg = v < 1.f ? (int)(v * 8.f) : v < 2.f ? 8 + (int)((v - 1.f) * 8.f) : v < 4.f ? 16 + (int)((v - 2.f) * 4.f) : 24 + (int)((v - 4.f) * 2.f);
            if (lane_in == 0) { SIG[j] = sg; OFF[j] = (sg >> 2) * 256 + (sg & 3); INV[sg] = j; } }
        LDS_WAIT(); asm volatile("" ::: "memory");
    }
#define P8_LANE_VARS int lane = lane_id(); const int qb = (lane & 7) * 16, hh2 = lane >> 3, ee2 = lane & 7; LAS f32x4* xnl = (LAS f32x4*)(L + 4096) + lane;
#define P8_RSTD(mm, dst) do { const bf16* xr_ = (const bf16*)(ws + WS_X1B) + (size_t)(mm) * D; float ss_ = 0.f; \
        _Pragma("unroll") for (int q = 0; q < 8; ++q) { const v2u w = *(const GAS v2u*)(xr_ + q * 256 + lane * 4); const float x0 = bflo(w.x), x1 = bfhi(w.x), x2_ = bflo(w.y), x3 = bfhi(w.y); ss_ += (x0 * x0 + x1 * x1) + (x2_ * x2_ + x3 * x3); } \
        dst = 1.0f / sqrtf(wave_sum_fast(ss_) * (1.f / D) + EPS); } while (0)
#define P8_S1_LOAD(mm, h) do { _Pragma("unroll") for (int q = 0; q < 4; ++q) { const f32x4 t = *(const GAS f32x4*)(S + (size_t)(mm) * 2048 + (h) * 1024 + lane * 16 + q * 4); sv[4 * q] = t.x; sv[4 * q + 1] = t.y; sv[4 * q + 2] = t.z; sv[4 * q + 3] = t.w; } } while (0)
#define P8_S1_SLICE(h, it) do { float mx = sv[0]; \
        _Pragma("unroll") for (int i = 1; i < 16; ++i) mx = fmaxf(mx, sv[i]); \
        float qm = fmaxf(mx, dpp_f<0xB1>(mx)); qm = fmaxf(qm, dpp_f<0x4E>(qm)); qm = fmaxf(qm, dpp_f<0x141>(qm)); \
        int bi = 1000; \
        _Pragma("unroll") for (int i = 15; i >= 0; --i) bi = (sv[i] == qm) ? (qb + i) : bi; \
        int qi = min(bi, dpp_i<0xB1>(bi)); qi = min(qi, dpp_i<0x4E>(qi)); qi = min(qi, dpp_i<0x141>(qi)); \
        const int li = qi - qb; \
        _Pragma("unroll") for (int i = 0; i < 16; ++i) sv[i] = (i == li) ? NINF : sv[i]; \
        if (ee2 == 0) { T1v[((h) * 8 + hh2) * 16 + (it)] = qm; T1i[((h) * 8 + hh2) * 16 + (it)] = qi; } } while (0)
#define P8_S2_SETUP() do { LDS_WAIT(); asm volatile("" ::: "memory"); \
        const LAS float* s1p = T1v + (2 * hh2) * 16; const LAS float* s2p = T1v + (2 * hh2 + 1) * 16; \
        s1a = s1p[ee2]; kq = 0; ha = s1a + s2p[0]; hb = s1p[ee2 + 8] + s2p[0]; smax = 0.f; den = 0.f; } while (0)
#define P8_S2_SLICE(it, EGn, EIn, rs) do { const LAS float* s2p = T1v + (2 * hh2 + 1) * 16; \
        const float mx = fmaxf(ha, hb); \
        float gm = fmaxf(mx, dpp_f<0xB1>(mx)); gm = fmaxf(gm, dpp_f<0x4E>(gm)); gm = fmaxf(gm, dpp_f<0x141>(gm)); \
        int bp = 100000; \
        bp = (hb == gm) ? ((ee2 + 8) * 16) : bp; \
        bp = (ha == gm) ? (ee2 * 16 + kq) : bp; \
        int gp = min(bp, dpp_i<0xB1>(bp)); gp = min(gp, dpp_i<0x4E>(gp)); gp = min(gp, dpp_i<0x141>(gp)); \
        const bool wa = (gp == ee2 * 16 + kq), wb = (gp == (ee2 + 8) * 16); \
        kq += wa ? 1 : 0; \
        const float nx = ((ee2 + 1) * (kq + 1) <= 16) ? s1a + s2p[kq & 15] : NINF;        \
        ha = wa ? nx : ha; hb = wb ? NINF : hb; \
        if ((it) == 0) smax = gm; \
        const float ex = __expf((gm - smax) * (rs)); den += ex; \
        if (ee2 == 0) { const int r1 = gp >> 4, r2 = gp & 15; (EGn)[hh2 * 16 + (it)] = ex; (EIn)[hh2 * 16 + (it)] = T1i[(2 * hh2) * 16 + r1] * 128 + T1i[(2 * hh2 + 1) * 16 + r2]; } } while (0)
#define P8_S2_FIN(EGn) do { LDS_WAIT(); asm volatile("" ::: "memory"); const float inv = 1.0f / den; (EGn)[hh2 * 16 + 2 * ee2] *= inv; (EGn)[hh2 * 16 + 2 * ee2 + 1] *= inv; LDS_WAIT(); asm volatile("" ::: "memory"); } while (0)
#define P8_XN_BUILD(mm, rs) do { const bf16* xr_ = (const bf16*)(ws + WS_X1B) + (size_t)(mm) * D; \
        _Pragma("unroll") for (int c = 0; c < 8; ++c) { f32x4 t; \
            _Pragma("unroll") for (int e = 0; e < 4; ++e) { const int o = __builtin_amdgcn_readfirstlane(OFF[4 * c + e]); t[e] = __builtin_bit_cast(float, (unsigned)xr_[o + lane * 4] << 16) * (rs) * a.g_ffn[o + lane * 4]; } \
            xnl[c * 64] = t; } \
        LDS_WAIT(); asm volatile("" ::: "memory"); } while (0)
    if (gw >= M) return;
    LAS float* RSN = (LAS float*)(L + 3328);
    {
        P8_LANE_VARS
        float rstd_cur, rstd_nxt = 0.f;
        P8_RSTD(gw, rstd_cur);
        if (gw + NGW < M) P8_RSTD(gw + NGW, rstd_nxt);
        RSN[0] = rstd_nxt;
        float sv[16], s1a = 0.f, ha = 0.f, hb = 0.f, smax = 0.f, den = 0.f; int kq = 0;
        LAS float* EG0 = P8_EXG(0); LAS int* EI0 = P8_EXI(0);
#pragma unroll 1
        for (int h = 0; h < 2; ++h) {
            P8_S1_LOAD(gw, h);
#pragma unroll 1
            for (int it = 0; it < 16; ++it) P8_S1_SLICE(h, it);
        }
        P8_S2_SETUP();
#pragma unroll 1
        for (int it = 0; it < 16; ++it) P8_S2_SLICE(it, EG0, EI0, rstd_cur);
        P8_S2_FIN(EG0);
        P8_XN_BUILD(gw, rstd_cur);
    }
    float acc[32];
#pragma unroll
    for (int j = 0; j < 32; ++j) acc[j] = 0.f;
    v4u ua0, ua1, ua2, ua3; v2u ub0, ub1, ub2, ub3;
    v4u va0, va1, va2, va3; unsigned vb0, vb1, vb2, vb3; float su0, su1, su2, su3, gg0, gg1, gg2, gg3;
#define P8_REQU_L(EI, e, un) p8_req_u(ua##un, ub##un, U6, (EI), (e), lane)
    { const int lane = lane_id(); P8_REQU_L(P8_EXI(0), 0, 0); P8_REQU_L(P8_EXI(0), 1, 1); P8_REQU_L(P8_EXI(0), 2, 2); P8_REQU_L(P8_EXI(0), 3, 3); }
    int buf = 0;
#pragma unroll 1
    for (int m = gw; m < M; m += NGW) {
        const int mn = m + NGW; const bool hn = mn < M;
        LAS float* EGc = P8_EXG(buf); LAS int* EIc = P8_EXI(buf); LAS float* EGn = P8_EXG(buf ^ 1); LAS int* EIn = P8_EXI(buf ^ 1);
        float sv[16];
        if (hn) { const int lane = lane_id(); P8_S1_LOAD(mn, 0); }
        else {
#pragma unroll
            for (int i = 0; i < 16; ++i) sv[i] = 0.f;
        }
#define P8_REQU(E_, un) do { const int Er_ = (E_); P8_REQU_L(((Er_ < 128) || !hn) ? EIc : EIn, Er_ & 127, un); } while (0)
#define P8_REQV(e, vn) p8_req_v(va##vn, vb##vn, su##vn, gg##vn, U6, USC, EIc, EGc, (e), lane)
#define P8_TOPK_VARS const int lane = lane_id(); const int qb = (lane & 7) * 16, hh2 = lane >> 3, ee2 = lane & 7; (void)qb; (void)hh2; (void)ee2;
        const int lane = lane_id(); LAS f32x4* xnl = (LAS f32x4*)(L + 4096) + lane;
#pragma unroll 1
        for (int e0 = 0; e0 < 128; e0 += 4) {
            const int g0 = e0 >> 2;
            if (hn && e0 == 32) { const int lane = lane_id(); P8_S1_LOAD(mn, 1); }
            if (hn && e0 >= 64) {
                P8_TOPK_VARS
                LAS f32x4* s2a = (LAS f32x4*)(L + 13312) + lane; LAS f32x2* s2b = (LAS f32x2*)(L + 14336) + lane;
                float s1a, ha, hb, smax, den; int kq;
                if (e0 == 64) { P8_S2_SETUP(); }
                else { const f32x4 t = *s2a; const f32x2 u = *s2b; s1a = t.x; ha = t.y; hb = t.z; { const float tw = t[3]; kq = __float_as_int(tw); }        smax = u.x; den = u.y; }
                const float rsn = RSN[0];
                P8_S2_SLICE(g0 - 16, EGn, EIn, rsn);
                if (e0 == 124) { P8_S2_FIN(EGn); }
                else { const float kf = __int_as_float(kq); *s2a = (f32x4){s1a, ha, hb, kf}; *s2b = (f32x2){smax, den}; }
            }
            const v4i_t idc = *(const LAS v4i_t*)(EIc + e0); const f32x4 ggc = *(const LAS f32x4*)(EGc + e0);
            const v4i_t idn = *(const LAS v4i_t*)((((e0 + 4) < 128) || !hn ? EIc : EIn) + ((e0 + 4) & 127));
            const int i0 = idc[0], i1 = idc[1], i2 = idc[2], i3 = idc[3], n0 = idn[0], n1 = idn[1], n2 = idn[2], n3 = idn[3];
            const float q0 = ggc[0], q1 = ggc[1], q2 = ggc[2], q3 = ggc[3];
            p8_req_v_id(va0, vb0, su0, gg0, U6, USC, i0, q0, lane); p8_req_v_id(va1, vb1, su1, gg1, U6, USC, i1, q1, lane);
            p8_req_v_id(va2, vb2, su2, gg2, U6, USC, i2, q2, lane); p8_req_v_id(va3, vb3, su3, gg3, U6, USC, i3, q3, lane);
            float p0_, p1_, p2_, p3_;
            p8_udot2(ua0, ub0, ua1, ub1, xnl, p0_, p1_);
            p8_req_u_id(ua0, ub0, U6, n0, lane); p8_req_u_id(ua1, ub1, U6, n1, lane);
            p8_udot2(ua2, ub2, ua3, ub3, xnl, p2_, p3_);
            p8_req_u_id(ua2, ub2, U6, n2, lane); p8_req_u_id(ua3, ub3, U6, n3, lane);
            const float R_ = p8_reduce4(p0_, p1_, p2_, p3_, lane);
            const float sus_ = (lane & 2) ? ((lane & 1) ? su3 : su2) : ((lane & 1) ? su1 : su0);
            const float gl_ = gelu_as(R_ * sus_);
            p8_vpart(va0, vb0, gg0 * p8_rdl(gl_, 0), acc); p8_vpart(va1, vb1, gg1 * p8_rdl(gl_, 1), acc);
            p8_vpart(va2, vb2, gg2 * p8_rdl(gl_, 2), acc); p8_vpart(va3, vb3, gg3 * p8_rdl(gl_, 3), acc);
            if (hn && e0 < 64) { P8_TOPK_VARS const int h = g0 >> 3, i2 = (g0 & 7) * 2; P8_S1_SLICE(h, i2); P8_S1_SLICE(h, i2 + 1); }
        }
        {
        const int lane = lane_id();
        const bf16* xrow = (const bf16*)(ws + WS_X1B) + (size_t)m * D;
        const bool hn2 = hn && (mn + NGW < M);
        v2u w1[8], wn[8], wr[8];
#pragma unroll
        for (int q = 0; q < 8; ++q) w1[q] = *(const GAS v2u*)(xrow + q * 256 + lane * 4);
        if (hn) {
            const bf16* xn_ = (const bf16*)(ws + WS_X1B) + (size_t)mn * D;
#pragma unroll
            for (int q = 0; q < 8; ++q) wn[q] = *(const GAS v2u*)(xn_ + q * 256 + lane * 4);
        }
        if (hn2) {
            const bf16* xr_ = (const bf16*)(ws + WS_X1B) + (size_t)(mn + NGW) * D;
#pragma unroll
            for (int q = 0; q < 8; ++q) wr[q] = *(const GAS v2u*)(xr_ + q * 256 + lane * 4);
        }
        f32x4 x2[8]; float s2 = 0.f;
#pragma unroll
        for (int q = 0; q < 8; ++q) { const f32x4 x1 = {bflo(w1[q].x), bfhi(w1[q].x), bflo(w1[q].y), bfhi(w1[q].y)};
            x2[q] = (f32x4){x1.x + acc[4 * q], x1.y + acc[4 * q + 1], x1.z + acc[4 * q + 2], x1.w + acc[4 * q + 3]}; acc[4 * q] = 0.f; acc[4 * q + 1] = 0.f; acc[4 * q + 2] = 0.f; acc[4 * q + 3] = 0.f; }
#pragma unroll
        for (int j = 0; j < 8; ++j) s2 += (x2[j].x * x2[j].x + x2[j].y * x2[j].y) + (x2[j].z * x2[j].z + x2[j].w * x2[j].w);
        const float rstd2 = 1.0f / sqrtf(wave_sum_fast(s2) * (1.f / D) + EPS);
        float* orow = a.out + (size_t)m * D;
#pragma unroll
        for (int q = 0; q < 8; ++q) *(GAS f32x4*)(orow + q * 256 + lane * 4) = x2[q] * rstd2 * *(const f32x4*)(a.g_fin + q * 256 + lane * 4);
        if (hn) {
            const float rsn = RSN[0];
            LAS float* xnf = (LAS float*)(L + 4096) + lane * 4;
#pragma unroll
            for (int q = 0; q < 8; ++q) { const f32x4 xv = {bflo(wn[q].x), bfhi(wn[q].x), bflo(wn[q].y), bfhi(wn[q].y)}; const f32x4 t = xv * rsn * *(const f32x4*)(a.g_ffn + q * 256 + lane * 4);
#pragma unroll
                for (int e = 0; e < 4; ++e) { const int pj = __builtin_amdgcn_readfirstlane(INV[4 * q + e]); xnf[(pj >> 2) * 256 + (pj & 3)] = t[e]; } }
            float r2 = 0.f;
            if (hn2) { float ss = 0.f;
#pragma unroll
                for (int q = 0; q < 8; ++q) { const float x0 = bflo(wr[q].x), x1 = bfhi(wr[q].x), x2_ = bflo(wr[q].y), x3 = bfhi(wr[q].y); ss += (x0 * x0 + x1 * x1) + (x2_ * x2_ + x3 * x3); }
                r2 = 1.0f / sqrtf(wave_sum_fast(ss) * (1.f / D) + EPS); }
            RSN[0] = r2; LDS_WAIT(); asm volatile("" ::: "memory");
        }
        }
        buf ^= 1;
    }
#undef P8_REQU
#undef P8_REQV
}


#ifndef N_LAUNCHES
#define N_LAUNCHES 1
#endif
constexpr int NPHASE = 9;
__global__ void __launch_bounds__(NWAVES * 64, 2) mk_fwd(Args args) {
    extern __shared__ __attribute__((aligned(16))) unsigned char lds_raw[];
    LAS unsigned char* lds = (LAS unsigned char*)lds_raw;
    volatile LAS unsigned* MISC = (volatile LAS unsigned*)(lds + MISC_OFF);
    const int wave = __builtin_amdgcn_readfirstlane(threadIdx.x >> 6);
#define lane (lane_id())
#define tid (wave * 64 + lane)
    const int G = gridDim.x; const int bx = blockIdx.x; const int vcu = (G % 8 == 0) ? (bx % 8) * (G / 8) + bx / 8 : bx;
    unsigned char* ws = args.ws;
    gu32* ctl = (gu32*)(ws + WS_CTL);
    for (int u = tid; u < (LDS_BYTES - LDSCTL_OFF) / 4; u += NWAVES * 64) ((LAS unsigned*)(lds + LDSCTL_OFF))[u] = 0u;
    __syncthreads();
    XcdBarrier bar; bar.bar = (unsigned*)(ctl + CW_BAR); bar.x = 0; bar.st = nullptr;
    if (N_LAUNCHES == 1) bar = xcd_barrier_post((unsigned*)(ctl + CW_BAR), MISC + 8);
    const int lo = args.ph_lo, hi = args.ph_hi;
#ifndef PHMASK
#define PHMASK 0x1ff
#endif
#define IN(k) (((PHMASK >> (k)) & 1) && lo <= (k) && (k) < hi)
#define GRID_BAR(k) do { if (IN(k) && IN((k) + 1)) xcd_barrier(bar, wave == 0 && lane == 0); } while (0)
#ifndef REPEAT_PHASE
#define REPEAT_PHASE -1
#endif
#define REP(k) for (int rep_ = 0; rep_ < ((REPEAT_PHASE == (k)) ? 2 : 1); ++rep_, ((REPEAT_PHASE == (k)) && rep_ < 2 ? xcd_barrier(bar, wave == 0 && lane == 0) : (void)0))

#ifdef TS_A
#define STAMP(k) do { if (bx == 0 && wave == 0) { const unsigned t_ = (unsigned)__builtin_amdgcn_s_memrealtime(); if (lane == 0) MISC[16 + (k)] = t_; } } while (0)
#else
#define STAMP(k) do {} while (0)
#endif
    STAMP(0);
    REP(0) if (IN(0)) { p0_prologue(args, lds, vcu, G, wave, lane); }
    GRID_BAR(0); STAMP(1);
    REP(1) if (IN(1)) {
#ifdef P1_FP8
        { pg8::Gemm g{(const bf16*)(ws + WS_XN8), (const bf16*)(ws + WS_XN8), M, 3584, D, 0x7f7f7f7f, 0x79797979}; Order<4> S; S.init(64, 14, G, bx);
          Epi1T<80> E{ws, (bf16*)args.out};
          pg8::gemm_phase<Epi1T<80>, Order<4>, true, true, true>(lds + RING_OFF, g, S, E, wave); }
#endif
#ifdef P1_NEED_BF16
        { pg8::Gemm g{(const bf16*)(ws + WS_XN), (const bf16*)(ws + WS_XN), M, 3584, D, 0, 0}; Order<1> S; S.init(64, 14, G, bx);
          Epi1 E{ws, (bf16*)args.out};
          pg8::gemm_phase<Epi1, Order<1>, true, true>(lds + RING_OFF, g, S, E, wave); }
#endif
        { pg8::Gemm g{(const bf16*)(ws + WS_XN8), (const bf16*)(ws + WS_WG8), M, 3584, D, 0x7f7f7f7f, 0x79797979}; Order<0> S; S.init(64, 14, G, (bx + G / 2) % G);
          Epi1g E{(bf16*)args.out};
          pg8::gemm_phase<Epi1g, Order<0>, true, true, true>(lds + RING_OFF, g, S, E, wave); }
    }
    GRID_BAR(1); STAMP(2);
    REP(2) if (IN(2)) { p2_rowstats(ws, vcu, G, wave, lane); STAMP(10); p2_indexer(ws, lds, bx, G, wave, lane);
#ifdef REP_INDEXER
        p2_indexer(ws, lds, bx, G, wave, lane);
#endif
    }
    GRID_BAR(2); STAMP(3);
    REP(3) if (IN(3)) {
        { pg8::Gemm g{(const bf16*)(ws + WS_XN8), (const bf16*)(ws + WS_WG8 + (size_t)3584 * D), M, 512, D, 0x7f7f7f7f, 0x79797979}; Order<0> S; S.init(64, 2, G, (bx + G / 2) % G);
          Epi1gT<14> E{(bf16*)args.out};
          pg8::gemm_phase<Epi1gT<14>, Order<0>, true, true, true>(lds + RING_OFF, g, S, E, wave); }
        { pg8::Gemm g{(const bf16*)(ws + WS_CQ), (const bf16*)(ws + WS_WUQ), M, 1536, 512}; Order<0> S; if (G == 256) S.init(64, 6, G / 2, bx < G / 2 ? bx : (1 << 20)); else S.init(64, 6, G, bx);        Epi3q E{ws};
          pg8::gemm_phase<Epi3q, Order<0>, true, true>(lds + RING_OFF, g, S, E, wave); }
        { pg8::Gemm g{(const bf16*)(ws + WS_CKV), (const bf16*)(ws + WS_CKV), M, 2048, 256}; Order<2> S; S.init(64, 8, G, bx); Epi3k E{ws};
          pg8::gemm_phase<Epi3k, Order<2>, true, true>(lds + RING_OFF, g, S, E, wave); }
        STAMP(11);
        p3_select(ws, lds, vcu, G, wave, lane);
        STAMP(12);
#ifdef REP_SELECT
        p3_select(ws, lds, vcu, G, wave, lane);
#endif
    }
    GRID_BAR(3); STAMP(4);
    REP(4) if (IN(4)) { p4_attention(ws, lds, bx, G, wave, lane); }
    GRID_BAR(4); STAMP(5);
    REP(5) if (IN(5)) {
        pg8::Gemm g{(const bf16*)(ws + WS_OA), (const bf16*)(ws + WS_WAB), 2 * M, 4096, 1024, 0x7b7b7b7b, 0x7a7a7a7a}; Order<3> S; S.init(64, 8, G, bx); Epi5 E{ws, (const bf16*)args.out};
        pg8::gemm_phase<Epi5, Order<3>, true, true, true>(lds + RING_OFF, g, S, E, wave);
    }
    GRID_BAR(5); STAMP(6);
    REP(6) if (IN(6)) {
        pg8::Gemm g{(const bf16*)(ws + WS_MRG), (const bf16*)(ws + WS_WO), M, D, D, 0x7b7b7b7b, 0x79797979}; Order<0> S; S.init(64, 8, G, bx); Epi6 E{ws, args.x, args.out};
        pg8::gemm_phase<Epi6, Order<0>, true, true, true>(lds + RING_OFF, g, S, E, wave);
    }
    GRID_BAR(6); STAMP(7);
    REP(7) if (IN(7)) {
        pg8::Gemm g{(const bf16*)(ws + WS_X1B), (const bf16*)(ws + WS_W2), M, D, D}; Order<0> S; S.init(64, 8, G, bx); Epi7 E{ws};
        pg8::gemm_phase<Epi7, Order<0>, true, true>(lds + RING_OFF, g, S, E, wave);
    }
    GRID_BAR(7); STAMP(8);
    if (IN(8)) { p8_peer(args, lds, vcu, G, wave, lane); }
#ifdef TS_A
#ifndef TS_BASE
#define TS_BASE 50.0f
#endif
#ifndef TS_OFF
#define TS_OFF 0.0f
#endif
#ifndef TS_SCALE
#define TS_SCALE 0.1f
#endif
    STAMP(9);
#ifdef TS_LAST
    if (bx == 0 && wave == 0 && lane == 0) { for (int q = 0; q < 24; ++q) __hip_atomic_store(ctl + 256 + q, MISC[16 + q], RLX_AGENT); }
    VM_WAIT(); __threadfence(); __syncthreads();
    if (wave == 0) {
        unsigned last = 0u;
        if (lane == 0) last = (__hip_atomic_fetch_add(ctl + 512, 1u, RLX_AGENT) == (unsigned)G - 1u) ? 1u : 0u;
        last = __builtin_amdgcn_readfirstlane(last);
        if (last) {
            __threadfence();
            const unsigned tend = (unsigned)__builtin_amdgcn_s_memrealtime();
            const float dA = (float)(tend - __hip_atomic_load(ctl + 256 + TS_A, RLX_AGENT)) * 0.01f;
            if (lane == 0) args.out[0] += TS_BASE + (dA - TS_OFF) * TS_SCALE;
        }
    }
#else
    if (bx == 0 && wave == 0) {
        LDS_WAIT();
#ifndef TS_A1
#define TS_A1 (TS_A + 1)
#endif
#ifndef TS_B1
#define TS_B1 (TS_B + 1)
#endif
        const float dA = (float)(MISC[16 + TS_A1] - MISC[16 + TS_A]) * 0.01f, dB = (float)(MISC[16 + TS_B1] - MISC[16 + TS_B]) * 0.01f;
        VM_WAIT();
        if (lane == 0) args.out[0] += TS_BASE + (dA - TS_OFF) * TS_SCALE;
        const float dl = dB * 0.002f;
        for (int j = 0; j < 32; ++j) args.out[(size_t)2048 * D + j * 64 + lane] += dl;
    }
#endif
#endif
#undef IN
#undef GRID_BAR
#undef lane
#undef tid
}

extern "C" void kernel_launch(void* const* d_in, const int* in_sizes, int n_in, void* d_out, int out_size, void* d_ws, size_t ws_size, hipStream_t stream) {
    static int grid = 0;
    if (grid == 0) {
        if (n_in != 18 || in_sizes[0] != M * D || out_size != M * D || ws_size < WS_END) { fprintf(stderr, "kernel_launch: unexpected problem (n_in %d, in0 %d, out %d, ws %zu)\n", n_in, n_in > 0 ? in_sizes[0] : -1, out_size, ws_size); grid = -1; return; }
        int dev = 0, cus = 0, per_cu = 0;
        if (hipGetDevice(&dev) != hipSuccess || hipDeviceGetAttribute(&cus, hipDeviceAttributeMultiprocessorCount, dev) != hipSuccess) { grid = -1; return; }
        if (hipFuncSetAttribute((const void*)mk_fwd, hipFuncAttributeMaxDynamicSharedMemorySize, LDS_BYTES) != hipSuccess) { fprintf(stderr, "kernel_launch: hipFuncSetAttribute failed\n"); grid = -1; return; }
        if (hipOccupancyMaxActiveBlocksPerMultiprocessor(&per_cu, (const void*)mk_fwd, NWAVES * 64, LDS_BYTES) != hipSuccess || per_cu < 1)
            fprintf(stderr, "kernel_launch: note: occupancy query reports %d workgroups per CU\n", per_cu);
        (void)hipGetLastError();
        grid = cus;
    }
    if (grid < 0) return;
    if (hipMemsetAsync((char*)d_ws + WS_CTL, 0, CTL_ZERO_BYTES, stream) != hipSuccess) return;
#ifdef TWO_MEMSETS
    (void)hipMemsetAsync((char*)d_ws + WS_CTL + 32768, 0, 4096, stream);
#endif
    Args a{};
    a.x = (const float*)d_in[0]; a.pos = (const int*)d_in[1]; a.g_mix = (const float*)d_in[2]; a.w_in = (const float*)d_in[3]; a.g_q = (const float*)d_in[4]; a.g_kv = (const float*)d_in[5];
    a.w_uq = (const float*)d_in[6]; a.w_uk = (const float*)d_in[7]; a.w_uv = (const float*)d_in[8]; a.w_a = (const float*)d_in[9]; a.w_b = (const float*)d_in[10]; a.w_o = (const float*)d_in[11];
    a.g_ffn = (const float*)d_in[12]; a.w_pq = (const float*)d_in[13]; a.subk = (const float*)d_in[14]; a.pu = (const float*)d_in[15]; a.pv = (const float*)d_in[16]; a.g_fin = (const float*)d_in[17];
    a.out = (float*)d_out; a.ws = (unsigned char*)d_ws;
    for (int i = 0; i < 32; ++i) a.invf[i] = pow(500000.0, -(2.0 * i) / 64.0);
    for (int i = 0; i < 16; ++i) a.invf[32 + i] = pow(500000.0, -(2.0 * i) / 32.0);
    for (int i = 0; i < 8; ++i) a.invf[48 + i] = pow(500000.0, -(2.0 * i) / 16.0);
    if (N_LAUNCHES == 1) { a.ph_lo = 0; a.ph_hi = NPHASE; hipLaunchKernelGGL(mk_fwd, dim3(grid), dim3(NWAVES * 64), LDS_BYTES, stream, a); }
    else for (int li = 0; li < NPHASE; ++li) { a.ph_lo = li; a.ph_hi = li + 1; hipLaunchKernelGGL(mk_fwd, dim3(grid), dim3(NWAVES * 64), LDS_BYTES, stream, a); }
}
```

```cpp
#include <hip/hip_runtime.h>
#include <cstdio>
#include <cstdint>
#include <cmath>
namespace pg8 {
#define PG8_LAS __attribute__((address_space(3)))
typedef unsigned short bf16_t;
typedef short bf16x8 __attribute__((ext_vector_type(8)));
typedef float f32x4 __attribute__((ext_vector_type(4)));
typedef unsigned u32x4 __attribute__((ext_vector_type(4)));
constexpr int BM = 256, BK = 64, HALF = 128, HTB = HALF * BK * 2  , STAGE_BYTES = 8 * HTB, NXCD = 8, WGM = 8;

__host__ __device__ __forceinline__ int lds_byte(int r, int c) { const int st = (r >> 4) * 2 + (c >> 5), rr = r & 15, cc = c & 31, ob = rr * 64 + cc * 2; return st * 1024 + (ob ^ (((ob >> 9) & 1) << 5)); }
__host__ __device__ __forceinline__ void stage_rc(int b, int& R, int& C) { const int st = b / 1024, sb = b % 1024, swz = sb ^ (((sb >> 9) & 1) << 5); R = (st >> 1) * 16 + swz / 64; C = (st & 1) * 32 + (swz % 64) / 2; }
__host__ __device__ __forceinline__ int perm32(int rho) { const int n = rho >> 4, i = rho & 15; return 8 * (i >> 2) + 4 * n + (i & 3); }

struct Unit { int pm, pn; };
struct Gemm { const bf16_t* A; const bf16_t* Bt; int M, N, K; int sA, sB; };
typedef int v8i_t __attribute__((ext_vector_type(8)));
typedef int v4i_t __attribute__((ext_vector_type(4)));
__device__ __forceinline__ v8i_t pg8_cat(bf16x8 lo, bf16x8 hi) { const v4i_t a = __builtin_bit_cast(v4i_t, lo), b = __builtin_bit_cast(v4i_t, hi); return (v8i_t){a.x, a.y, a.z, a.w, b.x, b.y, b.z, b.w}; }

template <class Epi, class Sched, bool ALIGN_EPI = false, bool SP2 = false, bool F8 = false  >
__device__ __forceinline__ void gemm_phase(PG8_LAS unsigned char* lds, const Gemm g, const Sched& S, const Epi& E, const int wid) {
    int lane; asm volatile("v_mbcnt_lo_u32_b32 %0, -1, 0\n\tv_mbcnt_hi_u32_b32 %0, -1, %0" : "=v"(lane)); const int tid = wid * 64 + lane, wr = wid >> 2, wc = wid & 3, fr = lane & 15, fq = lane >> 4;
    const int RB = F8 ? g.K : 2 * g.K, nt = RB / 128;
    unsigned voffA[2], voffB[2];
#pragma unroll
    for (int i = 0; i < 2; ++i) { int R, C; stage_rc(tid * 16 + i * 8192, R, C); const int Rb = Epi::PERM ? ((R & ~31) + perm32(R & 31)) : R;
        voffA[i] = (unsigned)(R * RB + 2 * C); voffB[i] = (unsigned)(Rb * RB + 2 * C); }
    const size_t kstep = (size_t)(BK * 2);
    const size_t hstep = (size_t)HALF * RB;
    const size_t tstep = 2 * hstep;
    const unsigned ldsw = (unsigned)wid * 1024u;
    const int aoff = lds_byte(wr * 64 + fr, fq * 8), boff = lds_byte(wc * 32 + fr, fq * 8);
    PG8_LAS unsigned char* ldsA = lds + aoff; PG8_LAS unsigned char* ldsB = lds + 65536 + boff; asm volatile("" : "+v"(ldsA), "+v"(ldsB));
#define PG8_SA(b, h) (((b) * 2 + (h)) * HTB)
#define PG8_SB(b, h) ((4 + (b) * 2 + (h)) * HTB)
#define PG8_STAGE(bufoff, gbase, voff) do { _Pragma("unroll") for (int _i = 0; _i < 2; ++_i) \
        __builtin_amdgcn_global_load_lds((const unsigned*)((const char*)(gbase) + (voff)[_i]), (PG8_LAS unsigned*)(lds + (bufoff) + ldsw + _i * 8192), 16, 0, 0); } while (0)
#define PG8_LD16A(off) (*(const PG8_LAS v4i_t*)(ldsA + (off)))
#define PG8_LD16B(off) (*(const PG8_LAS v4i_t*)(ldsB + (off)))
#define PG8_LDA(dst, b, h) do { _Pragma("unroll") for (int m = 0; m < 4; ++m) { if constexpr (F8) { const v4i_t lo_ = PG8_LD16A(PG8_SA(b, h) + m * 2048), hi_ = PG8_LD16A(PG8_SA(b, h) + m * 2048 + 1024); \
        dst##8[m] = (v8i_t){lo_.x, lo_.y, lo_.z, lo_.w, hi_.x, hi_.y, hi_.z, hi_.w}; } else { _Pragma("unroll") for (int k = 0; k < 2; ++k) dst[m][k] = *(const PG8_LAS bf16x8*)(ldsA + PG8_SA(b, h) + m * 2048 + k * 1024); } } } while (0)
#define PG8_LDB(dst, b, h) do { _Pragma("unroll") for (int n = 0; n < 2; ++n) { if constexpr (F8) { const v4i_t lo_ = PG8_LD16B(PG8_SB(b, h) - 65536 + n * 2048), hi_ = PG8_LD16B(PG8_SB(b, h) - 65536 + n * 2048 + 1024); \
        dst##8[n] = (v8i_t){lo_.x, lo_.y, lo_.z, lo_.w, hi_.x, hi_.y, hi_.z, hi_.w}; } else { _Pragma("unroll") for (int k = 0; k < 2; ++k) dst[n][k] = *(const PG8_LAS bf16x8*)(ldsB + PG8_SB(b, h) - 65536 + n * 2048 + k * 1024); } } } while (0)
#define PG8_MMA(ai, bj, At, Bt) do { __builtin_amdgcn_s_setprio(1); \
        if constexpr (F8) { _Pragma("unroll") for (int m = 0; m < 4; ++m) _Pragma("unroll") for (int n = 0; n < 2; ++n) \
            asm volatile("v_mfma_scale_f32_16x16x128_f8f6f4 %0, %1, %2, %0, %3, %4 op_sel_hi:[0,0,0]" : "+v"(acc[ai][bj][m][n]) : "v"(Bt##8[n]), "v"(At##8[m]), "v"(sclB), "v"(sclA)); } \
        else { _Pragma("unroll") for (int m = 0; m < 4; ++m) _Pragma("unroll") for (int n = 0; n < 2; ++n) _Pragma("unroll") for (int k = 0; k < 2; ++k) \
            acc[ai][bj][m][n] = __builtin_amdgcn_mfma_f32_16x16x32_bf16(Bt[n][k], At[m][k], acc[ai][bj][m][n], 0, 0, 0); } \
        __builtin_amdgcn_s_setprio(0); } while (0)
#define PG8_WAIT_V(n) asm volatile("s_waitcnt vmcnt(" #n ")" ::: "memory")
#define PG8_WAIT_L(n) asm volatile("s_waitcnt lgkmcnt(" #n ")" ::: "memory")
#define PG8_BAR __builtin_amdgcn_s_barrier()
#define PG8_SCHED __builtin_amdgcn_sched_barrier(0)
    Unit cur, nxt; int ui = 0;
    if (!S.next(0, cur)) return;
    f32x4 acc[2][2][4][2];
#pragma unroll
    for (int a = 0; a < 2; ++a)
#pragma unroll
        for (int b = 0; b < 2; ++b)
#pragma unroll
            for (int m = 0; m < 4; ++m)
#pragma unroll
                for (int n = 0; n < 2; ++n) acc[a][b][m][n] = (f32x4){0.f, 0.f, 0.f, 0.f};
    int sclA = g.sA, sclB = g.sB; asm volatile("" : "+v"(sclA), "+v"(sclB));
    bf16x8 At[4][2], B0[2][2], B1[2][2]; v8i_t At8[4], B08[2], B18[2]; (void)At; (void)B0; (void)B1; (void)At8; (void)B08; (void)B18;
    const char* cA = (const char*)g.A + (size_t)cur.pm * tstep; const char* cB = (const char*)g.Bt + (size_t)cur.pn * tstep;
    S.a_ready(cur);
    if constexpr (SP2) {
        PG8_STAGE(PG8_SB(0, 0), cB, voffB); PG8_STAGE(PG8_SB(0, 1), cB + hstep, voffB); PG8_STAGE(PG8_SA(0, 0), cA, voffA); PG8_STAGE(PG8_SA(0, 1), cA + hstep, voffA);
        if (wr == 1) PG8_BAR;
        PG8_WAIT_V(2); PG8_BAR;
        PG8_STAGE(PG8_SB(1, 0), cB + kstep, voffB); PG8_STAGE(PG8_SA(1, 0), cA + kstep, voffA); PG8_STAGE(PG8_SB(1, 1), cB + hstep + kstep, voffB);
        PG8_WAIT_V(6); PG8_BAR;
    } else {
        PG8_STAGE(PG8_SB(0, 0), cB, voffB); PG8_STAGE(PG8_SA(0, 0), cA, voffA); PG8_STAGE(PG8_SB(0, 1), cB + hstep, voffB); PG8_STAGE(PG8_SA(0, 1), cA + hstep, voffA);
        if (wr == 1) PG8_BAR;
        PG8_WAIT_V(4); PG8_BAR;
        PG8_STAGE(PG8_SB(1, 0), cB + kstep, voffB); PG8_STAGE(PG8_SA(1, 0), cA + kstep, voffA); PG8_STAGE(PG8_SB(1, 1), cB + hstep + kstep, voffB);
        PG8_WAIT_V(6); PG8_BAR;
    }
    for (;;) {
        const bool has_next = S.next(ui + 1, nxt);
        const char* nA = has_next ? (const char*)g.A + (size_t)nxt.pm * tstep : cA; const char* nB = has_next ? (const char*)g.Bt + (size_t)nxt.pn * tstep : cB;
        for (int t = 0; t < nt; t += 2) {
            const bool last = (t == nt - 2);
            const char* a1 = cA + (size_t)(t + 1) * kstep;
            const char* a2 = last ? nA : cA + (size_t)(t + 2) * kstep; const char* b2 = last ? nB : cB + (size_t)(t + 2) * kstep;
            const char* a3 = a2 + kstep; const char* b3 = b2 + kstep;
            if (last && has_next) S.a_ready(nxt);
            if constexpr (SP2) {
            PG8_LDB(B0, 0, 0); PG8_LDB(B1, 0, 1); PG8_SCHED; PG8_LDA(At, 0, 0); PG8_STAGE(PG8_SA(1, 1), a1 + hstep, voffA);
            PG8_WAIT_V(8); PG8_WAIT_L(0); PG8_BAR; PG8_MMA(0, 0, At, B0); PG8_MMA(0, 1, At, B1); PG8_BAR; PG8_SCHED;
            PG8_LDA(At, 0, 1); PG8_STAGE(PG8_SB(0, 0), b2, voffB); PG8_STAGE(PG8_SB(0, 1), b2 + hstep, voffB); PG8_STAGE(PG8_SA(0, 0), a2, voffA);
            PG8_WAIT_V(8); PG8_WAIT_L(0); PG8_BAR; PG8_MMA(1, 0, At, B0); PG8_MMA(1, 1, At, B1); PG8_BAR; PG8_SCHED;
            PG8_LDB(B0, 1, 0); PG8_LDB(B1, 1, 1); PG8_SCHED; PG8_LDA(At, 1, 0); PG8_STAGE(PG8_SA(0, 1), a2 + hstep, voffA);
            PG8_WAIT_V(8); PG8_WAIT_L(0); PG8_BAR; PG8_MMA(0, 0, At, B0); PG8_MMA(0, 1, At, B1); PG8_BAR; PG8_SCHED;
            PG8_LDA(At, 1, 1); PG8_STAGE(PG8_SB(1, 0), b3, voffB); PG8_STAGE(PG8_SB(1, 1), b3 + hstep, voffB); PG8_STAGE(PG8_SA(1, 0), a3, voffA);
            PG8_WAIT_V(8); PG8_WAIT_L(0); PG8_BAR; PG8_MMA(1, 0, At, B0); PG8_MMA(1, 1, At, B1); PG8_BAR; PG8_SCHED;
            } else {
            PG8_LDB(B0, 0, 0); PG8_SCHED; PG8_LDA(At, 0, 0); PG8_STAGE(PG8_SA(1, 1), a1 + hstep, voffA);
            PG8_WAIT_L(8); PG8_BAR; PG8_WAIT_L(0); PG8_MMA(0, 0, At, B0); PG8_BAR; PG8_SCHED;
            PG8_LDB(B1, 0, 1); PG8_STAGE(PG8_SB(0, 0), b2, voffB);
            PG8_BAR; PG8_WAIT_L(0); PG8_MMA(0, 1, At, B1); PG8_BAR;
            PG8_LDA(At, 0, 1); PG8_STAGE(PG8_SA(0, 0), a2, voffA);
            PG8_BAR; PG8_WAIT_L(0); PG8_MMA(1, 0, At, B0); PG8_BAR; PG8_SCHED;
            PG8_STAGE(PG8_SB(0, 1), b2 + hstep, voffB);
            PG8_WAIT_V(6); PG8_BAR; PG8_MMA(1, 1, At, B1); PG8_BAR;
            PG8_LDB(B0, 1, 0); PG8_SCHED; PG8_LDA(At, 1, 0); PG8_STAGE(PG8_SA(0, 1), a2 + hstep, voffA);
            PG8_WAIT_L(8); PG8_BAR; PG8_WAIT_L(0); PG8_MMA(0, 0, At, B0); PG8_BAR; PG8_SCHED;
            PG8_LDB(B1, 1, 1); PG8_STAGE(PG8_SB(1, 0), b3, voffB);
            PG8_BAR; PG8_WAIT_L(0); PG8_MMA(0, 1, At, B1); PG8_BAR;
            PG8_LDA(At, 1, 1); PG8_STAGE(PG8_SA(1, 0), a3, voffA);
            PG8_BAR; PG8_WAIT_L(0); PG8_MMA(1, 0, At, B0); PG8_BAR; PG8_SCHED;
            PG8_STAGE(PG8_SB(1, 1), b3 + hstep, voffB);
            PG8_WAIT_V(6); PG8_BAR; PG8_MMA(1, 1, At, B1); PG8_BAR;
            }
        }
        if constexpr (F8) {
            asm volatile("s_nop 15\n\ts_nop 15\n\ts_nop 15" : "+v"(acc[0][0][0][0]), "+v"(acc[0][0][0][1]), "+v"(acc[0][0][1][0]), "+v"(acc[0][0][1][1]), "+v"(acc[0][0][2][0]), "+v"(acc[0][0][2][1]), "+v"(acc[0][0][3][0]), "+v"(acc[0][0][3][1]), "+v"(acc[0][1][0][0]), "+v"(acc[0][1][0][1]), "+v"(acc[0][1][1][0]), "+v"(acc[0][1][1][1]), "+v"(acc[0][1][2][0]), "+v"(acc[0][1][2][1]), "+v"(acc[0][1][3][0]), "+v"(acc[0][1][3][1]) :: "memory");
            asm volatile("" : "+v"(acc[1][0][0][0]), "+v"(acc[1][0][0][1]), "+v"(acc[1][0][1][0]), "+v"(acc[1][0][1][1]), "+v"(acc[1][0][2][0]), "+v"(acc[1][0][2][1]), "+v"(acc[1][0][3][0]), "+v"(acc[1][0][3][1]), "+v"(acc[1][1][0][0]), "+v"(acc[1][1][0][1]), "+v"(acc[1][1][1][0]), "+v"(acc[1][1][1][1]), "+v"(acc[1][1][2][0]), "+v"(acc[1][1][2][1]), "+v"(acc[1][1][3][0]), "+v"(acc[1][1][3][1]));
            __builtin_amdgcn_sched_barrier(0); }
        if constexpr (ALIGN_EPI) { if (wr == 0) PG8_BAR; }
        if constexpr (!Epi::AFTER_DRAIN) { E(acc, cur, wr, wc, fr, fq); S.done(cur); }
        if (!has_next) break;
#pragma unroll
        for (int a = 0; a < 2; ++a)
#pragma unroll
            for (int b = 0; b < 2; ++b)
#pragma unroll
                for (int m = 0; m < 4; ++m)
#pragma unroll
                    for (int n = 0; n < 2; ++n) acc[a][b][m][n] = (f32x4){0.f, 0.f, 0.f, 0.f};
        cur = nxt; cA = nA; cB = nB; ++ui;
        if constexpr (ALIGN_EPI) { if (wr == 1) PG8_BAR; }
    }
    PG8_WAIT_V(0);
    if constexpr (!ALIGN_EPI) { if (wr == 0) PG8_BAR; }
    PG8_BAR;
    if constexpr (Epi::AFTER_DRAIN) { E.fused(acc, cur, wr, wc, fr, fq, lds, wid, lane); S.done(cur); }
#undef PG8_SA
#undef PG8_SB
#undef PG8_STAGE
#undef PG8_LD16A
#undef PG8_LD16B
#undef PG8_LDA
#undef PG8_LDB
#undef PG8_MMA
#undef PG8_WAIT_V
#undef PG8_WAIT_L
#undef PG8_BAR
#undef PG8_SCHED
}
}

#if !defined(P1_BF16) && !defined(P1_FP8)
#define P1_FP8 1
#endif
#if !defined(P1_FP8) || defined(P1_MASK)
#define P1_NEED_BF16 1
#endif
constexpr int NWAVES = 8;
constexpr int NB = 8, SEQ = 2048, D = 2048, M = NB * SEQ;
constexpr int IN_WIDTH = 7568;
constexpr int N1 = 7680;
constexpr int NEXP = 16384;
constexpr float EPS = 1e-6f;
constexpr float LOG2E = 1.4426950408889634f;
constexpr float MLA_QSCALE = 0.07216878364870322f * LOG2E;
constexpr float DSA_QSCALE = 0.08838834764831845f * LOG2E;

constexpr size_t MiB = 1u << 20;
constexpr size_t WS_CTL = 0, CTL_ZERO_BYTES = 64 * 1024;
constexpr size_t WS_T64 = 1 * MiB;
constexpr size_t WS_T32 = 5 * MiB;
constexpr size_t WS_T16 = 7 * MiB;
constexpr size_t WS_RS  = 8 * MiB;
constexpr size_t WS_USC = 8 * MiB + 256 * 1024;
constexpr size_t WS_VSC = 8 * MiB + 512 * 1024;
constexpr size_t WS_MB  = 9 * MiB;
constexpr size_t WS_SC  = 16 * MiB;
constexpr size_t WS_XN  = 18 * MiB;
constexpr size_t WS_OA  = 16 * MiB;
constexpr size_t WS_OB  = 32 * MiB;
constexpr size_t WS_X1B = 16 * MiB;
constexpr size_t WS_WIN = 82 * MiB;
constexpr size_t WS_WUQ = 112 * MiB;
constexpr size_t WS_CKV = 114 * MiB;
constexpr size_t WS_WUK = 122 * MiB;
constexpr size_t WS_WUV = 122 * MiB + 512 * 1024;
constexpr size_t WS_WAB = 123 * MiB;
constexpr size_t WS_WO  = 131 * MiB;
constexpr size_t WS_W2  = 139 * MiB;
constexpr size_t WS_U   = 147 * MiB;
constexpr size_t WS_V   = WS_U + 1536;
#ifndef V_FP6
#define V_FP4 1
#endif
#ifdef V_FP4
constexpr int EROW = 2688;
#else
constexpr int EROW = 3072;
#endif
constexpr size_t WS_CQ  = 275 * MiB;
constexpr size_t WS_DQ  = 291 * MiB;
constexpr size_t WS_DK  = 323 * MiB;
constexpr size_t WS_DVT = 331 * MiB;
constexpr size_t WS_IQ  = 339 * MiB;
constexpr size_t WS_KR  = 371 * MiB;
constexpr size_t WS_IK  = 373 * MiB;
constexpr size_t WS_IW  = 375 * MiB;
constexpr size_t WS_Q   = 82 * MiB;
constexpr size_t WS_KN  = 424 * MiB;
constexpr size_t WS_VT  = 456 * MiB;
constexpr size_t WS_PA  = 275 * MiB;
constexpr size_t WS_MRG = 339 * MiB;
constexpr size_t WS_S   = 275 * MiB;
constexpr size_t WS_XN8 = 376 * MiB;
constexpr size_t WS_WG8 = 408 * MiB;
constexpr size_t WS_WIN8 = 416 * MiB;
constexpr size_t WS_END = 488 * MiB;
constexpr int CW_BAR = 4096;

constexpr int RING_OFF = 0, RING_BYTES = 131072;
constexpr int LDSCTL_OFF = RING_BYTES, MISC_OFF = LDSCTL_OFF + 320;
constexpr int LDS_BYTES = 147456;

#define GAS __attribute__((address_space(1)))
#define LAS __attribute__((address_space(3)))
typedef unsigned short bf16;
typedef unsigned v4u __attribute__((ext_vector_type(4)));
typedef unsigned v2u __attribute__((ext_vector_type(2)));
typedef float f32x4 __attribute__((ext_vector_type(4)));
typedef float f32x2 __attribute__((ext_vector_type(2)));
typedef float f32x16 __attribute__((ext_vector_type(16)));
typedef short bf16x8 __attribute__((ext_vector_type(8)));
typedef GAS unsigned gu32;
typedef int v8i_t __attribute__((ext_vector_type(8)));
typedef int v4i_t __attribute__((ext_vector_type(4)));
#define RLX_AGENT __ATOMIC_RELAXED, __HIP_MEMORY_SCOPE_AGENT
#define LDS_WAIT() asm volatile("s_waitcnt lgkmcnt(0)" ::: "memory")
#define VM_WAIT() asm volatile("s_waitcnt vmcnt(0)" ::: "memory")
__device__ __forceinline__ unsigned f2bf(float f) { unsigned u = __builtin_bit_cast(unsigned, f); return (u + 0x7fffu + ((u >> 16) & 1u)) >> 16; }
__device__ __forceinline__ unsigned pk2(float lo, float hi) { unsigned r; asm volatile("v_cvt_pk_bf16_f32 %0, %1, %2" : "=v"(r) : "v"(lo), "v"(hi)); return r; }
__device__ __forceinline__ float bflo(unsigned w) { return __builtin_bit_cast(float, w << 16); }
__device__ __forceinline__ float bfhi(unsigned w) { return __builtin_bit_cast(float, w & 0xffff0000u); }
__device__ __forceinline__ float wave_sum(float v) {
#pragma unroll
    for (int o = 1; o < 64; o <<= 1) v += __shfl_xor(v, o);
    return v;
}
__device__ __forceinline__ int lane_id() { int l; asm volatile("v_mbcnt_lo_u32_b32 %0, -1, 0\n\tv_mbcnt_hi_u32_b32 %0, -1, %0" : "=v"(l)); return l; }
#define SWAP_ASM(op, a, b) asm volatile("s_nop 1\n\t" op " %0, %1\n\ts_nop 1" : "+v"(a), "+v"(b))
__device__ __forceinline__ float swap16_sum(float x) { float a = x, b = x; SWAP_ASM("v_permlane16_swap_b32", a, b); return a + b; }
__device__ __forceinline__ float swap32_sum(float x) { float a = x, b = x; SWAP_ASM("v_permlane32_swap_b32", a, b); return a + b; }
__device__ __forceinline__ float swap16_max(float x) { float a = x, b = x; SWAP_ASM("v_permlane16_swap_b32", a, b); return fmaxf(a, b); }
__device__ __forceinline__ float swap32_max(float x) { float a = x, b = x; SWAP_ASM("v_permlane32_swap_b32", a, b); return fmaxf(a, b); }
template <int CTRL> __device__ __forceinline__ float dpp_f(float x) { return __builtin_bit_cast(float, __builtin_amdgcn_mov_dpp(__builtin_bit_cast(int, x), CTRL, 0xf, 0xf, true)); }
template <int CTRL> __device__ __forceinline__ int dpp_i(int x) { return __builtin_amdgcn_mov_dpp(x, CTRL, 0xf, 0xf, true); }
__device__ __forceinline__ float wave_sum_fast(float x) {
    x += dpp_f<0xB1>(x); x += dpp_f<0x4E>(x); x += dpp_f<0x124>(x); x += dpp_f<0x128>(x);
    return swap32_sum(swap16_sum(x));
}
__device__ __forceinline__ float wave_sum_uniform(float x) {
    x += dpp_f<0xB1>(x); x += dpp_f<0x4E>(x); x += dpp_f<0x124>(x); x += dpp_f<0x128>(x);
    x += __builtin_bit_cast(float, __builtin_amdgcn_update_dpp(0, __builtin_bit_cast(int, x), 0x142, 0xa, 0xf, false));
    x += __builtin_bit_cast(float, __builtin_amdgcn_update_dpp(0, __builtin_bit_cast(int, x), 0x143, 0xc, 0xf, false));
    return __builtin_bit_cast(float, __builtin_amdgcn_readlane(__builtin_bit_cast(int, x), 63));
}
__device__ __forceinline__ float wave_max_fast(float x) {
    x = fmaxf(x, dpp_f<0xB1>(x)); x = fmaxf(x, dpp_f<0x4E>(x)); x = fmaxf(x, dpp_f<0x124>(x)); x = fmaxf(x, dpp_f<0x128>(x));
    return swap32_max(swap16_max(x));
}
__device__ __forceinline__ float xor32_max(float x) { return swap32_max(x); }
__device__ __forceinline__ float xor32_sum(float x) { return swap32_sum(x); }
__device__ __forceinline__ float gelu_as(float v) {
    const float av = fabsf(v), t = __builtin_amdgcn_rcpf(av * 0.2316418882f + 1.0f);
    float q = t * 0.5307027145f + (-0.7265760135f); q = q * t + 0.7107068705f; q = q * t + (-0.142248368f); q = q * t + 0.127414796f; q = q * t;
    const float e = __builtin_amdgcn_exp2f((v * v) * (-0.72134752044f));
    const float m = v * (q * e);
    return v < 0.f ? m : v - m;
}
#define XB_TMO      128
#define XB_XCNT(j)  (256  + 64 * (j))
#define XB_XSUB(j)  (1280 + 64 * (j))
#define XB_XGEN(j)  (2304 + 64 * (j))
#define XB_TOP      3328
#define XB_TOPGEN   3392
#define XCD_BAR_WORDS 3456
#define XB_SPIN_CAP (1u << 18)

__device__ __forceinline__ unsigned xb_ld(unsigned* p)              { return __hip_atomic_load(p, __ATOMIC_RELAXED, __HIP_MEMORY_SCOPE_AGENT); }
__device__ __forceinline__ unsigned xb_add(unsigned* p, unsigned v) { return __hip_atomic_fetch_add(p, v, __ATOMIC_RELAXED, __HIP_MEMORY_SCOPE_AGENT); }
__device__ __forceinline__ unsigned xb_xcc_id() { return (unsigned)__builtin_amdgcn_s_getreg((3 << 11) | 20) & 0xFu; }
#define XB_SPIN(cond, bar) do { unsigned _sp = 0; while (cond) { __builtin_amdgcn_s_sleep(1); \
    if ((++_sp & 255u) == 0u) { if (xb_ld(&(bar)[XB_TMO])) break; if (_sp > XB_SPIN_CAP) { atomicAdd(&(bar)[XB_TMO], 1u); break; } } } } while (0)

struct XcdBarrier {
    unsigned* bar; unsigned x;
    volatile LAS unsigned* st;
};

__device__ __forceinline__ XcdBarrier xcd_barrier_post(unsigned* bar, volatile LAS unsigned* st) {
    XcdBarrier b; b.bar = bar; b.x = xb_xcc_id(); b.st = st;
    if (threadIdx.x == 0) (void)xb_add(&bar[XB_XCNT(b.x)], 1u);
    return b;
}
__device__ __forceinline__ void xcd_barrier_complete(unsigned* bar, unsigned x, unsigned& nloc, unsigned& nx) {
    const unsigned G = gridDim.x * gridDim.y * gridDim.z;
    unsigned sum, cnt, mine, sp = 0u;
    for (;;) {
        sum = 0u; cnt = 0u; mine = 0u;
#pragma unroll
        for (unsigned j = 0; j < 16; ++j) { const unsigned c = xb_ld(&bar[XB_XCNT(j)]); sum += c; cnt += (c > 0u) ? 1u : 0u; mine = (j == x) ? c : mine; }
        if (sum == G) break;
        __builtin_amdgcn_s_sleep(1);
        if ((++sp & 255u) == 0u) { if (xb_ld(&bar[XB_TMO])) break; if (sp > XB_SPIN_CAP) { atomicAdd(&bar[XB_TMO], 1u); break; } }
    }
    nloc = mine > 0u ? mine : 1u; nx = cnt > 0u ? cnt : 1u;
}

__device__ __forceinline__ void xcd_barrier(const XcdBarrier& b, const bool leader  ) {
    asm volatile("s_waitcnt vmcnt(0)" ::: "memory");
    __syncthreads();
    if (leader) {
        unsigned* bar = b.bar;
        __builtin_amdgcn_s_waitcnt(0);
        unsigned nloc = b.st[0], nx = b.st[1];
        if (nloc == 0u) { xcd_barrier_complete(bar, b.x, nloc, nx); b.st[0] = nloc; b.st[1] = nx; }
        const unsigned old = xb_add(&bar[XB_XSUB(b.x)], 1u);
        const unsigned gen = old / nloc;
        if (old + 1u == (gen + 1u) * nloc) {
            __builtin_amdgcn_fence(__ATOMIC_RELEASE, "agent");
            asm volatile("s_waitcnt vmcnt(0)" ::: "memory");
            const unsigned og = xb_add(&bar[XB_TOP], 1u);
            const unsigned tg = og / nx;
            if (og + 1u == (tg + 1u) * nx) xb_add(&bar[XB_TOPGEN], 1u);
            else XB_SPIN(xb_ld(&bar[XB_TOPGEN]) == tg, bar);
            __builtin_amdgcn_fence(__ATOMIC_ACQUIRE, "agent");
            xb_add(&bar[XB_XGEN(b.x)], 1u);
            asm volatile("s_waitcnt vmcnt(0)" ::: "memory");
        } else {
            XB_SPIN(xb_ld(&bar[XB_XGEN(b.x)]) == gen, bar);
            __builtin_amdgcn_fence(__ATOMIC_ACQUIRE, "agent");
            asm volatile("s_waitcnt vmcnt(0)" ::: "memory");
        }
    }
    __syncthreads();
}

struct Args {
    const float* x; const int* pos; const float* g_mix; const float* w_in; const float* g_q; const float* g_kv;
    const float* w_uq; const float* w_uk; const float* w_uv; const float* w_a; const float* w_b; const float* w_o;
    const float* g_ffn; const float* w_pq; const float* subk; const float* pu; const float* pv; const float* g_fin;
    float* out; unsigned char* ws;
    double invf[56];
    int ph_lo, ph_hi;
};

__device__ __forceinline__ int src_win(int n) {
    if (n < 768) return n;
    if (n < 2048) { const int r = n - 768, head = r >> 7, j = r & 127; const int sj = j < 32 ? ((j & 1) * 16 + (j >> 1)) : j; return 832 + head * 128 + sj; }
    if (n < 2304) return 2112 + (n - 2048);
    if (n < 3328) { const int r = n - 2304, head = r >> 6, j = r & 63; const int sj = j < 16 ? ((j & 1) * 8 + (j >> 1)) : j; return 2368 + head * 64 + sj; }
    if (n < 3584) { const int r = n - 3328;
        if (r < 64) return 768 + (r & 1) * 32 + (r >> 1);
        if (r < 128) { const int j = r - 64; return 3392 + (j < 16 ? ((j & 1) * 8 + (j >> 1)) : j); }
        if (r < 144) return 3456 + (r - 128);
        return -1; }
    return 3472 + (n - 3584);
}
__device__ __forceinline__ int src_wuq(int n) {
    if (n < 1024) return (n >> 7) * 192 + (n & 127);
    const int r = n - 1024, head = r >> 6, j = r & 63; return head * 192 + 128 + (j & 1) * 32 + (j >> 1);
}
template <int MODE> __device__ __forceinline__ int src_map(int n) { if (MODE == 1) return src_win(n); if (MODE == 2) return src_wuq(n); if (MODE == 3) return 3472 + n; return n; }

template <int MODE, bool OUT8> __device__ __forceinline__ void p0_transpose_item(const float* W, int K, int N, int nblk, void* WTv, int row_off, LAS float* scr, int item, int lane, const float* kscale, float oscale) {
    const int kb = item / nblk, nb = item % nblk, k0 = 64 * kb, n0 = 32 * nb;
    const int sc = src_map<MODE>(n0 + (lane & 31));
    float tv[32];
#pragma unroll
    for (int i = 0; i < 32; ++i) { const int kk = 2 * i + (lane >> 5); tv[i] = sc >= 0 ? W[(size_t)(k0 + kk) * N + sc] : 0.f; }
#pragma unroll
    for (int i = 0; i < 32; ++i) { const int kk = 2 * i + (lane >> 5); float v = tv[i]; if (kscale) v *= kscale[k0 + kk]; scr[kk * 33 + (lane & 31)] = v; }
    LDS_WAIT(); asm volatile("" ::: "memory");
    const int c = lane & 7;
#pragma unroll
    for (int j = 0; j < 4; ++j) { const int n = (lane >> 3) + 8 * j; const LAS float* s = scr + (8 * c) * 33 + n;
        if (OUT8) { int p0 = __builtin_amdgcn_cvt_pk_fp8_f32(s[0 * 33] * oscale, s[1 * 33] * oscale, 0, false); p0 = __builtin_amdgcn_cvt_pk_fp8_f32(s[2 * 33] * oscale, s[3 * 33] * oscale, p0, true);
            int p1 = __builtin_amdgcn_cvt_pk_fp8_f32(s[4 * 33] * oscale, s[5 * 33] * oscale, 0, false); p1 = __builtin_amdgcn_cvt_pk_fp8_f32(s[6 * 33] * oscale, s[7 * 33] * oscale, p1, true);
            *(GAS v2u*)((unsigned char*)WTv + (size_t)(row_off + n0 + n) * K + k0 + 8 * c) = (v2u){(unsigned)p0, (unsigned)p1}; }
        else { v4u o; o.x = pk2(s[0 * 33], s[1 * 33]); o.y = pk2(s[2 * 33], s[3 * 33]); o.z = pk2(s[4 * 33], s[5 * 33]); o.w = pk2(s[6 * 33], s[7 * 33]);
            *(GAS v4u*)((bf16*)WTv + (size_t)(row_off + n0 + n) * K + k0 + 8 * c) = o; } }
    LDS_WAIT(); asm volatile("" ::: "memory");
}

__device__ __forceinline__ void p0_w2_item(const Args& a, bf16* W2, LAS float* scr, int item, int lane) {
    const int pass = item & 1, hp = item >> 7, d0 = ((item >> 1) & 63) * 32;
#pragma unroll 4
    for (int dd = 0; dd < 32; ++dd) scr[dd * 64 + lane] = a.w_pq[(size_t)(d0 + dd) * 1024 + hp * 64 + lane];
    LDS_WAIT(); asm volatile("" ::: "memory");
    {
        const int n = lane + 64 * pass;
        const f32x4* skp = (const f32x4*)(a.subk + ((size_t)hp * 128 + n) * 64);
        float acc[32];
#pragma unroll
        for (int i = 0; i < 32; ++i) acc[i] = 0.f;
#pragma unroll 2
        for (int c4 = 0; c4 < 16; ++c4) { const f32x4 sk = skp[c4];
#pragma unroll
            for (int dd = 0; dd < 32; ++dd) { const f32x4 w = *(const LAS f32x4*)(scr + dd * 64 + c4 * 4); acc[dd] += w.x * sk.x + w.y * sk.y + w.z * sk.z + w.w * sk.w; } }
        bf16* o = W2 + (size_t)(hp * 128 + n) * D + d0;
#pragma unroll
        for (int q = 0; q < 4; ++q) { v4u w; const float* g = a.g_ffn + d0 + 8 * q;
            w.x = pk2(acc[8 * q + 0] * g[0], acc[8 * q + 1] * g[1]); w.y = pk2(acc[8 * q + 2] * g[2], acc[8 * q + 3] * g[3]);
            w.z = pk2(acc[8 * q + 4] * g[4], acc[8 * q + 5] * g[5]); w.w = pk2(acc[8 * q + 6] * g[6], acc[8 * q + 7] * g[7]);
            *(GAS v4u*)(o + 8 * q) = w; }
    }
    LDS_WAIT(); asm volatile("" ::: "memory");
}

__device__ __forceinline__ void rms_row_load(const float* xrow, f32x4 (&v)[8], int lane) {
#pragma unroll
    for (int j = 0; j < 4; ++j) { const GAS f32x4* p = (const GAS f32x4*)(xrow + j * 512 + lane * 8); v[2 * j] = __builtin_nontemporal_load(p); v[2 * j + 1] = __builtin_nontemporal_load(p + 1); }
}
__device__ __forceinline__ void rms_row_finish(const f32x4 (&v)[8], const float* g, bf16* orow, unsigned char* orow8, int lane) {
    float s = 0.f;
#pragma unroll
    for (int j = 0; j < 8; ++j) s += (v[j].x * v[j].x + v[j].y * v[j].y) + (v[j].z * v[j].z + v[j].w * v[j].w);
    const float rstd = 1.0f / sqrtf(wave_sum_fast(s) * (1.f / D) + EPS);
#pragma unroll
    for (int j = 0; j < 4; ++j) { const f32x4 g0 = *(const f32x4*)(g + j * 512 + lane * 8), g1 = *(const f32x4*)(g + j * 512 + lane * 8 + 4);
        const f32x4 a0 = v[2 * j] * rstd * g0, a1 = v[2 * j + 1] * rstd * g1;
        v4u w; w.x = pk2(a0.x, a0.y); w.y = pk2(a0.z, a0.w); w.z = pk2(a1.x, a1.y); w.w = pk2(a1.z, a1.w);
#ifdef P1_NEED_BF16
        *(GAS v4u*)(orow + j * 512 + lane * 8) = w;
#endif
        int p0 = __builtin_amdgcn_cvt_pk_fp8_f32(a0.x, a0.y, 0, false); p0 = __builtin_amdgcn_cvt_pk_fp8_f32(a0.z, a0.w, p0, true);
        int p1 = __builtin_amdgcn_cvt_pk_fp8_f32(a1.x, a1.y, 0, false); p1 = __builtin_amdgcn_cvt_pk_fp8_f32(a1.z, a1.w, p1, true);
        *(GAS v2u*)(orow8 + j * 512 + lane * 8) = (v2u){(unsigned)p0, (unsigned)p1}; }
}
typedef float v16f_p0 __attribute__((ext_vector_type(16)));
typedef unsigned v6u_p0 __attribute__((ext_vector_type(6)));
__device__ __forceinline__ void quant_row_load(const float* xrow, f32x4 (&v)[8], int lane) {
#pragma unroll
    for (int q = 0; q < 8; ++q) v[q] = __builtin_nontemporal_load((const GAS f32x4*)(xrow + q * 256 + lane * 4));
}
__device__ __forceinline__ void quant_row_finish(const f32x4 (&v)[8], unsigned char* orow, float* scale, int lane) {
    float mx = 0.f;
#pragma unroll
    for (int j = 0; j < 8; ++j) mx = fmaxf(fmaxf(mx, fmaxf(fabsf(v[j].x), fabsf(v[j].y))), fmaxf(fabsf(v[j].z), fabsf(v[j].w)));
    mx = wave_max_fast(mx);
    const float sc = mx > 0.f ? mx * (1.0f / 7.5f) : 1.0f, inv = 1.0f / sc;
    v16f_p0 pa, pb;
#pragma unroll
    for (int q = 0; q < 4; ++q)
#pragma unroll
        for (int e = 0; e < 4; ++e) { pa[4 * q + e] = v[q][e] * inv; pb[4 * q + e] = v[4 + q][e] * inv; }
    const v6u_p0 p = __builtin_amdgcn_cvt_scalef32_2xpk16_fp6_f32(pa, pb, 1.0f);
    *(GAS v4u*)(orow + lane * 16) = (v4u){p[0], p[1], p[2], p[3]};
    *(GAS v2u*)(orow + 1024 + lane * 8) = (v2u){p[4], p[5]};
    if (lane == 0) *scale = sc;
}
__device__ __forceinline__ void quant_row_finish_fp4(const f32x4 (&v)[8], unsigned char* orow, int lane) {
    float bm = 0.f;
#pragma unroll
    for (int j = 0; j < 8; ++j) bm = fmaxf(fmaxf(bm, fmaxf(fabsf(v[j].x), fabsf(v[j].y))), fmaxf(fabsf(v[j].z), fabsf(v[j].w)));
    const unsigned sbits = bm > 0.f ? f2bf(bm * (1.0f / 6.0f)) : 0x3f80u;
    const float sb = __builtin_bit_cast(float, sbits << 16), inv = 1.0f / sb;
    v4u w;
#pragma unroll
    for (int d = 0; d < 4; ++d) { unsigned p = 0u; const f32x4 a = v[2 * d] * inv, b = v[2 * d + 1] * inv;
        p = __builtin_amdgcn_cvt_scalef32_pk_fp4_f32(p, a.x, a.y, 1.0f, 0); p = __builtin_amdgcn_cvt_scalef32_pk_fp4_f32(p, a.z, a.w, 1.0f, 1);
        p = __builtin_amdgcn_cvt_scalef32_pk_fp4_f32(p, b.x, b.y, 1.0f, 2); p = __builtin_amdgcn_cvt_scalef32_pk_fp4_f32(p, b.z, b.w, 1.0f, 3); w[d] = p; }
    *(GAS v4u*)(orow + lane * 16) = w;
    *(GAS unsigned short*)(orow + 1024 + lane * 2) = (unsigned short)sbits;
}
__device__ __forceinline__ void p0_expert_rows(unsigned char* ws, const float* pu_, const float* pv_, int gw, int NGW, int lane) {
#pragma unroll 1
    for (int m = gw; m < 2 * NEXP; m += 2 * NGW) {
        f32x4 va[8], vb[8]; const int e = m & (NEXP - 1), e2 = e + NGW; const bool isu = m < NEXP;
        const float* src = isu ? pu_ : pv_; unsigned char* dst = ws + (isu ? WS_U : WS_V); float* scl = (float*)(ws + (isu ? WS_USC : WS_VSC));
        quant_row_load(src + (size_t)e * D, va, lane); quant_row_load(src + (size_t)e2 * D, vb, lane);
#ifdef V_FP4
        if (!isu) { quant_row_finish_fp4(va, dst + (size_t)e * EROW, lane); quant_row_finish_fp4(vb, dst + (size_t)e2 * EROW, lane); } else
#endif
        { quant_row_finish(va, dst + (size_t)e * EROW, scl + e, lane); quant_row_finish(vb, dst + (size_t)e2 * EROW, scl + e2, lane); }
    }
}
__device__ __forceinline__ void p0_prologue(const Args& a, LAS unsigned char* lds, int vcu, int G, int wave, int lane) {
    unsigned char* ws = a.ws;
    LAS float* scr = (LAS float*)(lds + RING_OFF + wave * 16384);
    const int gw = vcu * NWAVES + wave, NGW = G * NWAVES;
    constexpr int I_WIN = 32 * 112, I_WG = 32 * 128, I_WUQ = 8 * 48, I_WUK = 4 * 32, I_WUV = 4 * 32, I_WA = 16 * 64, I_WB = 16 * 64, I_WO = 32 * 64, I_W2 = 2048;
#if defined(P1_FP8) && defined(P1_MASK)
    constexpr int I_WINX = I_WIN;
#else
    constexpr int I_WINX = 0;
#endif
    constexpr int NITEMS = I_WINX + I_WIN + I_WG + I_WUQ + I_WUK + I_WUV + I_WA + I_WB + I_WO + I_W2;
    for (int it = gw; it < NITEMS; it += NGW) {
        int r = it;
#ifdef P1_FP8
        if (r < I_WIN) { p0_transpose_item<1, true>(a.w_in, D, IN_WIDTH, 112, ws + WS_WIN8, 0, scr, r, lane, nullptr, 64.f); continue; } r -= I_WIN;
#endif
#ifdef P1_NEED_BF16
        if (r < I_WIN) { p0_transpose_item<1, false>(a.w_in, D, IN_WIDTH, 112, ws + WS_WIN, 0, scr, r, lane, nullptr, 1.f); continue; } r -= I_WIN;
#endif
        if (r < I_WG) { p0_transpose_item<3, true>(a.w_in, D, IN_WIDTH, 128, ws + WS_WG8, 0, scr, r, lane, nullptr, 64.f); continue; } r -= I_WG;
        if (r < I_WUQ) { p0_transpose_item<2, false>(a.w_uq, 512, 1536, 48, ws + WS_WUQ, 0, scr, r, lane, a.g_q, 1.f); continue; } r -= I_WUQ;
        if (r < I_WUK) { p0_transpose_item<0, false>(a.w_uk, 256, 1024, 32, ws + WS_WUK, 0, scr, r, lane, a.g_kv, 1.f); continue; } r -= I_WUK;
        if (r < I_WUV) { p0_transpose_item<0, false>(a.w_uv, 256, 1024, 32, ws + WS_WUV, 0, scr, r, lane, a.g_kv, 1.f); continue; } r -= I_WUV;
        if (r < I_WA) { p0_transpose_item<0, true>(a.w_a, 1024, 2048, 64, ws + WS_WAB, 0, scr, r, lane, nullptr, 32.f); continue; } r -= I_WA;
        if (r < I_WB) { p0_transpose_item<0, true>(a.w_b, 1024, 2048, 64, ws + WS_WAB, 2048, scr, r, lane, nullptr, 32.f); continue; } r -= I_WB;
        if (r < I_WO) { p0_transpose_item<0, true>(a.w_o, 2048, 2048, 64, ws + WS_WO, 0, scr, r, lane, nullptr, 64.f); continue; } r -= I_WO;
        p0_w2_item(a, (bf16*)(ws + WS_W2), scr, r, lane);
    }
#ifdef TS_A
#define P0STAMP(k) do { if (blockIdx.x == 0 && wave == 0) { const unsigned t_ = (unsigned)__builtin_amdgcn_s_memrealtime(); if (lane == 0) ((volatile LAS unsigned*)(lds + MISC_OFF))[16 + (k)] = t_; } } while (0)
#else
#define P0STAMP(k) do {} while (0)
#endif
    P0STAMP(20);
    for (int m = gw; m < M; m += 2 * NGW) {
        f32x4 va[8], vb[8]; const int m2 = m + NGW;
        rms_row_load(a.x + (size_t)m * D, va, lane); rms_row_load(a.x + (size_t)m2 * D, vb, lane);
        rms_row_finish(va, a.g_mix, (bf16*)(ws + WS_XN) + (size_t)m * D, ws + WS_XN8 + (size_t)m * D, lane); rms_row_finish(vb, a.g_mix, (bf16*)(ws + WS_XN) + (size_t)m2 * D, ws + WS_XN8 + (size_t)m2 * D, lane);
    }
    P0STAMP(21);
    if (G != 256) p0_expert_rows(ws, a.pu, a.pv, gw, NGW, lane);
    P0STAMP(22);
    const int gt = gw * 64 + lane, NGT = NGW * 64;
    for (int idx = gt; idx < M * 56; idx += NGT) {
        const int t = idx / 56, i = idx - t * 56;
        const double ang = (double)a.pos[t] * a.invf[i];
        double rev = ang * 0.15915494309189535; rev -= __builtin_rint(rev);
        const float r = (float)(rev * 6.283185307179586);
        const float c = cosf(r), s = sinf(r);
        f32x2* dst = i < 32 ? (f32x2*)(ws + WS_T64) + (size_t)t * 32 + i : i < 48 ? (f32x2*)(ws + WS_T32) + (size_t)t * 16 + (i - 32) : (f32x2*)(ws + WS_T16) + (size_t)t * 8 + (i - 48);
        *dst = (f32x2){c, s};
    }
}

template <int KIND> struct Order {
    int nM, nN, nwg, G, c;
    unsigned char* dws; const float* dpu; const float* dpv; int dslot, dgw, dngw; mutable int dcount;
    __device__ void init(int nM_, int nN_, int G_, int c_) { nM = nM_; nN = nN_; nwg = nM * nN; G = G_; c = c_; dws = nullptr; dpu = nullptr; dpv = nullptr; dslot = -1; dgw = 0; dngw = 0; dcount = 0; }
    __device__ void defer(unsigned char* ws_, const float* pu_, const float* pv_, int slot_, int gw_, int ngw_) { dws = ws_; dpu = pu_; dpv = pv_; dslot = slot_; dgw = gw_; dngw = ngw_; }
    __device__ bool next(int i, pg8::Unit& u) const {
        const int ii = (KIND == 3) ? (i >> 1) : i;
        const long L = (long)ii * G + c; if (L >= nwg) return false;
        int wgid = (int)L; { const int q = nwg / 8, r = nwg % 8, xcd = wgid % 8, off = wgid / 8; wgid = (xcd < r ? xcd * (q + 1) : r * (q + 1) + (xcd - r) * q) + off; }
        const int nig = 8 * nN, gid = wgid / nig, fm = gid * 8, gsz = (nM - fm) < 8 ? (nM - fm) : 8;
        const int pm = fm + ((wgid % nig) % gsz), vn = (wgid % nig) / gsz;
        if (KIND == 0) { u.pm = pm; u.pn = vn; }
        if (KIND == 1) { if (vn == 8) { u.pm = 72; u.pn = pm; } else { u.pm = pm; u.pn = 64 + vn; } }
        if (KIND == 4) { if (vn == 8) { u.pm = 88; u.pn = pm; } else { u.pm = pm; u.pn = 80 + vn; } }
        if (KIND == 2) { if (vn >= 4) { u.pm = 64 + vn; u.pn = pm; } else { u.pm = pm; u.pn = 64 + vn; } }
        if (KIND == 3) { const int br = i & 1; u.pm = pm + 64 * br; u.pn = vn + 8 * br; }
        return true;
    }
    __device__ __forceinline__ void a_ready(const pg8::Unit&) const {}
    __device__ __forceinline__ void done(const pg8::Unit&) const {
        if (dws != nullptr) { if (dcount == dslot) { p0_expert_rows(dws, dpu, dpv, dgw, dngw, lane_id()); asm volatile("s_waitcnt vmcnt(0)" ::: "memory"); } ++dcount; }
    }
};

__device__ __forceinline__ void st8bf(bf16* p, f32x4 a, f32x4 b) { v4u w; w.x = pk2(a.x, a.y); w.y = pk2(a.z, a.w); w.z = pk2(b.x, b.y); w.w = pk2(b.z, b.w); *(GAS v4u*)p = w; }
__device__ __forceinline__ void rope8(f32x4& a, f32x4& b, const float* tab) {
    const f32x4 t0 = *(const f32x4*)tab, t1 = *(const f32x4*)(tab + 4);
    const f32x4 ra = {a.x * t0.x - a.y * t0.y, a.y * t0.x + a.x * t0.y, a.z * t0.z - a.w * t0.w, a.w * t0.z + a.z * t0.w};
    const f32x4 rb = {b.x * t1.x - b.y * t1.y, b.y * t1.x + b.x * t1.y, b.z * t1.z - b.w * t1.w, b.w * t1.z + b.z * t1.w};
    a = ra; b = rb;
}
__device__ __forceinline__ void st8_vt(bf16* rowp, int tk0, f32x4 a, f32x4 b) {
    bf16* p = rowp + (tk0 & ~15) + 4 * ((tk0 >> 3) & 1);
    v2u w0, w1; w0.x = pk2(a.x, a.y); w0.y = pk2(a.z, a.w); w1.x = pk2(b.x, b.y); w1.y = pk2(b.z, b.w);
    *(GAS v2u*)p = w0; *(GAS v2u*)(p + 8) = w1;
}
__device__ __forceinline__ void st8f8(unsigned char* p, f32x4 a, f32x4 b) { int p0 = __builtin_amdgcn_cvt_pk_fp8_f32(a.x, a.y, 0, false); p0 = __builtin_amdgcn_cvt_pk_fp8_f32(a.z, a.w, p0, true);
    int p1 = __builtin_amdgcn_cvt_pk_fp8_f32(b.x, b.y, 0, false); p1 = __builtin_amdgcn_cvt_pk_fp8_f32(b.z, b.w, p1, true); *(GAS v2u*)p = (v2u){(unsigned)p0, (unsigned)p1}; }
__device__ __forceinline__ void st8_vt8(unsigned char* rowp, int tk0, f32x4 a, f32x4 b) {
    const int k0 = tk0 & 63, kh = k0 >> 5, kk0 = k0 & 31;
    unsigned char* p = rowp + (tk0 & ~63) + 16 * kh + 4 * (kk0 >> 3);
    int w0 = __builtin_amdgcn_cvt_pk_fp8_f32(a.x, a.y, 0, false); w0 = __builtin_amdgcn_cvt_pk_fp8_f32(a.z, a.w, w0, true);
    int w1 = __builtin_amdgcn_cvt_pk_fp8_f32(b.x, b.y, 0, false); w1 = __builtin_amdgcn_cvt_pk_fp8_f32(b.z, b.w, w1, true);
    *(GAS unsigned*)p = (unsigned)w0; *(GAS unsigned*)(p + 32) = (unsigned)w1;
}
#define EPI_FOR _Pragma("unroll") for (int ai = 0; ai < 2; ++ai) _Pragma("unroll") for (int m = 0; m < 4; ++m) _Pragma("unroll") for (int bj = 0; bj < 2; ++bj)
#ifndef EPI_BAR
#define EPI_BAR (bj == 0 && (m & 1) == 0)
#endif
#define EPI_VARS if (EPI_BAR) asm volatile("" ::: "memory"); const int rl = 128 * ai + 64 * wr + 16 * m + fr, lc = 128 * bj + 32 * wc + 8 * fq; f32x4 v0 = acc[ai][bj][m][0], v1 = acc[ai][bj][m][1]; (void)rl; (void)lc;

template <int WOFF> struct Epi1T {
    static constexpr bool PERM = true, AFTER_DRAIN = false;
    unsigned char* ws; bf16* G;
    __device__ __forceinline__ void operator()(const f32x4 (&acc)[2][2][4][2], const pg8::Unit& u, int wr, int wc, int fr_, int fq_) const {
        int fr = fr_, fq = fq_; asm volatile("" : "+v"(fr), "+v"(fq));
#ifdef P1_MASK
        { const int ctm = (u.pm >= 64) ? 8 : u.pn - WOFF; if (!(((WOFF == 80 ? P1_MASK : ~P1_MASK) >> ctm) & 1)) return; }
#endif
        if (u.pm >= 64) {
            unsigned char* DVT = ws + WS_DVT;
            EPI_FOR { EPI_VARS st8_vt8(DVT + (size_t)rl * M, u.pn * 256 + lc, v0, v1); }
            return;
        }
        const int ct = u.pn - WOFF; const size_t row0 = (size_t)u.pm * 256;
        if (ct < 2) { bf16* O = (bf16*)(ws + WS_CQ); EPI_FOR { EPI_VARS st8bf(O + (row0 + rl) * 512 + ct * 256 + lc, v0, v1); } }
        else if (ct == 2) { bf16* O = (bf16*)(ws + WS_CKV); EPI_FOR { EPI_VARS st8bf(O + (row0 + rl) * 256 + lc, v0, v1); } }
        else if (ct < 7) { unsigned char* O = ws + WS_DQ; const float* T = (const float*)(ws + WS_T32);
            EPI_FOR { EPI_VARS const int gc = (ct - 3) * 256 + lc, j = gc & 127; const size_t row = row0 + rl;
                if (j < 32) rope8(v0, v1, T + row * 32 + j);
                st8f8(O + row * 1024 + gc, v0 * (DSA_QSCALE * 16.f), v1 * (DSA_QSCALE * 16.f)); } }
        else if (ct == 7) { unsigned char* O = ws + WS_DK; const float* T = (const float*)(ws + WS_T32);
            EPI_FOR { EPI_VARS const int j = lc & 127; const size_t row = row0 + rl;
                if (j < 32) rope8(v0, v1, T + row * 32 + j);
                st8f8(O + row * 256 + lc, v0, v1); } }
        else if (ct < 13) { bf16* O = (bf16*)(ws + WS_IQ); const float* T = (const float*)(ws + WS_T16);
            EPI_FOR { EPI_VARS const int gc = (ct - 9) * 256 + lc, j = gc & 63; const size_t row = row0 + rl;
                if (j < 16) rope8(v0, v1, T + row * 16 + j);
                st8bf(O + row * 1024 + gc, v0, v1); } }
        else if (ct == 13) {
            EPI_FOR { EPI_VARS const size_t row = row0 + rl;
                if (lc < 64) { rope8(v0, v1, (const float*)(ws + WS_T64) + row * 64 + lc); st8f8(ws + WS_KR + row * 64 + lc, v0, v1); }
                else if (lc < 128) { const int j = lc - 64; if (j < 16) rope8(v0, v1, (const float*)(ws + WS_T16) + row * 16 + j); st8bf((bf16*)(ws + WS_IK) + row * 64 + j, v0, v1); }
                else if (lc < 144) { float* o = (float*)(ws + WS_IW) + row * 16 + (lc - 128); *(GAS f32x4*)o = v0 * 0.03125f; *(GAS f32x4*)(o + 4) = v1 * 0.03125f; } } }
    }
};
typedef Epi1T<64> Epi1;
template <int TOFF> struct Epi1gT {
    static constexpr bool PERM = true, AFTER_DRAIN = false;
    bf16* G;
    __device__ __forceinline__ void operator()(const f32x4 (&acc)[2][2][4][2], const pg8::Unit& u, int wr, int wc, int fr_, int fq_) const {
        int fr = fr_, fq = fq_; asm volatile("" : "+v"(fr), "+v"(fq));
        EPI_FOR { EPI_VARS const int gc = (u.pn + TOFF) * 256 + lc; const size_t row = (size_t)u.pm * 256 + rl;
            f32x4 s0, s1;
#pragma unroll
            for (int e = 0; e < 4; ++e) { s0[e] = __builtin_amdgcn_rcpf(1.f + __expf(-v0[e])); s1[e] = __builtin_amdgcn_rcpf(1.f + __expf(-v1[e])); }
            st8f8((unsigned char*)G + row * 4096 + gc, s0 * 128.f, s1 * 128.f); }
    }
};
typedef Epi1gT<0> Epi1g;

struct Epi3q {
    static constexpr bool PERM = true, AFTER_DRAIN = false;
    unsigned char* ws;
    __device__ __forceinline__ void operator()(const f32x4 (&acc)[2][2][4][2], const pg8::Unit& u, int wr, int wc, int fr_, int fq_) const {
        int fr = fr_, fq = fq_; asm volatile("" : "+v"(fr), "+v"(fq));
        unsigned char* Q = ws + WS_Q; const float* RSQ = (const float*)(ws + WS_RS); const float* T = (const float*)(ws + WS_T64);
        const size_t row0 = (size_t)u.pm * 256;
        EPI_FOR { EPI_VARS const size_t row = row0 + rl; const float sc = RSQ[row] * (MLA_QSCALE * 16.f); v0 = v0 * sc; v1 = v1 * sc;
            if (u.pn < 4) { const int gc = u.pn * 256 + lc; st8f8(Q + row * 1536 + (gc >> 7) * 192 + (gc & 127), v0, v1); }
            else { const int r = (u.pn - 4) * 256 + lc, j = r & 63; rope8(v0, v1, T + row * 64 + j); st8f8(Q + row * 1536 + (r >> 6) * 192 + 128 + j, v0, v1); } }
    }
};
struct Epi3k {
    static constexpr bool PERM = true, AFTER_DRAIN = false;
    unsigned char* ws;
    __device__ __forceinline__ void operator()(const f32x4 (&acc)[2][2][4][2], const pg8::Unit& u, int wr, int wc, int fr_, int fq_) const {
        int fr = fr_, fq = fq_; asm volatile("" : "+v"(fr), "+v"(fq));
        const float* RSK = (const float*)(ws + WS_RS) + M;
        if (u.pm >= 64) { unsigned char* VT = ws + WS_VT; const int vt = u.pm - 68;
            EPI_FOR { EPI_VARS const int tk0 = u.pn * 256 + lc; const f32x4 r0 = *(const f32x4*)(RSK + tk0), r1 = *(const f32x4*)(RSK + tk0 + 4);
                st8_vt8(VT + (size_t)(vt * 256 + rl) * M, tk0, v0 * r0, v1 * r1); }
            return; }
        unsigned char* KN = ws + WS_KN; const int ct = u.pn - 64; const size_t row0 = (size_t)u.pm * 256;
        EPI_FOR { EPI_VARS const size_t row = row0 + rl; const float sc = RSK[row]; st8f8(KN + row * 1024 + ct * 256 + lc, v0 * sc, v1 * sc); }
    }
};
struct Epi5 {
    static constexpr bool PERM = true, AFTER_DRAIN = false;
    unsigned char* ws; const bf16* G;
    __device__ __forceinline__ void operator()(const f32x4 (&acc)[2][2][4][2], const pg8::Unit& u, int wr, int wc, int fr_, int fq_) const {
        int fr = fr_, fq = fq_; asm volatile("" : "+v"(fr), "+v"(fq));
        bf16* PA = (bf16*)(ws + WS_PA); unsigned char* MRG = ws + WS_MRG;
        const size_t row0 = (size_t)(u.pm & 63) * 256; const int col0 = (u.pn & 7) * 256;
#ifdef DBG_ZERO_MLA
        if (u.pm < 64) { EPI_FOR { EPI_VARS st8bf(PA + (row0 + rl) * 2048 + col0 + lc, v0 * 0.f, v1 * 0.f); } return; }
#else
        if (u.pm < 64) { EPI_FOR { EPI_VARS st8f8((unsigned char*)PA + (row0 + rl) * 2048 + col0 + lc, v0 * 16.f, v1 * 16.f); } return; }
#endif
        EPI_FOR { EPI_VARS const size_t row = row0 + rl; const int col = col0 + lc;
            const unsigned char* G8 = (const unsigned char*)G;
            const v2u ga = __builtin_nontemporal_load((const GAS v2u*)(G8 + row * 4096 + col)), gb = __builtin_nontemporal_load((const GAS v2u*)(G8 + row * 4096 + 2048 + col));        const v2u pa8 = *(const GAS v2u*)((const unsigned char*)PA + row * 2048 + col);
            const f32x2 a0 = __builtin_amdgcn_cvt_pk_f32_fp8((int)ga.x, false), a1 = __builtin_amdgcn_cvt_pk_f32_fp8((int)ga.x, true), a2 = __builtin_amdgcn_cvt_pk_f32_fp8((int)ga.y, false), a3 = __builtin_amdgcn_cvt_pk_f32_fp8((int)ga.y, true);
            const f32x2 b0 = __builtin_amdgcn_cvt_pk_f32_fp8((int)gb.x, false), b1 = __builtin_amdgcn_cvt_pk_f32_fp8((int)gb.x, true), b2 = __builtin_amdgcn_cvt_pk_f32_fp8((int)gb.y, false), b3 = __builtin_amdgcn_cvt_pk_f32_fp8((int)gb.y, true);
            const f32x2 p0 = __builtin_amdgcn_cvt_pk_f32_fp8((int)pa8.x, false), p1 = __builtin_amdgcn_cvt_pk_f32_fp8((int)pa8.x, true), p2 = __builtin_amdgcn_cvt_pk_f32_fp8((int)pa8.y, false), p3 = __builtin_amdgcn_cvt_pk_f32_fp8((int)pa8.y, true);
            f32x4 o0, o1;
#ifdef DBG_ZERO_DSA
            v0 = v0 * 0.f; v1 = v1 * 0.f;
#endif
            v0 = v0 * 16.f; v1 = v1 * 16.f;
            o0.x = a0.x * p0.x + b0.x * v0.x; o0.y = a0.y * p0.y + b0.y * v0.y;
            o0.z = a1.x * p1.x + b1.x * v0.z; o0.w = a1.y * p1.y + b1.y * v0.w;
            o1.x = a2.x * p2.x + b2.x * v1.x; o1.y = a2.y * p2.y + b2.y * v1.y;
            o1.z = a3.x * p3.x + b3.x * v1.z; o1.w = a3.y * p3.y + b3.y * v1.w;
            st8f8(MRG + row * 2048 + col, o0 * (1.f / 128.f), o1 * (1.f / 128.f)); }
    }
};
struct Epi6 {
    static constexpr bool PERM = true, AFTER_DRAIN = false;
    unsigned char* ws; const float* x; float* out;
    __device__ __forceinline__ void operator()(const f32x4 (&acc)[2][2][4][2], const pg8::Unit& u, int wr, int wc, int fr_, int fq_) const {
        int fr = fr_, fq = fq_; asm volatile("" : "+v"(fr), "+v"(fq));
        bf16* X1B = (bf16*)(ws + WS_X1B);
        EPI_FOR { EPI_VARS const size_t off = ((size_t)u.pm * 256 + rl) * 2048 + u.pn * 256 + lc;
            const f32x4 a = __builtin_nontemporal_load((const GAS f32x4*)(x + off)) + v0, b = __builtin_nontemporal_load((const GAS f32x4*)(x + off + 4)) + v1;
            st8bf(X1B + off, a, b); }
    }
};
struct Epi7 {
    static constexpr bool PERM = true, AFTER_DRAIN = false;
    unsigned char* ws;
    __device__ __forceinline__ void operator()(const f32x4 (&acc)[2][2][4][2], const pg8::Unit& u, int wr, int wc, int fr_, int fq_) const {
        int fr = fr_, fq = fq_; asm volatile("" : "+v"(fr), "+v"(fq));
        float* S = (float*)(ws + WS_S);
        EPI_FOR { EPI_VARS const size_t off = ((size_t)u.pm * 256 + rl) * 2048 + u.pn * 256 + lc;
            *(GAS f32x4*)(S + off) = v0; *(GAS f32x4*)(S + off + 4) = v1; }
    }
};

__device__ __forceinline__ void p2_rowstats(unsigned char* ws, int vcu, int G, int wave, int lane) {
    const bf16* CQ = (const bf16*)(ws + WS_CQ); const bf16* CKV = (const bf16*)(ws + WS_CKV); float* RS = (float*)(ws + WS_RS);
    const int gw = vcu * NWAVES + wave, NGW = G * NWAVES;
    for (int m = gw; m < M; m += NGW) {
        const v4u q = *(const GAS v4u*)(CQ + (size_t)m * 512 + lane * 8); const v2u k = *(const GAS v2u*)(CKV + (size_t)m * 256 + lane * 4);
        float sq = 0.f, sk = 0.f;
#pragma unroll
        for (int e = 0; e < 4; ++e) { const float a = bflo(q[e]), b = bfhi(q[e]); sq += a * a + b * b; }
#pragma unroll
        for (int e = 0; e < 2; ++e) { const float a = bflo(k[e]), b = bfhi(k[e]); sk += a * a + b * b; }
        sq = wave_sum_fast(sq); sk = wave_sum_fast(sk);
        if (lane == 0) { RS[m] = 1.0f / sqrtf(sq * (1.f / 512.f) + EPS); RS[M + m] = 1.0f / sqrtf(sk * (1.f / 256.f) + EPS); }
    }
}
__device__ __forceinline__ size_t sc_base(int b, int c) { return (size_t)b * 2162688u + (size_t)2048 * c * (c + 1); }
__device__ __forceinline__ void idx_segment(unsigned char* ws, LAS unsigned char* lds, int b, int c, int k0, int k1, int wave, int lane, int tid) {
    const bf16* IQ = (const bf16*)(ws + WS_IQ); const bf16* IK = (const bf16*)(ws + WS_IK); const float* IW = (const float*)(ws + WS_IW); float* SC = (float*)(ws + WS_SC);
    const int t0 = b * SEQ + 64 * c, r = lane & 31, hk = lane >> 5;
    bf16x8 af[4][4]; f32x4 wv[4][4];
#pragma unroll
    for (int rt = 0; rt < 4; ++rt) {
        const int tq = t0 + 8 * wave + 2 * rt + ((r >> 2) & 1), hh = (r & 3) + 4 * (r >> 3);
#pragma unroll
        for (int ks = 0; ks < 4; ++ks) af[rt][ks] = *(const GAS bf16x8*)(IQ + (size_t)tq * 1024 + hh * 64 + 16 * ks + 8 * hk);
        const int tw = t0 + 8 * wave + 2 * rt + hk;
#pragma unroll
        for (int q4 = 0; q4 < 4; ++q4) wv[rt][q4] = *(const GAS f32x4*)(IW + (size_t)tw * 16 + 4 * q4);
    }
#pragma unroll
    for (int rt = 0; rt < 4; ++rt)
#pragma unroll
        for (int ks = 0; ks < 4; ++ks) { asm volatile("" :: "v"(af[rt][ks])); asm volatile("" :: "v"(wv[rt][ks])); }
#ifdef TS_A
    if (blockIdx.x == 0 && wave == 0 && c == 31) { const unsigned t_ = (unsigned)__builtin_amdgcn_s_memrealtime(); if (lane == 0) ((volatile LAS unsigned*)(lds + MISC_OFF))[16 + 13] = t_; }
#endif
    const int skey = tid >> 3, sch = tid & 7;
    const bf16* src = IK + ((size_t)b * SEQ + skey) * 64 + sch * 8;
    const int sdst = skey * 144 + sch * 16;
    const int nrow = 64 * (c + 1);
    float* scrow = SC + sc_base(b, c);
    { const v4u t = *(const GAS v4u*)(src + (size_t)k0 * 64 * 64); *(LAS v4u*)(lds + sdst) = t; }
    __syncthreads();
    for (int kt = k0; kt < k1; ++kt) {
        const int cur = (kt - k0) & 1; v4u nx = {0u, 0u, 0u, 0u};
        if (kt + 1 < k1) nx = *(const GAS v4u*)(src + (size_t)(kt + 1) * 64 * 64);
        const LAS unsigned char* kb = lds + cur * 9216;
#pragma unroll
        for (int kh = 0; kh < 2; ++kh) {
            bf16x8 bfr[4];
#pragma unroll
            for (int ks = 0; ks < 4; ++ks) bfr[ks] = *(const LAS bf16x8*)(kb + (32 * kh + r) * 144 + (16 * ks + 8 * hk) * 2);
#pragma unroll
            for (int rt = 0; rt < 4; ++rt) {
                f32x16 cc;
#pragma unroll
                for (int e = 0; e < 16; ++e) cc[e] = 0.f;
#pragma unroll
                for (int ks = 0; ks < 4; ++ks) cc = __builtin_amdgcn_mfma_f32_32x32x16_bf16(af[rt][ks], bfr[ks], cc, 0, 0, 0);
                float s = 0.f;
#pragma unroll
                for (int e = 0; e < 16; ++e) s += wv[rt][e >> 2][e & 3] * fmaxf(cc[e], 0.f);
                scrow[(size_t)(8 * wave + 2 * rt + hk) * nrow + 64 * kt + 32 * kh + r] = s;
            }
        }
        if (kt + 1 < k1) *(LAS v4u*)(lds + (cur ^ 1) * 9216 + sdst) = nx;
        __syncthreads();
#ifdef TS_A
        if (blockIdx.x == 0 && wave == 0 && c == 31 && kt == k0 + 7) { const unsigned t_ = (unsigned)__builtin_amdgcn_s_memrealtime(); if (lane == 0) ((volatile LAS unsigned*)(lds + MISC_OFF))[16 + 14] = t_; }
#endif
    }
#ifdef TS_A
    if (blockIdx.x == 0 && wave == 0 && c == 31) { const unsigned t_ = (unsigned)__builtin_amdgcn_s_memrealtime(); if (lane == 0) ((volatile LAS unsigned*)(lds + MISC_OFF))[16 + 15] = t_; }
#endif
}
__device__ __forceinline__ void p2_indexer(unsigned char* ws, LAS unsigned char* lds, int bx, int G, int wave, int lane) {
    const int tid = wave * 64 + lane;
    for (int i = bx; i < 256; i += G) {
        const int p = i >> 1, b = p >> 4, c = p & 15;
        if ((i & 1) == 0) { idx_segment(ws, lds, b, c, 0, c + 1, wave, lane, tid); idx_segment(ws, lds, b, 31 - c, 0, 16 - c, wave, lane, tid); }
        else idx_segment(ws, lds, b, 31 - c, 16 - c, 32 - c, wave, lane, tid);
    }
}

__device__ __forceinline__ unsigned or16(unsigned x) { unsigned a = x, b = x; asm volatile("s_nop 1\n\tv_permlane16_swap_b32 %0, %1\n\ts_nop 1" : "+v"(a), "+v"(b)); return a | b; }
__device__ __forceinline__ unsigned or32(unsigned x) { unsigned a = x, b = x; asm volatile("s_nop 1\n\tv_permlane32_swap_b32 %0, %1\n\ts_nop 1" : "+v"(a), "+v"(b)); return a | b; }
__device__ __forceinline__ void p3_select(unsigned char* ws, LAS unsigned char* lds, int vcu, int G, int wave, int lane_in) {
    const float* SC = (const float*)(ws + WS_SC); unsigned* MB = (unsigned*)(ws + WS_MB);
    LAS unsigned* hist = (LAS unsigned*)(lds + wave * 16384);
    const int gw = vcu * NWAVES + wave, NGW = G * NWAVES;
    for (int mi = gw; mi < M; mi += NGW) {
        int lane = lane_in; asm volatile("" : "+v"(lane));
        const int m = (mi & ~2047) | ((mi + 331 * (mi >> 11)) & 2047);
        const int b = m >> 11, c = (m & 2047) >> 6, qi = m & 63, n = 64 * (c + 1), nw = n >> 5;
        if (n <= 256) { MB[(size_t)m * 64 + lane] = lane < nw ? 0xffffffffu : 0u; continue; }
        unsigned key[32];
        const float* row = SC + sc_base(b, c) + (size_t)qi * n + lane * 32;
        const bool act = lane < nw;
#pragma unroll
        for (int q = 0; q < 8; ++q) { f32x4 t = {0.f, 0.f, 0.f, 0.f}; if (act) t = *(const GAS f32x4*)(row + 4 * q);
#pragma unroll
            for (int e = 0; e < 4; ++e) { const unsigned u = __builtin_bit_cast(unsigned, t[e] + 0.0f); key[4 * q + e] = u ^ ((u >> 31) ? 0xffffffffu : 0x80000000u); } }
        const int hbase = (lane & 3) * 256, hdummy = 1024 + lane;
        unsigned prefix = 0u; int k = 256, eqtot = 0, shift = 24;
#pragma unroll 1
        for (int pass = 0; pass < 4; ++pass) {
            shift = 24 - 8 * pass;
#pragma unroll
            for (int cp = 0; cp < 4; ++cp) *(LAS v4u*)(hist + cp * 256 + 4 * lane) = (v4u){0u, 0u, 0u, 0u};
            LDS_WAIT(); asm volatile("" ::: "memory");
            const unsigned hmask = pass == 0 ? 0u : (0xffffffffu << (shift + 8));
#pragma unroll
            for (int i = 0; i < 32; ++i) { const bool mt = act && (((key[i] ^ prefix) & hmask) == 0u); const int ad = mt ? hbase + (int)((key[i] >> shift) & 255u) : hdummy;
                __hip_atomic_fetch_add(hist + ad, 1u, __ATOMIC_RELAXED, __HIP_MEMORY_SCOPE_WORKGROUP); }
            LDS_WAIT(); asm volatile("" ::: "memory");
            v4u h = *(const LAS v4u*)(hist + 4 * lane);
#pragma unroll
            for (int cp = 1; cp < 4; ++cp) h += *(const LAS v4u*)(hist + cp * 256 + 4 * lane);
            const int t = (int)(h.x + h.y + h.z + h.w);
            int x = t;
            x += __builtin_amdgcn_update_dpp(0, x, 0x111, 0xf, 0xf, true); x += __builtin_amdgcn_update_dpp(0, x, 0x112, 0xf, 0xf, true);
            x += __builtin_amdgcn_update_dpp(0, x, 0x114, 0xf, 0xf, true); x += __builtin_amdgcn_update_dpp(0, x, 0x118, 0xf, 0xf, true);
            const int r0 = __builtin_amdgcn_readlane(x, 15), r1 = __builtin_amdgcn_readlane(x, 31), r2 = __builtin_amdgcn_readlane(x, 47), r3 = __builtin_amdgcn_readlane(x, 63);
            const int rw = lane >> 4, rbase = rw == 0 ? 0 : rw == 1 ? r0 : rw == 2 ? r0 + r1 : r0 + r1 + r2, total = r0 + r1 + r2 + r3;
            const int incl = total - (x + rbase - t);
            const int above = incl - t;
            const bool mine = (above < k) && (k <= incl);
            const int c3 = above + (int)h.w, c2 = c3 + (int)h.z, c1 = c2 + (int)h.y;
            int digit, knew, eqc;
            if (k <= c3) { digit = 4 * lane + 3; knew = k - above; eqc = (int)h.w; }
            else if (k <= c2) { digit = 4 * lane + 2; knew = k - c3; eqc = (int)h.z; }
            else if (k <= c1) { digit = 4 * lane + 1; knew = k - c2; eqc = (int)h.y; }
            else { digit = 4 * lane; knew = k - c1; eqc = (int)h.x; }
            const unsigned long long bm = __ballot(mine);
            const int src = __builtin_ctzll(bm);
            digit = __builtin_amdgcn_readlane(digit, src); k = __builtin_amdgcn_readlane(knew, src); eqtot = __builtin_amdgcn_readlane(eqc, src);
            prefix |= (unsigned)digit << shift;
            if (k == eqtot) break;
        }
        unsigned word = 0u;
        if (eqtot == k) {
            const unsigned pf = prefix >> shift;
#pragma unroll
            for (int i = 0; i < 32; ++i) word |= ((key[i] >> shift) >= pf) ? (1u << i) : 0u;
        } else {
            int below = 0;
#pragma unroll
            for (int i = 0; i < 32; ++i) { const unsigned long long em = __ballot(act && key[i] == prefix);
                below += (int)__builtin_amdgcn_mbcnt_hi((unsigned)(em >> 32), __builtin_amdgcn_mbcnt_lo((unsigned)em, 0u)); }
            int rk = below;
#pragma unroll
            for (int i = 0; i < 32; ++i) { const bool e = key[i] == prefix; const bool sel = (key[i] > prefix) || (e && rk < k); rk += e ? 1 : 0; word |= sel ? (1u << i) : 0u; }
        }
        MB[(size_t)m * 64 + lane] = act ? word : 0u;
    }
}

template <bool DSA> struct AttnCfg {
    static constexpr int DQK = DSA ? 128 : 192, NKB = DQK / 64, KSTR = DQK + 16, KBUF = 64 * KSTR, VSTR = 80, VBUF = 128 * VSTR, BUF = KBUF + VBUF;
};
template <bool DSA>
__device__ __forceinline__ void attn_unit(unsigned char* ws, LAS unsigned char* lds, int b, int hh  , int blk  , int wave, int lane, int tid) {
    typedef AttnCfg<DSA> C;
    const int r = lane & 31, hk = lane >> 5;
    const int head = DSA ? 4 * hh + (wave >> 1) : hh;
    const int tok0 = DSA ? b * SEQ + 64 * blk + 32 * (wave & 1) : b * SEQ + 256 * blk + 32 * wave;
    const int ntw = DSA ? blk + 1 : 4 * blk + (wave >> 1) + 1;
    const int ntb = DSA ? blk + 1 : 4 * blk + 4;
    const unsigned char* Qp = DSA ? ws + WS_DQ + (size_t)(tok0 + r) * 1024 + head * 128 : ws + WS_Q + (size_t)(tok0 + r) * 1536 + head * 192;
    v8i_t qf[C::NKB];
#pragma unroll
    for (int kb = 0; kb < C::NKB; ++kb) { const v4i_t lo = *(const GAS v4i_t*)(Qp + 64 * kb + 32 * hk), hi = *(const GAS v4i_t*)(Qp + 64 * kb + 32 * hk + 16); qf[kb] = (v8i_t){lo.x, lo.y, lo.z, lo.w, hi.x, hi.y, hi.z, hi.w}; }
    int sclK = 0x7f7f7f7f, sclQ = 0x7b7b7b7b, sclP = 0x7a7a7a7a; asm volatile("" : "+v"(sclK), "+v"(sclQ), "+v"(sclP));
    const int skey = tid >> 3, sub = tid & 7;
    const unsigned char* ksrc0 = DSA ? ws + WS_DK + ((size_t)b * SEQ + skey) * 256 + hh * 128 + sub * 16 : ws + WS_KN + ((size_t)b * SEQ + skey) * 1024 + hh * 128 + sub * 16;
    const unsigned char* ksrc2 = ws + WS_KR + ((size_t)b * SEQ + skey) * 64 + (sub & 3) * 16;
    const int kdst = skey * C::KSTR + sub * 16, kdst2 = skey * C::KSTR + 128 + (sub & 3) * 16;
    constexpr int KADV0 = DSA ? 64 * 256 : 64 * 1024, KADV2 = 64 * 64;
    const unsigned char* vsrc = (DSA ? ws + WS_DVT : ws + WS_VT) + (size_t)(hh * 128 + (tid >> 2)) * M + (size_t)b * SEQ + (tid & 3) * 16;
    const int vdst = C::KBUF + (tid >> 2) * C::VSTR + (tid & 3) * 16;
    v4u kreg[2], vreg[1];
#define ATT_LOAD(kt_) do { kreg[0] = *(const GAS v4u*)(ksrc0 + (size_t)(kt_) * KADV0); \
        if (!DSA) { if (sub < 4) kreg[1] = *(const GAS v4u*)(ksrc2 + (size_t)(kt_) * KADV2); } \
        vreg[0] = *(const GAS v4u*)(vsrc + (size_t)(kt_) * 64); } while (0)
#define ATT_STORE(buf_) do { LAS unsigned char* bb_ = lds + (buf_) * C::BUF; *(LAS v4u*)(bb_ + kdst) = kreg[0]; \
        if (!DSA) { if (sub < 4) *(LAS v4u*)(bb_ + kdst2) = kreg[1]; } \
        *(LAS v4u*)(bb_ + vdst) = vreg[0]; } while (0)
    kreg[1] = (v4u){0u, 0u, 0u, 0u};
    ATT_LOAD(0); ATT_STORE(0);
#pragma unroll
    for (int kb = 0; kb < C::NKB; ++kb) asm volatile("" :: "v"(qf[kb]));
    __syncthreads();
    f32x16 o[4];
#pragma unroll
    for (int dt = 0; dt < 4; ++dt)
#pragma unroll
        for (int e = 0; e < 16; ++e) o[dt][e] = 0.f;
    float mrun = -1e30f, lrun = 0.f;
    const unsigned long long* mbp = (const unsigned long long*)((const unsigned*)(ws + WS_MB) + (size_t)(tok0 + r) * 64);
    for (int kt = 0; kt < ntb; ++kt) {
        const int cur = kt & 1;
        if (kt + 1 < ntb) ATT_LOAD(kt + 1);
        if (kt < ntw) {
            const LAS unsigned char* kb_ = lds + cur * C::BUF; const LAS unsigned char* vb = kb_ + C::KBUF;
            unsigned long long mw = 0ull; if (DSA) mw = mbp[kt];
            f32x16 st[2];
#pragma unroll
            for (int kh = 0; kh < 2; ++kh)
#pragma unroll
                for (int kb = 0; kb < C::NKB; ++kb) { const LAS unsigned char* kp = kb_ + (32 * kh + r) * C::KSTR + 64 * kb + 32 * hk;
                    const v4i_t lo = *(const LAS v4i_t*)kp, hi = *(const LAS v4i_t*)(kp + 16); const v8i_t kf = {lo.x, lo.y, lo.z, lo.w, hi.x, hi.y, hi.z, hi.w};
                    if (kb == 0) asm volatile("v_mfma_scale_f32_32x32x64_f8f6f4 %0, %1, %2, 0, %3, %4 op_sel_hi:[0,0,0]" : "=&v"(st[kh]) : "v"(kf), "v"(qf[kb]), "v"(sclK), "v"(sclQ));
                    else asm volatile("v_mfma_scale_f32_32x32x64_f8f6f4 %0, %1, %2, %0, %3, %4 op_sel_hi:[0,0,0]" : "+v"(st[kh]) : "v"(kf), "v"(qf[kb]), "v"(sclK), "v"(sclQ)); }
            asm volatile("s_nop 15\n\ts_nop 7" : "+v"(st[0]), "+v"(st[1]));
            if (DSA) {
#pragma unroll
                for (int kh = 0; kh < 2; ++kh) { const unsigned wk = (kh ? (unsigned)(mw >> 32) : (unsigned)mw) >> (4 * hk);
#pragma unroll
                    for (int e = 0; e < 16; ++e) { const int cb = (e & 3) + 8 * (e >> 2); st[kh][e] = ((wk >> cb) & 1u) ? st[kh][e] : -__builtin_inff(); } }
            }
            float mx = st[0][0];
#pragma unroll
            for (int e = 1; e < 16; ++e) mx = fmaxf(mx, st[0][e]);
#pragma unroll
            for (int e = 0; e < 16; ++e) mx = fmaxf(mx, st[1][e]);
            mx = xor32_max(mx);
            if (__any(mx > mrun + 3.0f)) {
                const float mnew = fmaxf(mrun, mx), alpha = __builtin_amdgcn_exp2f(mrun - mnew);
                mrun = mnew; lrun *= alpha;
#pragma unroll
                for (int dt = 0; dt < 4; ++dt)
#pragma unroll
                    for (int e = 0; e < 16; ++e) o[dt][e] *= alpha;
            }
            const float mnew8 = mrun - 5.0f;
            float ps;
            {
                typedef float f32x2q __attribute__((ext_vector_type(2)));
                const f32x2q m2 = {mnew8, mnew8};
                f32x2q s2 = {0.f, 0.f};
#pragma unroll
                for (int kh = 0; kh < 2; ++kh)
#pragma unroll
                    for (int e = 0; e < 16; e += 2) { const f32x2q d = (f32x2q){st[kh][e], st[kh][e + 1]} - m2;
                        const f32x2q pq = {__builtin_amdgcn_exp2f(d.x), __builtin_amdgcn_exp2f(d.y)};
                        st[kh][e] = pq.x; st[kh][e + 1] = pq.y; s2 += pq; }
                ps = s2.x + s2.y;
            }
            ps = xor32_sum(ps);
            lrun += ps;
            v8i_t pf;
#pragma unroll
            for (int j = 0; j < 8; ++j) { const int kh = j >> 2, e0 = 4 * (j & 3);
                int w = __builtin_amdgcn_cvt_pk_fp8_f32(st[kh][e0], st[kh][e0 + 1], 0, false); w = __builtin_amdgcn_cvt_pk_fp8_f32(st[kh][e0 + 2], st[kh][e0 + 3], w, true); pf[j] = w; }
            asm volatile("s_nop 3" : "+v"(pf), "+v"(o[0]), "+v"(o[1]), "+v"(o[2]), "+v"(o[3]));
#pragma unroll
            for (int dt = 0; dt < 4; ++dt) { const LAS unsigned char* vp = vb + (32 * dt + r) * C::VSTR + 32 * hk;
                const v4i_t lo = *(const LAS v4i_t*)vp, hi = *(const LAS v4i_t*)(vp + 16); const v8i_t vf = {lo.x, lo.y, lo.z, lo.w, hi.x, hi.y, hi.z, hi.w};
                asm volatile("v_mfma_scale_f32_32x32x64_f8f6f4 %0, %1, %2, %0, %3, %4 op_sel_hi:[0,0,0]" : "+v"(o[dt]) : "v"(vf), "v"(pf), "v"(sclK), "v"(sclP)); }
        }
        if (kt + 1 < ntb) ATT_STORE(cur ^ 1);
        __syncthreads();
    }
    asm volatile("s_nop 15\n\ts_nop 7" : "+v"(o[0]), "+v"(o[1]), "+v"(o[2]), "+v"(o[3]));
    __builtin_amdgcn_sched_barrier(0);
    const float inv = 512.0f / lrun;
    unsigned char* Op = ws + (DSA ? WS_OB : WS_OA) + (size_t)(tok0 + r) * 1024 + head * 128 + 4 * hk;
#pragma unroll
    for (int dt = 0; dt < 4; ++dt)
#pragma unroll
        for (int g = 0; g < 4; ++g) { int p0 = __builtin_amdgcn_cvt_pk_fp8_f32(o[dt][4 * g] * inv, o[dt][4 * g + 1] * inv, 0, false); p0 = __builtin_amdgcn_cvt_pk_fp8_f32(o[dt][4 * g + 2] * inv, o[dt][4 * g + 3] * inv, p0, true);
            *(GAS unsigned*)(Op + 32 * dt + 8 * g) = (unsigned)p0; }
}
#undef ATT_LOAD
#undef ATT_STORE
__device__ __forceinline__ void p4_attention(unsigned char* ws, LAS unsigned char* lds, int bx, int G, int wave, int lane) {
    const int tid = wave * 64 + lane;
    for (int i = bx; i < 256; i += G) {
        const int xcd = i & 7, idx = i >> 3;
#ifndef NO_MLA
        { const int bh = (idx >> 2) * 8 + xcd, qp = idx & 3, b = bh >> 3, h = bh & 7;
          attn_unit<false>(ws, lds, b, h, 7 - qp, wave, lane, tid); attn_unit<false>(ws, lds, b, h, qp, wave, lane, tid); }
#endif
#ifndef NO_DSA
        { const int bg = (idx >> 4) * 8 + xcd, cp = idx & 15, b = bg >> 1, g = bg & 1;
          attn_unit<true>(ws, lds, b, g, 31 - cp, wave, lane, tid); attn_unit<true>(ws, lds, b, g, cp, wave, lane, tid); }
#endif
    }
}
typedef __bf16 bf16x2_t __attribute__((ext_vector_type(2)));
__device__ __forceinline__ float dot2bf(unsigned w, unsigned x, float acc) { return __builtin_amdgcn_fdot2_f32_bf16(__builtin_bit_cast(bf16x2_t, w), __builtin_bit_cast(bf16x2_t, x), acc, false); }
#ifndef P8_BATCH
#define P8_BATCH 1
#endif
typedef float f32x2v __attribute__((ext_vector_type(2)));
typedef float v16f __attribute__((ext_vector_type(16)));
typedef float v32f __attribute__((ext_vector_type(32)));
typedef unsigned v6u __attribute__((ext_vector_type(6)));
#ifdef V_FP4
typedef unsigned p8vb_t;
#else
typedef v2u p8vb_t;
#endif
#define P8_DECL(n) v4u ua##n[P8_BATCH], va##n[P8_BATCH]; v2u ub##n[P8_BATCH]; p8vb_t vb##n[P8_BATCH]; float su##n[P8_BATCH], sv##n[P8_BATCH], gg##n[P8_BATCH]
#define P8_ARGS(n) ua##n, va##n, ub##n, vb##n, su##n, sv##n, gg##n
__device__ __forceinline__ void p8_load(v4u (&s_ua)[P8_BATCH], v4u (&s_va)[P8_BATCH], v2u (&s_ub)[P8_BATCH], p8vb_t (&s_vb)[P8_BATCH], float (&s_su)[P8_BATCH], float (&s_sv)[P8_BATCH], float (&s_g)[P8_BATCH], const unsigned char* U6, const unsigned char* V6, const float* USC, const float* VSC, const LAS int* EXi, const LAS float* EXg, int e0, int lane) {
#pragma unroll
    for (int q = 0; q < P8_BATCH; ++q) {
        const int ex = __builtin_amdgcn_readfirstlane(EXi[e0 + q]); s_g[q] = __builtin_bit_cast(float, __builtin_amdgcn_readfirstlane(__builtin_bit_cast(int, EXg[e0 + q])));
        const unsigned char* up = U6 + (size_t)ex * EROW; asm("" : "+s"(up));
        const unsigned char* vp = up + 1536; (void)V6;
        const unsigned ul = (unsigned)lane;
        s_ua[q] = *(const GAS v4u*)(up + (size_t)(ul * 16u)); s_ub[q] = *(const GAS v2u*)(up + 1024 + (size_t)(ul * 8u));
#ifdef V_FP4
        s_va[q] = *(const GAS v4u*)(vp + (size_t)(ul * 16u)); s_vb[q] = (unsigned)*(const GAS unsigned short*)(vp + 1024 + (size_t)(ul * 2u));
        s_su[q] = USC[ex]; s_sv[q] = 1.0f; (void)VSC;
#else
        s_va[q] = *(const GAS v4u*)(vp + lane * 16); s_vb[q] = *(const GAS v2u*)(vp + 1024 + lane * 8);
        s_su[q] = USC[ex]; s_sv[q] = VSC[ex];
#endif
    }
}
__device__ __forceinline__ void p8_compute(const v4u (&s_ua)[P8_BATCH], const v4u (&s_va)[P8_BATCH], const v2u (&s_ub)[P8_BATCH], const p8vb_t (&s_vb)[P8_BATCH], const float (&s_su)[P8_BATCH], const float (&s_sv)[P8_BATCH], const float (&s_g)[P8_BATCH], const LAS f32x4* xnl  , float (&acc)[32]) {
#pragma unroll
    for (int q = 0; q < P8_BATCH; ++q) {
        float z;
        { const v6u pu = {s_ua[q].x, s_ua[q].y, s_ua[q].z, s_ua[q].w, s_ub[q].x, s_ub[q].y};
          const v32f ru = __builtin_amdgcn_cvt_scalef32_pk32_f32_fp6(pu, 1.0f);
          f32x2v d0 = {0.f, 0.f}, d1 = {0.f, 0.f};
#pragma unroll
          for (int c = 0; c < 8; ++c) { const f32x4 x = xnl[c * 64];
              d0 += (f32x2v){ru[4 * c], ru[4 * c + 1]} * (f32x2v){x.x, x.y}; d1 += (f32x2v){ru[4 * c + 2], ru[4 * c + 3]} * (f32x2v){x.z, x.w}; }
          z = wave_sum_uniform((d0.x + d0.y) + (d1.x + d1.y)) * s_su[q]; }
        const float coef = s_g[q] * s_sv[q] * gelu_as(z);
#ifdef V_FP4
        const float cb = coef * __builtin_bit_cast(float, s_vb[q] << 16);
#pragma unroll
        for (int d = 0; d < 4; ++d) {
            const f32x2v f0 = __builtin_amdgcn_cvt_scalef32_pk_f32_fp4(s_va[q][d], 1.0f, 0), f1 = __builtin_amdgcn_cvt_scalef32_pk_f32_fp4(s_va[q][d], 1.0f, 1);
            const f32x2v f2 = __builtin_amdgcn_cvt_scalef32_pk_f32_fp4(s_va[q][d], 1.0f, 2), f3 = __builtin_amdgcn_cvt_scalef32_pk_f32_fp4(s_va[q][d], 1.0f, 3);
            acc[8 * d] += cb * f0.x; acc[8 * d + 1] += cb * f0.y; acc[8 * d + 2] += cb * f1.x; acc[8 * d + 3] += cb * f1.y;
            acc[8 * d + 4] += cb * f2.x; acc[8 * d + 5] += cb * f2.y; acc[8 * d + 6] += cb * f3.x; acc[8 * d + 7] += cb * f3.y; }
#else
        const v6u pv = {s_va[q].x, s_va[q].y, s_va[q].z, s_va[q].w, s_vb[q].x, s_vb[q].y};
        const v32f rv = __builtin_amdgcn_cvt_scalef32_pk32_f32_fp6(pv, 1.0f);
#pragma unroll
        for (int j = 0; j < 32; ++j) acc[j] += coef * rv[j];
#endif
    }
}
__device__ __forceinline__ void p8_req_u(v4u& ua, v2u& ub, const unsigned char* U6, const LAS int* EXi, int e, int lane) {
    const int ex = __builtin_amdgcn_readfirstlane(EXi[e]);
    const unsigned char* up = U6 + (size_t)ex * EROW; asm("" : "+s"(up));
    const unsigned ul = (unsigned)lane;
    ua = *(const GAS v4u*)(up + (size_t)(ul * 16u)); ub = *(const GAS v2u*)(up + 1024 + (size_t)(ul * 8u));
}
__device__ __forceinline__ void p8_req_v(v4u& va, unsigned& vb, float& su, float& gg, const unsigned char* U6, const float* USC, const LAS int* EXi, const LAS float* EXg, int e, int lane) {
    const int ex = __builtin_amdgcn_readfirstlane(EXi[e]); gg = __builtin_bit_cast(float, __builtin_amdgcn_readfirstlane(__builtin_bit_cast(int, EXg[e])));
    const unsigned char* vp = U6 + (size_t)ex * EROW + 1536; asm("" : "+s"(vp));
    const unsigned ul = (unsigned)lane;
    va = *(const GAS v4u*)(vp + (size_t)(ul * 16u)); vb = (unsigned)*(const GAS unsigned short*)(vp + 1024 + (size_t)(ul * 2u));
    su = USC[ex];
}
__device__ __forceinline__ void p8_req_u_id(v4u& ua, v2u& ub, const unsigned char* U6, int ex_, int lane) {
    const int ex = __builtin_amdgcn_readfirstlane(ex_);
    const unsigned char* up = U6 + (size_t)ex * EROW; asm("" : "+s"(up));
    const unsigned ul = (unsigned)lane;
    ua = *(const GAS v4u*)(up + (size_t)(ul * 16u)); ub = *(const GAS v2u*)(up + 1024 + (size_t)(ul * 8u));
}
__device__ __forceinline__ void p8_req_v_id(v4u& va, unsigned& vb, float& su, float& gg, const unsigned char* U6, const float* USC, int ex_, float g_, int lane) {
    const int ex = __builtin_amdgcn_readfirstlane(ex_); gg = __builtin_bit_cast(float, __builtin_amdgcn_readfirstlane(__float_as_int(g_)));
    const unsigned char* vp = U6 + (size_t)ex * EROW + 1536; asm("" : "+s"(vp));
    const unsigned ul = (unsigned)lane;
    va = *(const GAS v4u*)(vp + (size_t)(ul * 16u)); vb = (unsigned)*(const GAS unsigned short*)(vp + 1024 + (size_t)(ul * 2u));
    su = USC[ex];
}
__device__ __forceinline__ float p8_udot(const v4u& ua, const v2u& ub, const LAS f32x4* xnl  ) {
    const v6u pu = {ua.x, ua.y, ua.z, ua.w, ub.x, ub.y};
    const v32f ru = __builtin_amdgcn_cvt_scalef32_pk32_f32_fp6(pu, 1.0f);
    f32x2v d0 = {0.f, 0.f}, d1 = {0.f, 0.f};
#pragma unroll
    for (int c = 0; c < 8; ++c) { const f32x4 x = xnl[c * 64];
        d0 += (f32x2v){ru[4 * c], ru[4 * c + 1]} * (f32x2v){x.x, x.y}; d1 += (f32x2v){ru[4 * c + 2], ru[4 * c + 3]} * (f32x2v){x.z, x.w}; }
    return (d0.x + d0.y) + (d1.x + d1.y);
}
__device__ __forceinline__ void p8_udot2(const v4u& uaA, const v2u& ubA, const v4u& uaB, const v2u& ubB, const LAS f32x4* xnl, float& pA, float& pB) {
    const v6u pa = {uaA.x, uaA.y, uaA.z, uaA.w, ubA.x, ubA.y}, pb = {uaB.x, uaB.y, uaB.z, uaB.w, ubB.x, ubB.y};
    const v32f ra = __builtin_amdgcn_cvt_scalef32_pk32_f32_fp6(pa, 1.0f), rb = __builtin_amdgcn_cvt_scalef32_pk32_f32_fp6(pb, 1.0f);
    f32x2v a0 = {0.f, 0.f}, a1 = {0.f, 0.f}, b0 = {0.f, 0.f}, b1 = {0.f, 0.f};
#pragma unroll
    for (int c = 0; c < 8; ++c) { const f32x4 x = xnl[c * 64]; const f32x2v xl = {x.x, x.y}, xh = {x.z, x.w};
        a0 += (f32x2v){ra[4 * c], ra[4 * c + 1]} * xl; a1 += (f32x2v){ra[4 * c + 2], ra[4 * c + 3]} * xh;
        b0 += (f32x2v){rb[4 * c], rb[4 * c + 1]} * xl; b1 += (f32x2v){rb[4 * c + 2], rb[4 * c + 3]} * xh; }
    pA = (a0.x + a0.y) + (a1.x + a1.y); pB = (b0.x + b0.y) + (b1.x + b1.y);
}
__device__ __forceinline__ void p8_vpart(const v4u& va, unsigned vb, float cg  , float (&acc)[32]) {
    const float cb = cg * __builtin_bit_cast(float, vb << 16);
#pragma unroll
    for (int d = 0; d < 4; ++d) {
        const f32x2v f0 = __builtin_amdgcn_cvt_scalef32_pk_f32_fp4(va[d], 1.0f, 0), f1 = __builtin_amdgcn_cvt_scalef32_pk_f32_fp4(va[d], 1.0f, 1);
        const f32x2v f2 = __builtin_amdgcn_cvt_scalef32_pk_f32_fp4(va[d], 1.0f, 2), f3 = __builtin_amdgcn_cvt_scalef32_pk_f32_fp4(va[d], 1.0f, 3);
        acc[8 * d] += cb * f0.x; acc[8 * d + 1] += cb * f0.y; acc[8 * d + 2] += cb * f1.x; acc[8 * d + 3] += cb * f1.y;
        acc[8 * d + 4] += cb * f2.x; acc[8 * d + 5] += cb * f2.y; acc[8 * d + 6] += cb * f3.x; acc[8 * d + 7] += cb * f3.y; }
}
__device__ __forceinline__ float p8_reduce4(float p0, float p1, float p2, float p3, int lane) {
    const bool b0 = (lane & 1) != 0, b1 = (lane & 2) != 0;
    const float a = b0 ? p1 : p0, as = b0 ? p0 : p1, c = b0 ? p3 : p2, cs = b0 ? p2 : p3;
    const float A = a + dpp_f<0xB1>(as), C = c + dpp_f<0xB1>(cs);
    const float r = b1 ? C : A, rs = b1 ? A : C;
    float R = r + dpp_f<0x4E>(rs);
    R += dpp_f<0x124>(R); R += dpp_f<0x128>(R);
    { float a = R, b = R; asm("s_nop 1\n\tv_permlane16_swap_b32 %0, %1\n\ts_nop 1" : "+v"(a), "+v"(b)); R = a + b; }
    { float a = R, b = R; asm("s_nop 1\n\tv_permlane32_swap_b32 %0, %1\n\ts_nop 1" : "+v"(a), "+v"(b)); R = a + b; }
    return R;
}
__device__ __forceinline__ float p8_rdl(float v, int l) { return __builtin_bit_cast(float, __builtin_amdgcn_readlane(__builtin_bit_cast(int, v), l)); }
__device__ __forceinline__ float fp6_probe(int i) { return i < 8 ? 0.125f * i : i < 16 ? 1.0f + 0.125f * (i - 8) : i < 24 ? 2.0f + 0.25f * (i - 16) : 4.0f + 0.5f * (i - 24); }
__device__ __forceinline__ void p8_peer(const Args& a, LAS unsigned char* lds, int vcu, int G, int wave, int lane_in) {
    unsigned char* ws = a.ws;
    const unsigned char* U6 = ws + WS_U; const unsigned char* V6 = ws + WS_V; const float* USC = (const float*)(ws + WS_USC); const float* VSC = (const float*)(ws + WS_VSC); const float* S = (const float*)(ws + WS_S);
    LAS unsigned char* L = lds + wave * 16384;
    LAS float* T1v = (LAS float*)(L);
    LAS int*   T1i = (LAS int*)(L + 1024);
    LAS int*   OFF = (LAS int*)(L + 3072);
    LAS int*   INV = (LAS int*)(L + 3392);
    LAS int*   SIG = (LAS int*)(L + 3200);
#define P8_EXG(b) ((LAS float*)(L + ((b) ? 12288 : 2048)))
#define P8_EXI(b) ((LAS int*)(L + ((b) ? 12800 : 2560)))
    const int gw = vcu * NWAVES + wave, NGW = G * NWAVES;
    const float NINF = -__builtin_inff();
    {
        v16f pa, pb;
#pragma unroll
        for (int i = 0; i < 16; ++i) { pa[i] = fp6_probe(i); pb[i] = fp6_probe(16 + i); }
        asm volatile("" : "+v"(pa), "+v"(pb));
        const v6u pp = __builtin_amdgcn_cvt_scalef32_2xpk16_fp6_f32(pa, pb, 1.0f);
        const v32f pr = __builtin_amdgcn_cvt_scalef32_pk32_f32_fp6(pp, 1.0f);
#pragma unroll
        for (int j = 0; j < 32; ++j) { const float v = pr[j]; const int sg = v < 1.f ? (int)(v * 8.f) : v < 2.f ? 8 + (int)((v - 1.f) * 8.f) : v < 4.f ? 16 + (int)((v - 2.f) * 4.f) : 24 + (int)((v - 4.f) * 2.f);
            if (lane_in == 0) { SIG[j] = sg; OFF[j] = (sg >> 2) * 256 + (sg & 3); INV[sg] = j; } }
        LDS_WAIT(); asm volatile("" ::: "memory");
    }
#define P8_LANE_VARS int lane = lane_id(); const int qb = (lane & 7) * 16, hh2 = lane >> 3, ee2 = lane & 7; LAS f32x4* xnl = (LAS f32x4*)(L + 4096) + lane;
#define P8_RSTD(mm, dst) do { const bf16* xr_ = (const bf16*)(ws + WS_X1B) + (size_t)(mm) * D; float ss_ = 0.f; \
        _Pragma("unroll") for (int q = 0; q < 8; ++q) { const v2u w = *(const GAS v2u*)(xr_ + q * 256 + lane * 4); const float x0 = bflo(w.x), x1 = bfhi(w.x), x2_ = bflo(w.y), x3 = bfhi(w.y); ss_ += (x0 * x0 + x1 * x1) + (x2_ * x2_ + x3 * x3); } \
        dst = 1.0f / sqrtf(wave_sum_fast(ss_) * (1.f / D) + EPS); } while (0)
#define P8_S1_LOAD(mm, h) do { _Pragma("unroll") for (int q = 0; q < 4; ++q) { const f32x4 t = *(const GAS f32x4*)(S + (size_t)(mm) * 2048 + (h) * 1024 + lane * 16 + q * 4); sv[4 * q] = t.x; sv[4 * q + 1] = t.y; sv[4 * q + 2] = t.z; sv[4 * q + 3] = t.w; } } while (0)
#define P8_S1_SLICE(h, it) do { float mx = sv[0]; \
        _Pragma("unroll") for (int i = 1; i < 16; ++i) mx = fmaxf(mx, sv[i]); \
        float qm = fmaxf(mx, dpp_f<0xB1>(mx)); qm = fmaxf(qm, dpp_f<0x4E>(qm)); qm = fmaxf(qm, dpp_f<0x141>(qm)); \
        int bi = 1000; \
        _Pragma("unroll") for (int i = 15; i >= 0; --i) bi = (sv[i] == qm) ? (qb + i) : bi; \
        int qi = min(bi, dpp_i<0xB1>(bi)); qi = min(qi, dpp_i<0x4E>(qi)); qi = min(qi, dpp_i<0x141>(qi)); \
        const int li = qi - qb; \
        _Pragma("unroll") for (int i = 0; i < 16; ++i) sv[i] = (i == li) ? NINF : sv[i]; \
        if (ee2 == 0) { T1v[((h) * 8 + hh2) * 16 + (it)] = qm; T1i[((h) * 8 + hh2) * 16 + (it)] = qi; } } while (0)
#define P8_S2_SETUP() do { LDS_WAIT(); asm volatile("" ::: "memory"); \
        const LAS float* s1p = T1v + (2 * hh2) * 16; const LAS float* s2p = T1v + (2 * hh2 + 1) * 16; \
        s1a = s1p[ee2]; kq = 0; ha = s1a + s2p[0]; hb = s1p[ee2 + 8] + s2p[0]; smax = 0.f; den = 0.f; } while (0)
#define P8_S2_SLICE(it, EGn, EIn, rs) do { const LAS float* s2p = T1v + (2 * hh2 + 1) * 16; \
        const float mx = fmaxf(ha, hb); \
        float gm = fmaxf(mx, dpp_f<0xB1>(mx)); gm = fmaxf(gm, dpp_f<0x4E>(gm)); gm = fmaxf(gm, dpp_f<0x141>(gm)); \
        int bp = 100000; \
        bp = (hb == gm) ? ((ee2 + 8) * 16) : bp; \
        bp = (ha == gm) ? (ee2 * 16 + kq) : bp; \
        int gp = min(bp, dpp_i<0xB1>(bp)); gp = min(gp, dpp_i<0x4E>(gp)); gp = min(gp, dpp_i<0x141>(gp)); \
        const bool wa = (gp == ee2 * 16 + kq), wb = (gp == (ee2 + 8) * 16); \
        kq += wa ? 1 : 0; \
        const float nx = ((ee2 + 1) * (kq + 1) <= 16) ? s1a + s2p[kq & 15] : NINF;        \
        ha = wa ? nx : ha; hb = wb ? NINF : hb; \
        if ((it) == 0) smax = gm; \
        const float ex = __expf((gm - smax) * (rs)); den += ex; \
        if (ee2 == 0) { const int r1 = gp >> 4, r2 = gp & 15; (EGn)[hh2 * 16 + (it)] = ex; (EIn)[hh2 * 16 + (it)] = T1i[(2 * hh2) * 16 + r1] * 128 + T1i[(2 * hh2 + 1) * 16 + r2]; } } while (0)
#define P8_S2_FIN(EGn) do { LDS_WAIT(); asm volatile("" ::: "memory"); const float inv = 1.0f / den; (EGn)[hh2 * 16 + 2 * ee2] *= inv; (EGn)[hh2 * 16 + 2 * ee2 + 1] *= inv; LDS_WAIT(); asm volatile("" ::: "memory"); } while (0)
#define P8_XN_BUILD(mm, rs) do { const bf16* xr_ = (const bf16*)(ws + WS_X1B) + (size_t)(mm) * D; \
        _Pragma("unroll") for (int c = 0; c < 8; ++c) { f32x4 t; \
            _Pragma("unroll") for (int e = 0; e < 4; ++e) { const int o = __builtin_amdgcn_readfirstlane(OFF[4 * c + e]); t[e] = __builtin_bit_cast(float, (unsigned)xr_[o + lane * 4] << 16) * (rs) * a.g_ffn[o + lane * 4]; } \
            xnl[c * 64] = t; } \
        LDS_WAIT(); asm volatile("" ::: "memory"); } while (0)
    if (gw >= M) return;
    LAS float* RSN = (LAS float*)(L + 3328);
    {
        P8_LANE_VARS
        float rstd_cur, rstd_nxt = 0.f;
        P8_RSTD(gw, rstd_cur);
        if (gw + NGW < M) P8_RSTD(gw + NGW, rstd_nxt);
        RSN[0] = rstd_nxt;
        float sv[16], s1a = 0.f, ha = 0.f, hb = 0.f, smax = 0.f, den = 0.f; int kq = 0;
        LAS float* EG0 = P8_EXG(0); LAS int* EI0 = P8_EXI(0);
#pragma unroll 1
        for (int h = 0; h < 2; ++h) {
            P8_S1_LOAD(gw, h);
#pragma unroll 1
            for (int it = 0; it < 16; ++it) P8_S1_SLICE(h, it);
        }
        P8_S2_SETUP();
#pragma unroll 1
        for (int it = 0; it < 16; ++it) P8_S2_SLICE(it, EG0, EI0, rstd_cur);
        P8_S2_FIN(EG0);
        P8_XN_BUILD(gw, rstd_cur);
    }
    float acc[32];
#pragma unroll
    for (int j = 0; j < 32; ++j) acc[j] = 0.f;
    v4u ua0, ua1, ua2, ua3; v2u ub0, ub1, ub2, ub3;
    v4u va0, va1, va2, va3; unsigned vb0, vb1, vb2, vb3; float su0, su1, su2, su3, gg0, gg1, gg2, gg3;
#define P8_REQU_L(EI, e, un) p8_req_u(ua##un, ub##un, U6, (EI), (e), lane)
    { const int lane = lane_id(); P8_REQU_L(P8_EXI(0), 0, 0); P8_REQU_L(P8_EXI(0), 1, 1); P8_REQU_L(P8_EXI(0), 2, 2); P8_REQU_L(P8_EXI(0), 3, 3); }
    int buf = 0;
#pragma unroll 1
    for (int m = gw; m < M; m += NGW) {
        const int mn = m + NGW; const bool hn = mn < M;
        LAS float* EGc = P8_EXG(buf); LAS int* EIc = P8_EXI(buf); LAS float* EGn = P8_EXG(buf ^ 1); LAS int* EIn = P8_EXI(buf ^ 1);
        float sv[16];
        if (hn) { const int lane = lane_id(); P8_S1_LOAD(mn, 0); }
        else {
#pragma unroll
            for (int i = 0; i < 16; ++i) sv[i] = 0.f;
        }
#define P8_REQU(E_, un) do { const int Er_ = (E_); P8_REQU_L(((Er_ < 128) || !hn) ? EIc : EIn, Er_ & 127, un); } while (0)
#define P8_REQV(e, vn) p8_req_v(va##vn, vb##vn, su##vn, gg##vn, U6, USC, EIc, EGc, (e), lane)
#define P8_TOPK_VARS const int lane = lane_id(); const int qb = (lane & 7) * 16, hh2 = lane >> 3, ee2 = lane & 7; (void)qb; (void)hh2; (void)ee2;
        const int lane = lane_id(); LAS f32x4* xnl = (LAS f32x4*)(L + 4096) + lane;
#pragma unroll 1
        for (int e0 = 0; e0 < 128; e0 += 4) {
            const int g0 = e0 >> 2;
            if (hn && e0 == 32) { const int lane = lane_id(); P8_S1_LOAD(mn, 1); }
            if (hn && e0 >= 64) {
                P8_TOPK_VARS
                LAS f32x4* s2a = (LAS f32x4*)(L + 13312) + lane; LAS f32x2* s2b = (LAS f32x2*)(L + 14336) + lane;
                float s1a, ha, hb, smax, den; int kq;
                if (e0 == 64) { P8_S2_SETUP(); }
                else { const f32x4 t = *s2a; const f32x2 u = *s2b; s1a = t.x; ha = t.y; hb = t.z; { const float tw = t[3]; kq = __float_as_int(tw); }        smax = u.x; den = u.y; }
                const float rsn = RSN[0];
                P8_S2_SLICE(g0 - 16, EGn, EIn, rsn);
                if (e0 == 124) { P8_S2_FIN(EGn); }
                else { const float kf = __int_as_float(kq); *s2a = (f32x4){s1a, ha, hb, kf}; *s2b = (f32x2){smax, den}; }
            }
            const v4i_t idc = *(const LAS v4i_t*)(EIc + e0); const f32x4 ggc = *(const LAS f32x4*)(EGc + e0);
            const v4i_t idn = *(const LAS v4i_t*)((((e0 + 4) < 128) || !hn ? EIc : EIn) + ((e0 + 4) & 127));
            const int i0 = idc[0], i1 = idc[1], i2 = idc[2], i3 = idc[3], n0 = idn[0], n1 = idn[1], n2 = idn[2], n3 = idn[3];
            const float q0 = ggc[0], q1 = ggc[1], q2 = ggc[2], q3 = ggc[3];
            p8_req_v_id(va0, vb0, su0, gg0, U6, USC, i0, q0, lane); p8_req_v_id(va1, vb1, su1, gg1, U6, USC, i1, q1, lane);
            p8_req_v_id(va2, vb2, su2, gg2, U6, USC, i2, q2, lane); p8_req_v_id(va3, vb3, su3, gg3, U6, USC, i3, q3, lane);
            float p0_, p1_, p2_, p3_;
            p8_udot2(ua0, ub0, ua1, ub1, xnl, p0_, p1_);
            p8_req_u_id(ua0, ub0, U6, n0, lane); p8_req_u_id(ua1, ub1, U6, n1, lane);
            p8_udot2(ua2, ub2, ua3, ub3, xnl, p2_, p3_);
            p8_req_u_id(ua2, ub2, U6, n2, lane); p8_req_u_id(ua3, ub3, U6, n3, lane);
            const float R_ = p8_reduce4(p0_, p1_, p2_, p3_, lane);
            const float sus_ = (lane & 2) ? ((lane & 1) ? su3 : su2) : ((lane & 1) ? su1 : su0);
            const float gl_ = gelu_as(R_ * sus_);
            p8_vpart(va0, vb0, gg0 * p8_rdl(gl_, 0), acc); p8_vpart(va1, vb1, gg1 * p8_rdl(gl_, 1), acc);
            p8_vpart(va2, vb2, gg2 * p8_rdl(gl_, 2), acc); p8_vpart(va3, vb3, gg3 * p8_rdl(gl_, 3), acc);
            if (hn && e0 < 64) { P8_TOPK_VARS const int h = g0 >> 3, i2 = (g0 & 7) * 2; P8_S1_SLICE(h, i2); P8_S1_SLICE(h, i2 + 1); }
        }
        {
        const int lane = lane_id();
        const bf16* xrow = (const bf16*)(ws + WS_X1B) + (size_t)m * D;
        const bool hn2 = hn && (mn + NGW < M);
        v2u w1[8], wn[8], wr[8];
#pragma unroll
        for (int q = 0; q < 8; ++q) w1[q] = *(const GAS v2u*)(xrow + q * 256 + lane * 4);
        if (hn) {
            const bf16* xn_ = (const bf16*)(ws + WS_X1B) + (size_t)mn * D;
#pragma unroll
            for (int q = 0; q < 8; ++q) wn[q] = *(const GAS v2u*)(xn_ + q * 256 + lane * 4);
        }
        if (hn2) {
            const bf16* xr_ = (const bf16*)(ws + WS_X1B) + (size_t)(mn + NGW) * D;
#pragma unroll
            for (int q = 0; q < 8; ++q) wr[q] = *(const GAS v2u*)(xr_ + q * 256 + lane * 4);
        }
        f32x4 x2[8]; float s2 = 0.f;
#pragma unroll
        for (int q = 0; q < 8; ++q) { const f32x4 x1 = {bflo(w1[q].x), bfhi(w1[q].x), bflo(w1[q].y), bfhi(w1[q].y)};
            x2[q] = (f32x4){x1.x + acc[4 * q], x1.y + acc[4 * q + 1], x1.z + acc[4 * q + 2], x1.w + acc[4 * q + 3]}; acc[4 * q] = 0.f; acc[4 * q + 1] = 0.f; acc[4 * q + 2] = 0.f; acc[4 * q + 3] = 0.f; }
#pragma unroll
        for (int j = 0; j < 8; ++j) s2 += (x2[j].x * x2[j].x + x2[j].y * x2[j].y) + (x2[j].z * x2[j].z + x2[j].w * x2[j].w);
        const float rstd2 = 1.0f / sqrtf(wave_sum_fast(s2) * (1.f / D) + EPS);
        float* orow = a.out + (size_t)m * D;
#pragma unroll
        for (int q = 0; q < 8; ++q) __builtin_nontemporal_store(x2[q] * rstd2 * *(const f32x4*)(a.g_fin + q * 256 + lane * 4), (GAS f32x4*)(orow + q * 256 + lane * 4));
        if (hn) {
            const float rsn = RSN[0];
            LAS float* xnf = (LAS float*)(L + 4096) + lane * 4;
#pragma unroll
            for (int q = 0; q < 8; ++q) { const f32x4 xv = {bflo(wn[q].x), bfhi(wn[q].x), bflo(wn[q].y), bfhi(wn[q].y)}; const f32x4 t = xv * rsn * *(const f32x4*)(a.g_ffn + q * 256 + lane * 4);
#pragma unroll
                for (int e = 0; e < 4; ++e) { const int pj = __builtin_amdgcn_readfirstlane(INV[4 * q + e]); xnf[(pj >> 2) * 256 + (pj & 3)] = t[e]; } }
            float r2 = 0.f;
            if (hn2) { float ss = 0.f;
#pragma unroll
                for (int q = 0; q < 8; ++q) { const float x0 = bflo(wr[q].x), x1 = bfhi(wr[q].x), x2_ = bflo(wr[q].y), x3 = bfhi(wr[q].y); ss += (x0 * x0 + x1 * x1) + (x2_ * x2_ + x3 * x3); }
                r2 = 1.0f / sqrtf(wave_sum_fast(ss) * (1.f / D) + EPS); }
            RSN[0] = r2; LDS_WAIT(); asm volatile("" ::: "memory");
        }
        }
        buf ^= 1;
    }
#undef P8_REQU
#undef P8_REQV
}


#ifndef N_LAUNCHES
#define N_LAUNCHES 1
#endif
constexpr int NPHASE = 9;
__global__ void __launch_bounds__(NWAVES * 64, 2) mk_fwd(Args args) {
    extern __shared__ __attribute__((aligned(16))) unsigned char lds_raw[];
    LAS unsigned char* lds = (LAS unsigned char*)lds_raw;
    volatile LAS unsigned* MISC = (volatile LAS unsigned*)(lds + MISC_OFF);
    const int wave = __builtin_amdgcn_readfirstlane(threadIdx.x >> 6);
#define lane (lane_id())
#define tid (wave * 64 + lane)
    const int G = gridDim.x; const int bx = blockIdx.x; const int vcu = (G % 8 == 0) ? (bx % 8) * (G / 8) + bx / 8 : bx;
    unsigned char* ws = args.ws;
    gu32* ctl = (gu32*)(ws + WS_CTL);
    for (int u = tid; u < (LDS_BYTES - LDSCTL_OFF) / 4; u += NWAVES * 64) ((LAS unsigned*)(lds + LDSCTL_OFF))[u] = 0u;
    __syncthreads();
    XcdBarrier bar; bar.bar = (unsigned*)(ctl + CW_BAR); bar.x = 0; bar.st = nullptr;
    if (N_LAUNCHES == 1) bar = xcd_barrier_post((unsigned*)(ctl + CW_BAR), MISC + 8);
    const int lo = args.ph_lo, hi = args.ph_hi;
#ifndef PHMASK
#define PHMASK 0x1ff
#endif
#define IN(k) (((PHMASK >> (k)) & 1) && lo <= (k) && (k) < hi)
#define GRID_BAR(k) do { if (IN(k) && IN((k) + 1)) xcd_barrier(bar, wave == 0 && lane == 0); } while (0)
#ifndef REPEAT_PHASE
#define REPEAT_PHASE -1
#endif
#define REP(k) for (int rep_ = 0; rep_ < ((REPEAT_PHASE == (k)) ? 2 : 1); ++rep_, ((REPEAT_PHASE == (k)) && rep_ < 2 ? xcd_barrier(bar, wave == 0 && lane == 0) : (void)0))

#ifdef TS_A
#define STAMP(k) do { if (bx == 0 && wave == 0) { const unsigned t_ = (unsigned)__builtin_amdgcn_s_memrealtime(); if (lane == 0) MISC[16 + (k)] = t_; } } while (0)
#else
#define STAMP(k) do {} while (0)
#endif
    STAMP(0);
    REP(0) if (IN(0)) { p0_prologue(args, lds, vcu, G, wave, lane); }
    GRID_BAR(0); STAMP(1);
    REP(1) if (IN(1)) {
#ifdef P1_FP8
        { pg8::Gemm g{(const bf16*)(ws + WS_XN8), (const bf16*)(ws + WS_XN8), M, 3584, D, 0x7f7f7f7f, 0x79797979}; Order<4> S; S.init(64, 14, G, bx); if (G == 256 && (bx % 6) < 3) S.defer(ws, args.pu, args.pv, bx % 6, vcu * NWAVES + wave, G * NWAVES);
          Epi1T<80> E{ws, (bf16*)args.out};
          pg8::gemm_phase<Epi1T<80>, Order<4>, true, true, true>(lds + RING_OFF, g, S, E, wave); }
#endif
#ifdef P1_NEED_BF16
        { pg8::Gemm g{(const bf16*)(ws + WS_XN), (const bf16*)(ws + WS_XN), M, 3584, D, 0, 0}; Order<1> S; S.init(64, 14, G, bx);
          Epi1 E{ws, (bf16*)args.out};
          pg8::gemm_phase<Epi1, Order<1>, true, true>(lds + RING_OFF, g, S, E, wave); }
#endif
        { pg8::Gemm g{(const bf16*)(ws + WS_XN8), (const bf16*)(ws + WS_WG8), M, 3584, D, 0x7f7f7f7f, 0x79797979}; Order<0> S; S.init(64, 14, G, (bx + G / 2) % G); if (G == 256 && (bx % 6) >= 3) S.defer(ws, args.pu, args.pv, bx % 6 - 3, vcu * NWAVES + wave, G * NWAVES);
          Epi1g E{(bf16*)args.out};
          pg8::gemm_phase<Epi1g, Order<0>, true, true, true>(lds + RING_OFF, g, S, E, wave); }
    }
    GRID_BAR(1); STAMP(2);
    REP(2) if (IN(2)) { p2_rowstats(ws, vcu, G, wave, lane); STAMP(10); p2_indexer(ws, lds, bx, G, wave, lane);
#ifdef REP_INDEXER
        p2_indexer(ws, lds, bx, G, wave, lane);
#endif
    }
    GRID_BAR(2); STAMP(3);
    REP(3) if (IN(3)) {
        { pg8::Gemm g{(const bf16*)(ws + WS_XN8), (const bf16*)(ws + WS_WG8 + (size_t)3584 * D), M, 512, D, 0x7f7f7f7f, 0x79797979}; Order<0> S; S.init(64, 2, G, (bx + G / 2) % G);
          Epi1gT<14> E{(bf16*)args.out};
          pg8::gemm_phase<Epi1gT<14>, Order<0>, true, true, true>(lds + RING_OFF, g, S, E, wave); }
        { pg8::Gemm g{(const bf16*)(ws + WS_CQ), (const bf16*)(ws + WS_WUQ), M, 1536, 512}; Order<0> S; S.init(64, 6, G, bx); Epi3q E{ws};
          pg8::gemm_phase<Epi3q, Order<0>, true, true>(lds + RING_OFF, g, S, E, wave); }
        { pg8::Gemm g{(const bf16*)(ws + WS_CKV), (const bf16*)(ws + WS_CKV), M, 2048, 256}; Order<2> S; S.init(64, 8, G, bx); Epi3k E{ws};
          pg8::gemm_phase<Epi3k, Order<2>, true, true>(lds + RING_OFF, g, S, E, wave); }
        STAMP(11);
        p3_select(ws, lds, vcu, G, wave, lane);
        STAMP(12);
#ifdef REP_SELECT
        p3_select(ws, lds, vcu, G, wave, lane);
#endif
    }
    GRID_BAR(3); STAMP(4);
    REP(4) if (IN(4)) { p4_attention(ws, lds, bx, G, wave, lane); }
    GRID_BAR(4); STAMP(5);
    REP(5) if (IN(5)) {
        pg8::Gemm g{(const bf16*)(ws + WS_OA), (const bf16*)(ws + WS_WAB), 2 * M, 4096, 1024, 0x7b7b7b7b, 0x7a7a7a7a}; Order<3> S; S.init(64, 8, G, bx); Epi5 E{ws, (const bf16*)args.out};
        pg8::gemm_phase<Epi5, Order<3>, true, true, true>(lds + RING_OFF, g, S, E, wave);
    }
    GRID_BAR(5); STAMP(6);
    REP(6) if (IN(6)) {
        pg8::Gemm g{(const bf16*)(ws + WS_MRG), (const bf16*)(ws + WS_WO), M, D, D, 0x7b7b7b7b, 0x79797979}; Order<0> S; S.init(64, 8, G, bx); Epi6 E{ws, args.x, args.out};
        pg8::gemm_phase<Epi6, Order<0>, true, true, true>(lds + RING_OFF, g, S, E, wave);
    }
    GRID_BAR(6); STAMP(7);
    REP(7) if (IN(7)) {
        pg8::Gemm g{(const bf16*)(ws + WS_X1B), (const bf16*)(ws + WS_W2), M, D, D}; Order<0> S; S.init(64, 8, G, bx); Epi7 E{ws};
        pg8::gemm_phase<Epi7, Order<0>, true, true>(lds + RING_OFF, g, S, E, wave);
    }
    GRID_BAR(7); STAMP(8);
    if (IN(8)) { p8_peer(args, lds, vcu, G, wave, lane); }
#ifdef TS_A
#ifndef TS_BASE
#define TS_BASE 50.0f
#endif
#ifndef TS_OFF
#define TS_OFF 0.0f
#endif
#ifndef TS_SCALE
#define TS_SCALE 0.1f
#endif
    STAMP(9);
#ifdef TS_LAST
    if (bx == 0 && wave == 0 && lane == 0) { for (int q = 0; q < 24; ++q) __hip_atomic_store(ctl + 256 + q, MISC[16 + q], RLX_AGENT); }
    VM_WAIT(); __threadfence(); __syncthreads();
    if (wave == 0) {
        unsigned last = 0u;
        if (lane == 0) last = (__hip_atomic_fetch_add(ctl + 512, 1u, RLX_AGENT) == (unsigned)G - 1u) ? 1u : 0u;
        last = __builtin_amdgcn_readfirstlane(last);
        if (last) {
            __threadfence();
            const unsigned tend = (unsigned)__builtin_amdgcn_s_memrealtime();
            const float dA = (float)(tend - __hip_atomic_load(ctl + 256 + TS_A, RLX_AGENT)) * 0.01f;
            if (lane == 0) args.out[0] += TS_BASE + (dA - TS_OFF) * TS_SCALE;
        }
    }
#else
    if (bx == 0 && wave == 0) {
        LDS_WAIT();
#ifndef TS_A1
#define TS_A1 (TS_A + 1)
#endif
#ifndef TS_B1
#define TS_B1 (TS_B + 1)
#endif
        const float dA = (float)(MISC[16 + TS_A1] - MISC[16 + TS_A]) * 0.01f, dB = (float)(MISC[16 + TS_B1] - MISC[16 + TS_B]) * 0.01f;
        VM_WAIT();
        if (lane == 0) args.out[0] += TS_BASE + (dA - TS_OFF) * TS_SCALE;
        const float dl = dB * 0.002f;
        for (int j = 0; j < 32; ++j) args.out[(size_t)2048 * D + j * 64 + lane] += dl;
    }
#endif
#endif
#undef IN
#undef GRID_BAR
#undef lane
#undef tid
}

extern "C" void kernel_launch(void* const* d_in, const int* in_sizes, int n_in, void* d_out, int out_size, void* d_ws, size_t ws_size, hipStream_t stream) {
    static int grid = 0;
    if (grid == 0) {
        if (n_in != 18 || in_sizes[0] != M * D || out_size != M * D || ws_size < WS_END) { fprintf(stderr, "kernel_launch: unexpected problem (n_in %d, in0 %d, out %d, ws %zu)\n", n_in, n_in > 0 ? in_sizes[0] : -1, out_size, ws_size); grid = -1; return; }
        int dev = 0, cus = 0, per_cu = 0;
        if (hipGetDevice(&dev) != hipSuccess || hipDeviceGetAttribute(&cus, hipDeviceAttributeMultiprocessorCount, dev) != hipSuccess) { grid = -1; return; }
        if (hipFuncSetAttribute((const void*)mk_fwd, hipFuncAttributeMaxDynamicSharedMemorySize, LDS_BYTES) != hipSuccess) { fprintf(stderr, "kernel_launch: hipFuncSetAttribute failed\n"); grid = -1; return; }
        if (hipOccupancyMaxActiveBlocksPerMultiprocessor(&per_cu, (const void*)mk_fwd, NWAVES * 64, LDS_BYTES) != hipSuccess || per_cu < 1)
            fprintf(stderr, "kernel_launch: note: occupancy query reports %d workgroups per CU\n", per_cu);
        (void)hipGetLastError();
        grid = cus;
    }
    if (grid < 0) return;
    if (hipMemsetAsync((char*)d_ws + WS_CTL, 0, CTL_ZERO_BYTES, stream) != hipSuccess) return;
#ifdef TWO_MEMSETS
    (void)hipMemsetAsync((char*)d_ws + WS_CTL + 32768, 0, 4096, stream);
#endif
    Args a{};
    a.x = (const float*)d_in[0]; a.pos = (const int*)d_in[1]; a.g_mix = (const float*)d_in[2]; a.w_in = (const float*)d_in[3]; a.g_q = (const float*)d_in[4]; a.g_kv = (const float*)d_in[5];
    a.w_uq = (const float*)d_in[6]; a.w_uk = (const float*)d_in[7]; a.w_uv = (const float*)d_in[8]; a.w_a = (const float*)d_in[9]; a.w_b = (const float*)d_in[10]; a.w_o = (const float*)d_in[11];
    a.g_ffn = (const float*)d_in[12]; a.w_pq = (const float*)d_in[13]; a.subk = (const float*)d_in[14]; a.pu = (const float*)d_in[15]; a.pv = (const float*)d_in[16]; a.g_fin = (const float*)d_in[17];
    a.out = (float*)d_out; a.ws = (unsigned char*)d_ws;
    for (int i = 0; i < 32; ++i) a.invf[i] = pow(500000.0, -(2.0 * i) / 64.0);
    for (int i = 0; i < 16; ++i) a.invf[32 + i] = pow(500000.0, -(2.0 * i) / 32.0);
    for (int i = 0; i < 8; ++i) a.invf[48 + i] = pow(500000.0, -(2.0 * i) / 16.0);
    if (N_LAUNCHES == 1) { a.ph_lo = 0; a.ph_hi = NPHASE; hipLaunchKernelGGL(mk_fwd, dim3(grid), dim3(NWAVES * 64), LDS_BYTES, stream, a); }
    else for (int li = 0; li < NPHASE; ++li) { a.ph_lo = li; a.ph_hi = li + 1; hipLaunchKernelGGL(mk_fwd, dim3(grid), dim3(NWAVES * 64), LDS_BYTES, stream, a); }
}
```
